# Optimizing an MI355X kernel written in HIP

```python
import math
import jax, jax.numpy as jnp
from jax import lax
import numpy as np

D_MODEL = 2048
BATCH = 4
SEQ = 8192
DEPTH = 1

CTX_LEN = 256
GRID_W = 64

F_GROUPS = 4
F_GROUP_DIM = 256
F_WIDTH = F_GROUPS * F_GROUP_DIM
S_GROUP_DIM = 16
S_GROUPS = 32
S_WIDTH = S_GROUPS * S_GROUP_DIM
S_STATE = 64
DT_MIN = 1e-3
DT_MAX = 1e-1
N_DIRECTIONS = 2
N_BRANCH = 2
IN_WIDTH = F_WIDTH + S_WIDTH + N_BRANCH * D_MODEL
N_EXPERT_GROUPS = 4
EXPERTS_PER_GROUP = 8
N_EXPERTS = N_EXPERT_GROUPS * EXPERTS_PER_GROUP
TOP_K = 2
D_EXPERT = 1024
ROW_BLOCK = 128
N_MOD = 6
LN_EPS = 1e-5
DEEPNORM_ALPHA = (2.0 * DEPTH) ** 0.25
DEEPNORM_BETA = (8.0 * DEPTH) ** -0.25

kernel_name = "hybrid_fourier_s5_hmoe_dit"

F32 = jnp.float32


def layer_norm(x, gain=None, bias=None):
    xf = x.astype(F32)
    mu = xf.mean(-1, keepdims=True)
    var = jnp.square(xf - mu).mean(-1, keepdims=True)
    y = (xf - mu) * lax.rsqrt(var + LN_EPS)
    if gain is not None:
        y = y * gain.astype(F32) + bias.astype(F32)
    return y.astype(x.dtype)


def modulate(x, shift, scale):
    return layer_norm(x) * (1 + scale[:, None]) + shift[:, None]


def fourier_mix(u, pos_shape):
    b = u.shape[0]
    uf = u.astype(F32).reshape((b,) + pos_shape + (F_GROUPS, F_GROUP_DIM))
    axes = tuple(range(1, 1 + len(pos_shape))) + (uf.ndim - 1,)
    y = jnp.fft.fftn(uf, axes=axes, norm="ortho").real
    return y.reshape(u.shape).astype(u.dtype)


def _linear_recurrence(left, right):
    a_l, b_l = left
    a_r, b_r = right
    return a_r * a_l, a_r * b_l + b_r


def s5_states(u, lam_re, lam_im, log_dt, b_re, b_im, s0):
    lam = lax.complex(lam_re.astype(F32), lam_im.astype(F32))
    dt = jnp.exp(log_dt.astype(F32))[:, None]
    lam_bar = jnp.exp(lam * dt)
    b_cplx = lax.complex(b_re.astype(F32), b_im.astype(F32))
    b_bar = ((lam_bar - 1.0) / lam)[:, :, None] * b_cplx
    bu = jnp.einsum("gph,blgh->blgp", b_bar, u.astype(jnp.complex64))
    if s0 is not None:
        bu = bu.at[:, 0].add(lam_bar * s0)
    a = jnp.broadcast_to(lam_bar, bu.shape)
    _, states = lax.associative_scan(_linear_recurrence, (a, bu), axis=1)
    return states


def s5_readout(states, c_re, c_im):
    c_cplx = lax.complex(c_re.astype(F32), c_im.astype(F32))
    return jnp.einsum("ghp,blgp->blgh", c_cplx, states).real


def s5_glu(y, w_glu, b_glu):
    y = jax.nn.gelu(y.reshape(y.shape[0], y.shape[1], S_WIDTH))
    return y * jax.nn.sigmoid(y @ w_glu.astype(F32) + b_glu.astype(F32))


def merge_branches(f_out, s_out, z_f, z_s, w_f_proj, w_s_proj, w_out):
    m = jax.nn.sigmoid(z_f) * (f_out @ w_f_proj) + jax.nn.sigmoid(z_s) * (s_out @ w_s_proj)
    return m @ w_out


def hierarchical_route(h, w_group, b_group, w_expert, b_expert):
    t = h.shape[0]
    g_prob = jax.nn.softmax((h @ w_group + b_group).astype(F32), axis=-1)
    g_top, g_idx = lax.top_k(g_prob, 1)
    e_logits = (h @ w_expert + b_expert).astype(F32).reshape(t, N_EXPERT_GROUPS, EXPERTS_PER_GROUP)
    e_logits = jnp.take_along_axis(e_logits, g_idx[:, :, None], axis=1)[:, 0]
    e_top, e_local = lax.top_k(jax.nn.softmax(e_logits, axis=-1), TOP_K)
    weights = g_top * e_top / e_top.sum(-1, keepdims=True)
    experts = g_idx * EXPERTS_PER_GROUP + e_local
    return experts, weights


def expert_dispatch(h, experts, weights, w1, w3, w2):
    t, d = h.shape
    n_assign = t * TOP_K
    e_flat = experts.reshape(-1)
    w_flat = weights.reshape(-1)
    tok_flat = jnp.repeat(jnp.arange(t, dtype=jnp.int32), TOP_K)
    counts = jnp.bincount(e_flat, length=N_EXPERTS)
    padded = (counts + ROW_BLOCK - 1) // ROW_BLOCK * ROW_BLOCK
    start = jnp.cumsum(counts) - counts
    pend = jnp.cumsum(padded)
    pstart = pend - padded
    order = jnp.argsort(e_flat)
    e_sorted = e_flat[order]
    dest = pstart[e_sorted] + jnp.arange(n_assign) - start[e_sorted]
    n_blocks = -(-(n_assign + N_EXPERTS * (ROW_BLOCK - 1)) // ROW_BLOCK)
    n_rows = n_blocks * ROW_BLOCK
    row_tok = jnp.full((n_rows,), t, jnp.int32).at[dest].set(tok_flat[order])
    row_w = jnp.zeros((n_rows,), F32).at[dest].set(w_flat[order])
    block_exp = jnp.minimum(
        jnp.searchsorted(pend, jnp.arange(n_blocks) * ROW_BLOCK, side="right"), N_EXPERTS - 1)
    h_pad = jnp.concatenate([h, jnp.zeros((1, d), h.dtype)], axis=0)
    xb = h_pad[row_tok].reshape(n_blocks, ROW_BLOCK, d)

    def run_block(args):
        xblk, e = args
        return (jax.nn.silu(xblk @ w1[e]) * (xblk @ w3[e])) @ w2[e]

    yb = lax.map(run_block, (xb, block_exp)).reshape(n_rows, d)
    out = jnp.zeros_like(h_pad).at[row_tok].add(yb * row_w[:, None].astype(yb.dtype))
    return out[:t]


def hierarchical_moe(h, w_group, b_group, w_expert, b_expert, w1, w3, w2):
    experts, weights = hierarchical_route(h, w_group, b_group, w_expert, b_expert)
    return expert_dispatch(h, experts, weights, w1, w3, w2)


def setup_inputs(seed: int = 0) -> dict:
    key = jax.random.key(seed)
    ks = jax.random.split(key, 32)
    nrm = jax.random.normal
    L, D = DEPTH, D_MODEL
    G, P, H = S_GROUPS, S_STATE, S_GROUP_DIM
    lam_im0 = jnp.pi * jnp.arange(P, dtype=F32)
    return {
        "x": nrm(ks[0], (BATCH, SEQ, D), F32),
        "c": nrm(ks[1], (BATCH, D), F32),
        "ctx": nrm(ks[2], (BATCH, CTX_LEN, D), F32),
        "c_ctx": nrm(ks[3], (D,), F32),
        "w_ada": nrm(ks[4], (L, D, N_MOD * D), F32) * D ** -0.5,
        "b_ada": 0.01 * nrm(ks[5], (L, N_MOD * D), F32),
        "w_in": nrm(ks[6], (L, D, IN_WIDTH), F32) * D ** -0.5,
        "w_f_proj": nrm(ks[7], (L, F_WIDTH, D), F32) * F_WIDTH ** -0.5,
        "lam_re": -0.5 * (1.0 + 0.01 * nrm(ks[8], (L, N_DIRECTIONS, G, P), F32)),
        "lam_im": lam_im0 + 0.01 * nrm(ks[9], (L, N_DIRECTIONS, G, P), F32),
        "log_dt": jax.random.uniform(ks[10], (L, N_DIRECTIONS, G), F32,
                                     math.log(DT_MIN), math.log(DT_MAX)),
        "b_re": nrm(ks[11], (L, N_DIRECTIONS, G, P, H), F32) * (2.0 * H) ** -0.5,
        "b_im": nrm(ks[12], (L, N_DIRECTIONS, G, P, H), F32) * (2.0 * H) ** -0.5,
        "c_re": nrm(ks[13], (L, N_DIRECTIONS, G, H, P), F32) * (2.0 * P) ** -0.5,
        "c_im": nrm(ks[14], (L, N_DIRECTIONS, G, H, P), F32) * (2.0 * P) ** -0.5,
        "d_skip": nrm(ks[15], (L, G, H), F32),
        "w_glu": nrm(ks[16], (L, S_WIDTH, S_WIDTH), F32) * S_WIDTH ** -0.5,
        "b_glu": 0.01 * nrm(ks[17], (L, S_WIDTH), F32),
        "w_s_proj": nrm(ks[18], (L, S_WIDTH, D), F32) * S_WIDTH ** -0.5,
        "w_out": nrm(ks[19], (L, D, D), F32) * D ** -0.5 * DEEPNORM_BETA,
        "ln1_g": 1.0 + 0.01 * nrm(ks[20], (L, D), F32),
        "ln1_b": 0.01 * nrm(ks[21], (L, D), F32),
        "w_group": nrm(ks[22], (L, D, N_EXPERT_GROUPS), F32) * D ** -0.5,
        "b_group": 0.01 * nrm(ks[23], (L, N_EXPERT_GROUPS), F32),
        "w_expert": nrm(ks[24], (L, D, N_EXPERTS), F32) * D ** -0.5,
        "b_expert": 0.01 * nrm(ks[25], (L, N_EXPERTS), F32),
        "w1": nrm(ks[26], (L, N_EXPERTS, D, D_EXPERT), F32) * D ** -0.5,
        "w3": nrm(ks[27], (L, N_EXPERTS, D, D_EXPERT), F32) * D ** -0.5,
        "w2": nrm(ks[28], (L, N_EXPERTS, D_EXPERT, D), F32) * D_EXPERT ** -0.5 * DEEPNORM_BETA,
        "ln2_g": 1.0 + 0.01 * nrm(ks[29], (L, D), F32),
        "ln2_b": 0.01 * nrm(ks[30], (L, D), F32),
    }


def reference(x, c, ctx, c_ctx, w_ada, b_ada, w_in, w_f_proj, lam_re, lam_im, log_dt,
              b_re, b_im, c_re, c_im, d_skip, w_glu, b_glu, w_s_proj, w_out,
              ln1_g, ln1_b, w_group, b_group, w_expert, b_expert, w1, w3, w2,
              ln2_g, ln2_b):
    bsz, seq, _ = x.shape
    ctx_len = ctx.shape[1]
    rows = seq // GRID_W
    ctx_x = ctx
    cut = (F_WIDTH, F_WIDTH + S_WIDTH, F_WIDTH + S_WIDTH + D_MODEL)
    for l in range(DEPTH):
        last = l == DEPTH - 1
        mod = jnp.split(jax.nn.silu(c) @ w_ada[l] + b_ada[l], N_MOD, axis=-1)
        mod_c = jnp.split(jax.nn.silu(c_ctx)[None] @ w_ada[l] + b_ada[l], N_MOD, axis=-1)
        ssm_dir = [(lam_re[l, d], lam_im[l, d], log_dt[l, d], b_re[l, d], b_im[l, d])
                   for d in range(N_DIRECTIONS)]

        h = modulate(x, mod[0], mod[1])
        u_f, u_s, z_f, z_s = jnp.split(h @ w_in[l], cut, axis=-1)
        hc = modulate(ctx_x, mod_c[0], mod_c[1])
        if last:
            uc_s = hc @ w_in[l, :, F_WIDTH:F_WIDTH + S_WIDTH]
        else:
            uc_f, uc_s, zc_f, zc_s = jnp.split(hc @ w_in[l], cut, axis=-1)
        uc_s = uc_s.astype(F32).reshape(bsz, ctx_len, S_GROUPS, S_GROUP_DIM)
        sc_f = s5_states(uc_s, *ssm_dir[0], None)
        sc_b = s5_states(uc_s[:, ::-1], *ssm_dir[1], None)
        u_s = u_s.astype(F32).reshape(bsz, seq, S_GROUPS, S_GROUP_DIM)
        s_f = s5_states(u_s, *ssm_dir[0], sc_f[:, -1])
        s_b = s5_states(u_s[:, ::-1], *ssm_dir[1], sc_b[:, -1])[:, ::-1]
        y_s = (s5_readout(s_f, c_re[l, 0], c_im[l, 0]) + s5_readout(s_b, c_re[l, 1], c_im[l, 1])
               + d_skip[l] * u_s)
        s_out = s5_glu(y_s, w_glu[l], b_glu[l]).astype(x.dtype)
        f_out = fourier_mix(u_f, (rows, GRID_W))
        mix = merge_branches(f_out, s_out, z_f, z_s, w_f_proj[l], w_s_proj[l], w_out[l])
        x_mid = layer_norm(DEEPNORM_ALPHA * x + mod[2][:, None] * mix, ln1_g[l], ln1_b[l])
        if not last:
            yc_s = (s5_readout(sc_f, c_re[l, 0], c_im[l, 0])
                    + s5_readout(sc_b[:, ::-1], c_re[l, 1], c_im[l, 1]) + d_skip[l] * uc_s)
            sc_out = s5_glu(yc_s, w_glu[l], b_glu[l]).astype(x.dtype)
            fc_out = fourier_mix(uc_f, (ctx_len,))
            mix_c = merge_branches(fc_out, sc_out, zc_f, zc_s, w_f_proj[l], w_s_proj[l], w_out[l])
            ctx_x = layer_norm(DEEPNORM_ALPHA * ctx_x + mod_c[2][:, None] * mix_c, ln1_g[l], ln1_b[l])
        x = x_mid

        h2 = modulate(x, mod[3], mod[4]).reshape(bsz * seq, D_MODEL)
        moe_args = (w_group[l], b_group[l], w_expert[l], b_expert[l], w1[l], w3[l], w2[l])
        if last:
            y2 = hierarchical_moe(h2, *moe_args).reshape(bsz, seq, D_MODEL)
        else:
            h2c = modulate(ctx_x, mod_c[3], mod_c[4]).reshape(bsz * ctx_len, D_MODEL)
            y_all = hierarchical_moe(jnp.concatenate([h2, h2c], axis=0), *moe_args)
            y2 = y_all[:bsz * seq].reshape(bsz, seq, D_MODEL)
            y2c = y_all[bsz * seq:].reshape(bsz, ctx_len, D_MODEL)
            ctx_x = layer_norm(DEEPNORM_ALPHA * ctx_x + mod_c[5][:, None] * y2c, ln2_g[l], ln2_b[l])
        x = layer_norm(DEEPNORM_ALPHA * x + mod[5][:, None] * y2, ln2_g[l], ln2_b[l])
    return x
```

```cpp
#include <hip/hip_runtime.h>
#include <cstdio>
#include <cstdint>

#ifndef MK_ONE_LAUNCH
#define MK_ONE_LAUNCH 1
#endif

#define GAS __attribute__((address_space(1)))
#define LAS __attribute__((address_space(3)))
typedef unsigned short bf16;
typedef float f32x4 __attribute__((ext_vector_type(4)));
typedef float f32x2 __attribute__((ext_vector_type(2)));
typedef short bf16x8 __attribute__((ext_vector_type(8)));
typedef unsigned u32x4 __attribute__((ext_vector_type(4)));
typedef unsigned u32x2 __attribute__((ext_vector_type(2)));
typedef int i32x4 __attribute__((ext_vector_type(4)));
typedef int i32x8 __attribute__((ext_vector_type(8)));
typedef GAS unsigned gu32;
#define RLX_AGENT __ATOMIC_RELAXED, __HIP_MEMORY_SCOPE_AGENT

constexpr int D = 2048, NB = 4, SEQ = 8192, T = NB * SEQ, CTXL = 256, TC = NB * CTXL;
constexpr int FW = 1024, SW = 512, INW = 5632;
constexpr int SG = 32, SH = 16, SP = 64, LC = 32, NCH = 264, NCTXCH = 8, A2LD = 768;
constexpr int NE = 32, DE = 1024, ECAP = 32768;
constexpr float LN_EPS = 1e-5f;
constexpr float DN_ALPHA = 1.189207115002721f;
constexpr int NPHASE = 14;

constexpr size_t MiB = 1u << 20;
constexpr size_t WS_CTL = 0, CTL_ZERO_BYTES = 1 * MiB;
constexpr size_t WS_MODPART = 1 * MiB;
constexpr size_t WS_MODV = 5 * MiB;
constexpr size_t WS_PW = 6 * MiB;
constexpr size_t WS_BBAR = 8 * MiB;
constexpr size_t WS_LAML = 9 * MiB;
constexpr size_t WS_LAMSEG = 9 * MiB + 512 * 1024;
constexpr size_t WS_KLAG = 10 * MiB;
constexpr size_t WS_RW = 12 * MiB;
constexpr size_t WS_ROWLIST = 13 * MiB;
constexpr size_t WS_FKT = 17 * MiB;
constexpr size_t WS_FCT = 17 * MiB + 256 * 1024;
constexpr size_t WS_FRT = 17 * MiB + 512 * 1024;
constexpr size_t WS_WRTHI = 17 * MiB + 768 * 1024;
constexpr size_t WS_WRTLO = 18 * MiB;
constexpr size_t WS_HC = 19 * MiB;
constexpr size_t WS_WINT = 24 * MiB;
constexpr size_t WS_WG8 = 32 * MiB;
constexpr size_t WS_WFT = 46 * MiB;
constexpr size_t WS_WST = 50 * MiB;
constexpr size_t WS_WOT = 52 * MiB;
constexpr size_t WS_WGLUT = 60 * MiB;
constexpr size_t WS_WET = 61 * MiB;
constexpr size_t WS_TV = 69 * MiB;
constexpr size_t WS_W13T = 96 * MiB;
constexpr size_t WS_XMID = 224 * MiB;
constexpr size_t WS_W2T = 352 * MiB;
constexpr size_t WS_R3 = 480 * MiB;
constexpr size_t WS_RA = 608 * MiB;
constexpr size_t WS_RB = 736 * MiB;
constexpr size_t WS_UF = WS_RB;
constexpr size_t WS_A2 = WS_RB + 64 * MiB;
constexpr size_t WS_E = WS_RB + 114 * MiB;
constexpr size_t WS_YS = WS_RB + 148 * MiB;
constexpr size_t WS_SOUT = WS_RB + 180 * MiB;
constexpr size_t WS_END = 992 * MiB;
constexpr int CW_TMO = 0, CW_BAR = 4096, CW_CNT = 8192;

constexpr int RING_BYTES = 131072;
constexpr int MISC_OFF = 147456;
constexpr int LDS_BYTES = 155648;
constexpr int NWAVES = 8;

typedef __bf16 bf16x2_t __attribute__((ext_vector_type(2)));
__device__ __forceinline__ unsigned pk_bf16(float lo, float hi) { const bf16x2_t r = __builtin_convertvector((f32x2){lo, hi}, bf16x2_t); return __builtin_bit_cast(unsigned, r); }
__device__ __forceinline__ float bf_lo(unsigned u) { return __uint_as_float(u << 16); }
__device__ __forceinline__ float bf_hi(unsigned u) { return __uint_as_float(u & 0xffff0000u); }
__device__ __forceinline__ bf16 f2bf(float f) { unsigned u = __float_as_uint(f); return (bf16)((u + 0x7fffu + ((u >> 16) & 1u)) >> 16); }
__device__ __forceinline__ float bf2f(bf16 b) { return __uint_as_float(((unsigned)b) << 16); }
__device__ __forceinline__ float fsigmoid(float x) { return __builtin_amdgcn_rcpf(1.0f + __builtin_amdgcn_exp2f(-1.44269504f * x)); }
__device__ __forceinline__ void st16_bf16(bf16* dst, f32x4 a, f32x4 b, f32x4 c, f32x4 d) {
    u32x4 w0, w1; w0.x = pk_bf16(a[0], a[1]); w0.y = pk_bf16(a[2], a[3]); w0.z = pk_bf16(b[0], b[1]); w0.w = pk_bf16(b[2], b[3]);
    w1.x = pk_bf16(c[0], c[1]); w1.y = pk_bf16(c[2], c[3]); w1.z = pk_bf16(d[0], d[1]); w1.w = pk_bf16(d[2], d[3]);
    *(u32x4*)dst = w0; *(u32x4*)(dst + 8) = w1; }
__device__ __forceinline__ unsigned pk4_u8(float a, float b, float c, float d) {
    const unsigned ya = __builtin_bit_cast(unsigned, a * 255.0f + 8388608.0f), yb = __builtin_bit_cast(unsigned, b * 255.0f + 8388608.0f), yc = __builtin_bit_cast(unsigned, c * 255.0f + 8388608.0f), yd = __builtin_bit_cast(unsigned, d * 255.0f + 8388608.0f);
    const unsigned w01 = __builtin_amdgcn_perm(yb, ya, 0x0c0c0400u), w23 = __builtin_amdgcn_perm(yd, yc, 0x0c0c0400u);
    return __builtin_amdgcn_perm(w23, w01, 0x05040100u); }
__device__ __forceinline__ f32x4 u8x4_f32(unsigned w) { return (f32x4){(float)(w & 0xffu), (float)((w >> 8) & 0xffu), (float)((w >> 16) & 0xffu), (float)(w >> 24)}; }
__device__ __forceinline__ float gelu_tanh(float x) { return x * fsigmoid(1.5957691216f * (x + 0.044715f * x * x * x)); }
__device__ __forceinline__ float wave_sum(float v) {
#pragma unroll
    for (int o = 1; o < 64; o <<= 1) v += __shfl_xor(v, o);
    return v;
}
constexpr float W8_SCALE = 64.0f, W8_INV = 1.0f / 64.0f;
__device__ __forceinline__ float clamp8(float x) { return __builtin_amdgcn_fmed3f(x, -448.0f, 448.0f); }
__device__ __forceinline__ unsigned pk4_fp8(float a, float b, float c, float d) { int w = 0; w = __builtin_amdgcn_cvt_pk_fp8_f32(clamp8(a), clamp8(b), w, false); w = __builtin_amdgcn_cvt_pk_fp8_f32(clamp8(c), clamp8(d), w, true); return (unsigned)w; }
#define LDS_WAIT() asm volatile("s_waitcnt lgkmcnt(0)" ::: "memory")
#define VM_WAIT() asm volatile("s_waitcnt vmcnt(0)" ::: "memory")

#define XB_TMO      128
#define XB_XCNT(j)  (256  + 64 * (j))
#define XB_XSUB(j)  (1280 + 64 * (j))
#define XB_XGEN(j)  (2304 + 64 * (j))
#define XB_TOP      3328
#define XB_TOPGEN   3392
#define XCD_BAR_WORDS 3456
#define XB_SPIN_CAP (1u << 18)
__device__ __forceinline__ unsigned xb_ld(unsigned* p)              { return __hip_atomic_load(p, __ATOMIC_RELAXED, __HIP_MEMORY_SCOPE_AGENT); }
__device__ __forceinline__ unsigned xb_add(unsigned* p, unsigned v) { return __hip_atomic_fetch_add(p, v, __ATOMIC_RELAXED, __HIP_MEMORY_SCOPE_AGENT); }
__device__ __forceinline__ unsigned xb_xcc_id() { return (unsigned)__builtin_amdgcn_s_getreg((3 << 11) | 20) & 0xFu; }
#define XB_SPIN(cond, bar) do { unsigned _sp = 0; while (cond) { __builtin_amdgcn_s_sleep(1); \
    if ((++_sp & 255u) == 0u) { if (xb_ld(&(bar)[XB_TMO])) break; if (_sp > XB_SPIN_CAP) { atomicAdd(&(bar)[XB_TMO], 1u); break; } } } } while (0)
struct XcdBarrier { unsigned* bar; unsigned x; volatile LAS unsigned* st; };
__device__ __forceinline__ XcdBarrier xcd_barrier_post(unsigned* bar, volatile LAS unsigned* st) {
    XcdBarrier b; b.bar = bar; b.x = xb_xcc_id(); b.st = st;
    if (threadIdx.x == 0) (void)xb_add(&bar[XB_XCNT(b.x)], 1u);
    return b;
}
__device__ __forceinline__ void xcd_barrier_complete(unsigned* bar, unsigned x, unsigned& nloc, unsigned& nx) {
    const unsigned G = gridDim.x * gridDim.y * gridDim.z;
    unsigned sum, cnt, mine, sp = 0u;
    for (;;) {
        sum = 0u; cnt = 0u; mine = 0u;
#pragma unroll
        for (unsigned j = 0; j < 16; ++j) { const unsigned c = xb_ld(&bar[XB_XCNT(j)]); sum += c; cnt += (c > 0u) ? 1u : 0u; mine = (j == x) ? c : mine; }
        if (sum == G) break;
        __builtin_amdgcn_s_sleep(1);
        if ((++sp & 255u) == 0u) { if (xb_ld(&bar[XB_TMO])) break; if (sp > XB_SPIN_CAP) { atomicAdd(&bar[XB_TMO], 1u); break; } }
    }
    nloc = mine > 0u ? mine : 1u; nx = cnt > 0u ? cnt : 1u;
}
__device__ __forceinline__ void xcd_barrier(const XcdBarrier& b) {
    asm volatile("s_waitcnt vmcnt(0)" ::: "memory");
    __syncthreads();
    if (threadIdx.x == 0) {
        unsigned* bar = b.bar;
        __builtin_amdgcn_s_waitcnt(0);
        unsigned nloc = b.st[0], nx = b.st[1];
        if (nloc == 0u) { xcd_barrier_complete(bar, b.x, nloc, nx); b.st[0] = nloc; b.st[1] = nx; }
        const unsigned old = xb_add(&bar[XB_XSUB(b.x)], 1u);
        const unsigned gen = old / nloc;
        if (old + 1u == (gen + 1u) * nloc) {
            __builtin_amdgcn_fence(__ATOMIC_RELEASE, "agent");
            asm volatile("s_waitcnt vmcnt(0)" ::: "memory");
            const unsigned og = xb_add(&bar[XB_TOP], 1u);
            const unsigned tg = og / nx;
            if (og + 1u == (tg + 1u) * nx) xb_add(&bar[XB_TOPGEN], 1u);
            else XB_SPIN(xb_ld(&bar[XB_TOPGEN]) == tg, bar);
            __builtin_amdgcn_fence(__ATOMIC_ACQUIRE, "agent");
            xb_add(&bar[XB_XGEN(b.x)], 1u);
            asm volatile("s_waitcnt vmcnt(0)" ::: "memory");
        } else {
            XB_SPIN(xb_ld(&bar[XB_XGEN(b.x)]) == gen, bar);
            __builtin_amdgcn_fence(__ATOMIC_ACQUIRE, "agent");
            asm volatile("s_waitcnt vmcnt(0)" ::: "memory");
        }
    }
    __syncthreads();
}

namespace pg8 {
#define PG8_LAS __attribute__((address_space(3)))
constexpr int BM = 256, BK = 64, HALF = 128, HTB = HALF * BK * 2, STAGE_BYTES = 8 * HTB, NXCD = 8, WGM = 8;
__host__ __device__ __forceinline__ int lds_byte(int r, int c) { const int st = (r >> 4) * 2 + (c >> 5), rr = r & 15, cc = c & 31, ob = rr * 64 + cc * 2; return st * 1024 + (ob ^ (((ob >> 9) & 1) << 5)); }
__host__ __device__ __forceinline__ void stage_rc(int b, int& R, int& C) { const int st = b / 1024, sb = b % 1024, swz = sb ^ (((sb >> 9) & 1) << 5); R = (st >> 1) * 16 + swz / 64; C = (st & 1) * 32 + (swz % 64) / 2; }
__host__ __device__ __forceinline__ int perm32(int rho) { const int n = rho >> 4, i = rho & 15; return 8 * (i >> 2) + 4 * n + (i & 3); }

struct GUnit { const char* A; const char* B; int nt, x0, x1, x2, x3; };
template <class E, class = void> struct HasSeg { static constexpr bool v = false; };
template <class E> struct HasSeg<E, decltype((void)E::SEG2)> { static constexpr bool v = E::SEG2; };
template <class E, class = void> struct HasP16 { static constexpr bool v = false; };
template <class E> struct HasP16<E, decltype((void)E::PERM16)> { static constexpr bool v = E::PERM16; };

struct RectOrder {
    int nM, nN, nwg, G, c;
    __device__ __forceinline__ void init(int nM_, int nN_, int G_, int c_) { nM = nM_; nN = nN_; nwg = nM * nN; G = G_; c = c_; }
    __device__ __forceinline__ bool get(int i, int& pm, int& pn) const {
        const long L = (long)i * G + c; if (L >= nwg) return false;
        int wgid = (int)L; { const int q = nwg / NXCD, r = nwg % NXCD, xcd = wgid % NXCD, off = wgid / NXCD; wgid = (xcd < r ? xcd * (q + 1) : r * (q + 1) + (xcd - r) * q) + off; }
        const int nig = WGM * nN, gid = wgid / nig, fm = gid * WGM, gsz = (nM - fm) < WGM ? (nM - fm) : WGM;
        pm = fm + ((wgid % nig) % gsz); pn = (wgid % nig) / gsz; return true;
    }
};

template <class Epi, class Sched, bool ALIGN_EPI = true, bool F8 = false>
__device__ __forceinline__ void gemm_phase(PG8_LAS unsigned char* lds, const Sched& S, const Epi& E) {
    const int tid = threadIdx.x, wid = __builtin_amdgcn_readfirstlane(tid >> 6), lane = tid & 63, wr = wid >> 2, wc = wid & 3, fr = lane & 15, fq = lane >> 4;
    int Rs[2], Cs[2];
#pragma unroll
    for (int i = 0; i < 2; ++i) stage_rc(tid * 16 + i * 8192, Rs[i], Cs[i]);
    unsigned voffB[2][2], voffA[2][2], voffAn[2][2];
#pragma unroll
    for (int h = 0; h < 2; ++h)
#pragma unroll
        for (int i = 0; i < 2; ++i) {
            if constexpr (HasP16<Epi>::v) { const int r = Rs[i]; voffB[h][i] = S.b_off(64 * (r >> 5) + 16 * ((r & 15) >> 2) + 8 * h + 4 * ((r >> 4) & 1) + (r & 3), Cs[i]); }
            else { const int Rb = Epi::PERM ? ((Rs[i] & ~31) + perm32(Rs[i] & 31)) : Rs[i]; voffB[h][i] = S.b_off(h * HALF + Rb, Cs[i]); } }
    const size_t kstep = (size_t)(BK * 2);
    const unsigned ldsw = (unsigned)wid * 1024u;
    const int aoff = lds_byte(wr * 64 + fr, fq * 8), boff = lds_byte(wc * 32 + fr, fq * 8);
#define PG8_SA(b, h) (((b) * 2 + (h)) * HTB)
#define PG8_SB(b, h) ((4 + (b) * 2 + (h)) * HTB)
#define PG8_STAGE(bufoff, gbase, voff) do { _Pragma("unroll") for (int _i = 0; _i < 2; ++_i) \
        __builtin_amdgcn_global_load_lds((const unsigned*)((const char*)(gbase) + (voff)[_i]), (PG8_LAS unsigned*)(lds + (bufoff) + ldsw + _i * 8192), 16, 0, 0); } while (0)
#define PG8_LDA(dst, b, h) do { if constexpr (F8) { _Pragma("unroll") for (int m = 0; m < 4; ++m) dst##8[m] = __builtin_shufflevector(*(const PG8_LAS i32x4*)(lds + PG8_SA(b, h) + aoff + m * 2048), *(const PG8_LAS i32x4*)(lds + PG8_SA(b, h) + aoff + m * 2048 + 1024), 0, 1, 2, 3, 4, 5, 6, 7); } \
        else { _Pragma("unroll") for (int m = 0; m < 4; ++m) _Pragma("unroll") for (int k = 0; k < 2; ++k) dst[m][k] = *(const PG8_LAS bf16x8*)(lds + PG8_SA(b, h) + aoff + m * 2048 + k * 1024); } } while (0)
#define PG8_LDB(dst, b, h) do { if constexpr (F8) { _Pragma("unroll") for (int n = 0; n < 2; ++n) dst##8[n] = __builtin_shufflevector(*(const PG8_LAS i32x4*)(lds + PG8_SB(b, h) + boff + n * 2048), *(const PG8_LAS i32x4*)(lds + PG8_SB(b, h) + boff + n * 2048 + 1024), 0, 1, 2, 3, 4, 5, 6, 7); } \
        else { _Pragma("unroll") for (int n = 0; n < 2; ++n) _Pragma("unroll") for (int k = 0; k < 2; ++k) dst[n][k] = *(const PG8_LAS bf16x8*)(lds + PG8_SB(b, h) + boff + n * 2048 + k * 1024); } } while (0)
#define PG8_MMA(ai, bj, At, Bt) do { __builtin_amdgcn_s_setprio(1); _Pragma("unroll") for (int m = 0; m < 4; ++m) _Pragma("unroll") for (int n = 0; n < 2; ++n) { \
        if constexpr (F8) { asm volatile("v_mfma_scale_f32_16x16x128_f8f6f4 %0, %1, %2, %0, %3, %3 op_sel_hi:[0,0,0]" : "+v"(acc[ai][bj][m][n]) : "v"(Bt##8[n]), "v"(At##8[m]), "v"(f8scale)); } \
        else { _Pragma("unroll") for (int k = 0; k < 2; ++k) acc[ai][bj][m][n] = __builtin_amdgcn_mfma_f32_16x16x32_bf16(Bt[n][k], At[m][k], acc[ai][bj][m][n], 0, 0, 0); } } \
        if constexpr (F8) asm volatile("s_nop 3" ::: "memory");     \
        __builtin_amdgcn_s_setprio(0); } while (0)
#define PG8_WAIT_V(n) asm volatile("s_waitcnt vmcnt(" #n ")" ::: "memory")
#define PG8_WAIT_L(n) asm volatile("s_waitcnt lgkmcnt(" #n ")" ::: "memory")
#define PG8_BAR __builtin_amdgcn_s_barrier()
#define PG8_SCHED __builtin_amdgcn_sched_barrier(0)
    GUnit cur, nxt; int ui = 0;
    if (!S.next(0, cur)) return;
    S.a_off(cur, Rs, Cs, voffA);
#pragma unroll
    for (int h = 0; h < 2; ++h)
#pragma unroll
        for (int i = 0; i < 2; ++i) voffAn[h][i] = voffA[h][i];
    f32x4 acc[2][2][4][2];
#pragma unroll
    for (int a = 0; a < 2; ++a)
#pragma unroll
        for (int b = 0; b < 2; ++b)
#pragma unroll
            for (int m = 0; m < 4; ++m)
#pragma unroll
                for (int n = 0; n < 2; ++n) acc[a][b][m][n] = (f32x4){0.f, 0.f, 0.f, 0.f};
    bf16x8 At[4][2], B0[2][2], B1[2][2]; i32x8 At8[4], B08[2], B18[2];
    const int f8scale = 0x7F7F7F7F;
    const char* cA = cur.A; const char* cB = cur.B;
    PG8_STAGE(PG8_SB(0, 0), cB, voffB[0]); PG8_STAGE(PG8_SB(0, 1), cB, voffB[1]); PG8_STAGE(PG8_SA(0, 0), cA, voffA[0]); PG8_STAGE(PG8_SA(0, 1), cA, voffA[1]);
    if (wr == 1) PG8_BAR;
    PG8_WAIT_V(2); PG8_BAR;
    PG8_STAGE(PG8_SB(1, 0), cB + kstep, voffB[0]); PG8_STAGE(PG8_SA(1, 0), cA + kstep, voffA[0]); PG8_STAGE(PG8_SB(1, 1), cB + kstep, voffB[1]);
    PG8_WAIT_V(6); PG8_BAR;
    for (;;) {
        const bool has_next = S.next(ui + 1, nxt);
        const char* nA = has_next ? nxt.A : cA; const char* nB = has_next ? nxt.B : cB;
        const int nt = cur.nt;
#pragma unroll 1
        for (int t = 0; t < nt; t += 2) {
            const bool last = (t == nt - 2);
            if constexpr (Sched::GATHER) { if (last && has_next) S.a_off(nxt, Rs, Cs, voffAn); }
            const char* a1 = cA + (size_t)(t + 1) * kstep;
            const char* a2 = last ? nA : cA + (size_t)(t + 2) * kstep; const char* b2 = last ? nB : cB + (size_t)(t + 2) * kstep;
            const char* a3 = a2 + kstep; const char* b3 = b2 + kstep;
            unsigned vA2[2][2];
#pragma unroll
            for (int h = 0; h < 2; ++h)
#pragma unroll
                for (int i = 0; i < 2; ++i) { if constexpr (Sched::GATHER) vA2[h][i] = (last && has_next) ? voffAn[h][i] : voffA[h][i]; else vA2[h][i] = voffA[h][i]; }
            PG8_LDB(B0, 0, 0); PG8_LDB(B1, 0, 1); PG8_SCHED; PG8_LDA(At, 0, 0); PG8_STAGE(PG8_SA(1, 1), a1, voffA[1]);
            PG8_WAIT_V(8); PG8_WAIT_L(0); PG8_BAR; PG8_MMA(0, 0, At, B0); PG8_MMA(0, 1, At, B1); PG8_BAR; PG8_SCHED;
            PG8_LDA(At, 0, 1); PG8_STAGE(PG8_SB(0, 0), b2, voffB[0]); PG8_STAGE(PG8_SB(0, 1), b2, voffB[1]); PG8_STAGE(PG8_SA(0, 0), a2, vA2[0]);
            PG8_WAIT_V(8); PG8_WAIT_L(0); PG8_BAR; PG8_MMA(1, 0, At, B0); PG8_MMA(1, 1, At, B1); PG8_BAR; PG8_SCHED;
            PG8_LDB(B0, 1, 0); PG8_LDB(B1, 1, 1); PG8_SCHED; PG8_LDA(At, 1, 0); PG8_STAGE(PG8_SA(0, 1), a2, vA2[1]);
            PG8_WAIT_V(8); PG8_WAIT_L(0); PG8_BAR; PG8_MMA(0, 0, At, B0); PG8_MMA(0, 1, At, B1); PG8_BAR; PG8_SCHED;
            PG8_LDA(At, 1, 1); PG8_STAGE(PG8_SB(1, 0), b3, voffB[0]); PG8_STAGE(PG8_SB(1, 1), b3, voffB[1]); PG8_STAGE(PG8_SA(1, 0), a3, vA2[0]);
            PG8_WAIT_V(8); PG8_WAIT_L(0); PG8_BAR; PG8_MMA(1, 0, At, B0); PG8_MMA(1, 1, At, B1); PG8_BAR; PG8_SCHED;
        }
        if constexpr (ALIGN_EPI) { if (wr == 0) PG8_BAR; }
        if constexpr (F8) {
#pragma unroll
            for (int a = 0; a < 2; ++a)
#pragma unroll
                for (int b = 0; b < 2; ++b)
                    asm volatile("s_nop 15\n\ts_nop 7" : "+v"(acc[a][b][0][0]), "+v"(acc[a][b][0][1]), "+v"(acc[a][b][1][0]), "+v"(acc[a][b][1][1]), "+v"(acc[a][b][2][0]), "+v"(acc[a][b][2][1]), "+v"(acc[a][b][3][0]), "+v"(acc[a][b][3][1]));
        }
        E(acc, cur, wr, wc, fr, fq);
        if (!has_next) break;
        if (!(HasSeg<Epi>::v && cur.x2 == 0)) {
#pragma unroll
        for (int a = 0; a < 2; ++a)
#pragma unroll
            for (int b = 0; b < 2; ++b)
#pragma unroll
                for (int m = 0; m < 4; ++m)
#pragma unroll
                    for (int n = 0; n < 2; ++n) acc[a][b][m][n] = (f32x4){0.f, 0.f, 0.f, 0.f};
        }
        cur = nxt; cA = nA; cB = nB; ++ui;
#pragma unroll
        for (int h = 0; h < 2; ++h)
#pragma unroll
            for (int i = 0; i < 2; ++i) voffA[h][i] = voffAn[h][i];
        if constexpr (ALIGN_EPI) { if (wr == 1) PG8_BAR; }
    }
    PG8_WAIT_V(0);
    if constexpr (!ALIGN_EPI) { if (wr == 0) PG8_BAR; }
    PG8_BAR;
#undef PG8_SA
#undef PG8_SB
#undef PG8_STAGE
#undef PG8_LDA
#undef PG8_LDB
#undef PG8_MMA
#undef PG8_WAIT_V
#undef PG8_WAIT_L
#undef PG8_BAR
#undef PG8_SCHED
}
}
using pg8::GUnit;
typedef const f32x4 (&AccRef)[2][2][4][2];


struct SchedRect {
    static constexpr bool GATHER = false;
    pg8::RectOrder o; const char* A; const char* B; int lda, ldb, nt;
    __device__ __forceinline__ bool next(int i, GUnit& u) const { int pm, pn; if (!o.get(i, pm, pn)) return false;
        u.A = A + (size_t)pm * 256 * lda * 2; u.B = B + (size_t)pn * 256 * ldb * 2; u.nt = nt; u.x0 = pm; u.x1 = pn; u.x2 = 0; u.x3 = 0; return true; }
    __device__ __forceinline__ unsigned b_off(int R, int C) const { return (unsigned)(R * ldb + C) * 2u; }
    __device__ __forceinline__ void a_off(const GUnit&, const int (&R)[2], const int (&C)[2], unsigned (&v)[2][2]) const {
#pragma unroll
        for (int h = 0; h < 2; ++h)
#pragma unroll
            for (int i = 0; i < 2; ++i) v[h][i] = (unsigned)((h * 128 + R[i]) * lda + C[i]) * 2u; }
};
struct SchedRectOff {
    static constexpr bool GATHER = false;
    pg8::RectOrder o; const char* A; const char* B; int lda, ldb, nt, pn0;
    __device__ __forceinline__ bool next(int i, GUnit& u) const { int pm, pn; if (!o.get(i, pm, pn)) return false;
        u.A = A + (size_t)pm * 256 * lda * 2; u.B = B + (size_t)pn * 256 * ldb * 2; u.nt = nt; u.x0 = pm; u.x1 = pn + pn0; u.x2 = 0; u.x3 = 0; return true; }
    __device__ __forceinline__ unsigned b_off(int R, int C) const { return (unsigned)(R * ldb + C) * 2u; }
    __device__ __forceinline__ void a_off(const GUnit&, const int (&R)[2], const int (&C)[2], unsigned (&v)[2][2]) const {
#pragma unroll
        for (int h = 0; h < 2; ++h)
#pragma unroll
            for (int i = 0; i < 2; ++i) v[h][i] = (unsigned)((h * 128 + R[i]) * lda + C[i]) * 2u; }
};
struct SchedMerge {
    static constexpr bool GATHER = false; static constexpr int PITCH = SW + FW;
    pg8::RectOrder o; const char* A; const char* B;
    __device__ __forceinline__ bool next(int i, GUnit& u) const { int pm, pn; if (!o.get(i >> 1, pm, pn)) return false; const int seg = i & 1;
        u.A = A + (size_t)pm * 256 * PITCH + seg * SW; u.B = B + (size_t)pn * 256 * PITCH + seg * SW; u.nt = seg ? FW / 128 : SW / 128; u.x0 = pm; u.x1 = pn; u.x2 = seg; u.x3 = 0; return true; }
    __device__ __forceinline__ unsigned b_off(int R, int C) const { return (unsigned)(R * PITCH + C * 2); }
    __device__ __forceinline__ void a_off(const GUnit&, const int (&R)[2], const int (&C)[2], unsigned (&v)[2][2]) const {
#pragma unroll
        for (int h = 0; h < 2; ++h)
#pragma unroll
            for (int i = 0; i < 2; ++i) v[h][i] = (unsigned)((h * 128 + R[i]) * PITCH + C[i] * 2); }
};
struct SchedE {
    static constexpr bool GATHER = false;
    int G, c; const char* A2; const char* WeT;
    __device__ __forceinline__ bool next(int i, GUnit& u) const { const int L = i * G + c; if (L >= 128) return false; const int g = L >> 2, b = L & 3;
        u.A = A2 + ((size_t)((g * 4 + b) * NCH + NCTXCH) * A2LD) * 2; u.B = WeT + (size_t)g * 256 * 512 * 2; u.nt = 8; u.x0 = g; u.x1 = b; u.x2 = 0; u.x3 = 0; return true; }
    __device__ __forceinline__ unsigned b_off(int R, int C) const { return (unsigned)(R * 512 + C) * 2u; }
    __device__ __forceinline__ void a_off(const GUnit&, const int (&R)[2], const int (&C)[2], unsigned (&v)[2][2]) const {
#pragma unroll
        for (int h = 0; h < 2; ++h)
#pragma unroll
            for (int i = 0; i < 2; ++i) v[h][i] = (unsigned)((h * 128 + R[i]) * A2LD + C[i]) * 2u; }
};
struct SchedSSM {
    static constexpr bool GATHER = false;
    int G, c; const char* A2; const char* TV;
    __device__ __forceinline__ bool next(int i, GUnit& u) const { const int L = i * G + c; if (L >= 256) return false; const int g = L >> 3, b = (L >> 1) & 3, pn = L & 1;
        u.A = A2 + ((size_t)((g * 4 + b) * NCH + NCTXCH) * A2LD) * 2; u.B = TV + ((size_t)(g * 512 + pn * 256) * A2LD) * 2; u.nt = 12; u.x0 = g; u.x1 = b; u.x2 = pn; u.x3 = 0; return true; }
    __device__ __forceinline__ unsigned b_off(int R, int C) const { return (unsigned)(R * A2LD + C) * 2u; }
    __device__ __forceinline__ void a_off(const GUnit&, const int (&R)[2], const int (&C)[2], unsigned (&v)[2][2]) const {
#pragma unroll
        for (int h = 0; h < 2; ++h)
#pragma unroll
            for (int i = 0; i < 2; ++i) v[h][i] = (unsigned)((h * 128 + R[i]) * A2LD + C[i]) * 2u; }
};
struct SchedF1 {
    static constexpr bool GATHER = false;
    int G, c; const char* FkT; const char* UF;
    __device__ __forceinline__ bool next(int i, GUnit& u) const { const int L = i * G + c; if (L >= 1024) return false; const int pn = L >> 1, pm = L & 1;
        u.A = FkT + (size_t)pm * 256 * 256 * 2; u.B = UF + (size_t)pn * 64 * FW * 2; u.nt = 4; u.x0 = pm; u.x1 = pn; u.x2 = 0; u.x3 = 0; return true; }
    __device__ __forceinline__ unsigned b_off(int R, int C) const { const int g = R >> 6, cc = R & 63; return (unsigned)(cc * FW + g * 256 + C) * 2u; }
    __device__ __forceinline__ void a_off(const GUnit&, const int (&R)[2], const int (&C)[2], unsigned (&v)[2][2]) const {
#pragma unroll
        for (int h = 0; h < 2; ++h)
#pragma unroll
            for (int i = 0; i < 2; ++i) v[h][i] = (unsigned)((h * 128 + R[i]) * 256 + C[i]) * 2u; }
};
struct SchedF2 {
    static constexpr bool GATHER = false;
    int G, c; const char* FcT; const char* Z1T;
    __device__ __forceinline__ bool next(int i, GUnit& u) const { const int L = i * G + c; if (L >= 2048) return false; const int b = L >> 9, g = (L >> 7) & 3, kp = L & 127;
        u.A = FcT; u.B = Z1T + ((size_t)((b * 128) * 4 + g) * 256 + 2 * kp) * 128 * 2; u.nt = 2; u.x0 = b; u.x1 = g; u.x2 = 2 * kp; u.x3 = 0; return true; }
    __device__ __forceinline__ unsigned b_off(int R, int C) const { const int dk = R >> 7, r = R & 127; return (unsigned)(r * (4 * 256 * 128) + dk * 128 + C) * 2u; }
    __device__ __forceinline__ void a_off(const GUnit&, const int (&R)[2], const int (&C)[2], unsigned (&v)[2][2]) const {
#pragma unroll
        for (int h = 0; h < 2; ++h)
#pragma unroll
            for (int i = 0; i < 2; ++i) v[h][i] = (unsigned)((h * 128 + R[i]) * 128 + C[i]) * 2u; }
};
struct SchedF3 {
    static constexpr bool GATHER = false;
    int G, c; const char* FrT; const char* Z2T;
    __device__ __forceinline__ bool next(int i, GUnit& u) const { const int L = i * G + c; if (L >= 1024) return false; const int b = L >> 8, cp = (L >> 2) & 63, g = L & 3;
        u.A = FrT; u.B = Z2T + ((size_t)((b * 4 + g) * 256) * 64 + cp) * 256 * 2; u.nt = 4; u.x0 = b; u.x1 = cp; u.x2 = g; u.x3 = 0; return true; }
    __device__ __forceinline__ unsigned b_off(int R, int C) const { return (unsigned)(R * (64 * 256) + C) * 2u; }
    __device__ __forceinline__ void a_off(const GUnit&, const int (&R)[2], const int (&C)[2], unsigned (&v)[2][2]) const {
#pragma unroll
        for (int h = 0; h < 2; ++h)
#pragma unroll
            for (int i = 0; i < 2; ++i) v[h][i] = (unsigned)((h * 128 + R[i]) * 256 + C[i]) * 2u; }
};
template <int SHIFT, int PA, int PB, int NT> struct SchedMoe {
    static constexpr bool GATHER = true;
    int G, c; const char* Abase; const char* Bbase; const int* rowlist; const LAS int* pre; const LAS int* cnt;
    __device__ __forceinline__ bool next(int i, GUnit& u) const { const int L = i * G + c; const int ti = L >> 3, ct = L & 7; if (ti >= __builtin_amdgcn_readfirstlane(pre[NE])) return false;
        int e = 0;
#pragma unroll 1
        for (int s = 16; s >= 1; s >>= 1) if (pre[e + s] <= ti) e += s;
        e = __builtin_amdgcn_readfirstlane(e);
        u.A = Abase; u.B = Bbase + (size_t)(e * 2048 + ct * 256) * PB; u.nt = NT; u.x0 = e; u.x1 = ti - __builtin_amdgcn_readfirstlane(pre[e]); u.x2 = ct; u.x3 = __builtin_amdgcn_readfirstlane(cnt[e]); return true; }
    __device__ __forceinline__ unsigned b_off(int R, int C) const { return (unsigned)(R * PB + C * 2); }
    __device__ __forceinline__ void a_off(const GUnit& u, const int (&R)[2], const int (&C)[2], unsigned (&v)[2][2]) const {
        const int* rl = rowlist + (size_t)u.x0 * ECAP; const int base = u.x1 * 256, cm = u.x3 - 1;
#pragma unroll
        for (int h = 0; h < 2; ++h)
#pragma unroll
            for (int i = 0; i < 2; ++i) { int p = base + h * 128 + R[i]; p = p < cm ? p : cm; const unsigned ent = (unsigned)rl[p]; v[h][i] = (ent >> SHIFT) * (unsigned)PA + (unsigned)C[i] * 2u; } }
};

template <bool S8> struct EpiInProjT {
    static constexpr bool PERM = true, PERM16 = true;
    bf16* UF; bf16* A2; bf16* GZF; bf16* GZS;
    __device__ __forceinline__ void operator()(AccRef acc, const GUnit& u, int wr, int wc, int fr, int fq) const {
        const int pm = u.x0, pn = u.x1; const int col = pn * 256 + wc * 64 + 16 * fq;
#pragma unroll
        for (int ai = 0; ai < 2; ++ai)
#pragma unroll
            for (int m = 0; m < 4; ++m) { const int row = pm * 256 + ai * 128 + wr * 64 + m * 16 + fr; bf16* dst;
                if (pn < 4) dst = UF + (size_t)row * FW + col;
                else { const int g = (col - FW) >> 4, b = row >> 13, t = row & (SEQ - 1); dst = A2 + ((size_t)((g * 4 + b) * NCH + NCTXCH + (t >> 5)) * A2LD + (t & 31) * 16); }
                constexpr float SC = S8 ? W8_INV : 1.0f; st16_bf16(dst, acc[ai][0][m][0] * SC, acc[ai][0][m][1] * SC, acc[ai][1][m][0] * SC, acc[ai][1][m][1] * SC); }
    }
};
typedef EpiInProjT<false> EpiInProj;
struct EpiGates8 {
    static constexpr bool PERM = true, PERM16 = true;
    unsigned char* GZF; unsigned char* GZS;
    __device__ __forceinline__ void operator()(AccRef acc, const GUnit& u, int wr, int wc, int fr, int fq) const {
        const int pm = u.x0, pn = u.x1; unsigned char* base = (pn < 8 ? GZF : GZS) + (size_t)(pm * 256 + wr * 64 + fr) * D + (pn & 7) * 256 + wc * 64 + 16 * fq;
#pragma unroll
        for (int ai = 0; ai < 2; ++ai)
#pragma unroll
            for (int m = 0; m < 4; ++m) { u32x4 w;
#pragma unroll
                for (int bj = 0; bj < 2; ++bj)
#pragma unroll
                    for (int n = 0; n < 2; ++n) { const f32x4 v = acc[ai][bj][m][n]; w[bj * 2 + n] = pk4_u8(fsigmoid(v[0] * W8_INV), fsigmoid(v[1] * W8_INV), fsigmoid(v[2] * W8_INV), fsigmoid(v[3] * W8_INV)); }
                *(u32x4*)(base + (size_t)(ai * 128 + m * 16) * D) = w; }
    }
};
struct EpiE {
    static constexpr bool PERM = false;
    float* E;
    __device__ __forceinline__ void operator()(AccRef acc, const GUnit& u, int wr, int wc, int fr, int fq) const {
        float* base = E + (size_t)((u.x0 * 4 + u.x1) * NCH + NCTXCH) * 256;
#pragma unroll
        for (int ai = 0; ai < 2; ++ai)
#pragma unroll
            for (int m = 0; m < 4; ++m) { float* rowp = base + (size_t)(ai * 128 + wr * 64 + m * 16 + fr) * 256 + wc * 32 + 4 * fq;
#pragma unroll
                for (int bj = 0; bj < 2; ++bj)
#pragma unroll
                    for (int n = 0; n < 2; ++n) *(f32x4*)(rowp + bj * 128 + n * 16) = acc[ai][bj][m][n]; }
    }
};
struct EpiSSM {
    static constexpr bool PERM = true, PERM16 = true;
    bf16* YS;
    __device__ __forceinline__ void operator()(AccRef acc, const GUnit& u, int wr, int wc, int fr, int fq) const {
        const int g = u.x0, b = u.x1, pn = u.x2; const int tt = (pn * 256 + wc * 64 + 16 * fq) >> 4;
#pragma unroll
        for (int ai = 0; ai < 2; ++ai)
#pragma unroll
            for (int m = 0; m < 4; ++m) { const int ch = ai * 128 + wr * 64 + m * 16 + fr; const size_t tok = (size_t)b * SEQ + ch * LC + tt;
                f32x4 v0 = acc[ai][0][m][0], v1 = acc[ai][0][m][1], v2 = acc[ai][1][m][0], v3 = acc[ai][1][m][1];
#pragma unroll
                for (int j = 0; j < 4; ++j) { v0[j] = gelu_tanh(v0[j]); v1[j] = gelu_tanh(v1[j]); v2[j] = gelu_tanh(v2[j]); v3[j] = gelu_tanh(v3[j]); }
                st16_bf16(YS + tok * SW + g * 16, v0, v1, v2, v3); }
    }
};
constexpr float S8_SCALE = 16.0f, S8_INV = 1.0f / 16.0f;
template <int MODE> struct EpiGate {
    static constexpr bool PERM = true, PERM16 = true; static constexpr float ASC = MODE == 0 ? W8_INV / 255.0f : (MODE == 1 ? W8_INV * S8_INV / 255.0f : 1.0f);
    bf16* O; const void* G0; const float* bias; int ld; unsigned char* O8; int ldo;
    __device__ __forceinline__ void operator()(AccRef acc, const GUnit& u, int wr, int wc, int fr, int fq) const {
        const int pm = u.x0, pn = u.x1;
        const size_t off0 = (size_t)(pm * 256 + wr * 64 + fr) * ld + pn * 256 + wc * 64 + 16 * fq;
        f32x4 bv[2][2];
        if (MODE == 2) {
#pragma unroll
            for (int q = 0; q < 4; ++q) bv[q >> 1][q & 1] = *(const f32x4*)(bias + pn * 256 + wc * 64 + 16 * fq + 4 * q); }
#pragma unroll
        for (int ai = 0; ai < 2; ++ai) {
            u32x4 gq[4], yq[4][2], oq[4][2];
#pragma unroll
            for (int m = 0; m < 4; ++m) { const size_t off = off0 + (size_t)(ai * 128 + m * 16) * ld;
                if (MODE == 2) { yq[m][0] = *(const u32x4*)((const bf16*)G0 + off); yq[m][1] = *(const u32x4*)((const bf16*)G0 + off + 8); }
                else gq[m] = __builtin_nontemporal_load((const u32x4*)((const unsigned char*)G0 + off));
                if (MODE == 1) { oq[m][0] = *(const u32x4*)(O + off); oq[m][1] = *(const u32x4*)(O + off + 8); } }
#pragma unroll
            for (int m = 0; m < 4; ++m) { const size_t off = off0 + (size_t)(ai * 128 + m * 16) * ld;
                f32x4 v[2][2];
#pragma unroll
                for (int bj = 0; bj < 2; ++bj)
#pragma unroll
                    for (int n = 0; n < 2; ++n) { const int q = bj * 2 + n; const f32x4 a = acc[ai][bj][m][n];
                        if (MODE == 2) { const unsigned lo = yq[m][bj][2 * n], hi = yq[m][bj][2 * n + 1]; const f32x4 y = (f32x4){bf_lo(lo), bf_hi(lo), bf_lo(hi), bf_hi(hi)};
#pragma unroll
                            for (int j = 0; j < 4; ++j) v[bj][n][j] = y[j] * fsigmoid(a[j] + bv[bj][n][j]) * S8_SCALE; }
                        else { const f32x4 g = u8x4_f32(gq[m][q]);
                            if (MODE == 0) v[bj][n] = a * g * ASC;
                            else { const unsigned lo = oq[m][bj][2 * n], hi = oq[m][bj][2 * n + 1]; v[bj][n] = (f32x4){bf_lo(lo), bf_hi(lo), bf_lo(hi), bf_hi(hi)} + a * g * ASC; } } }
                if (MODE == 0) {
#pragma unroll
                    for (int bj = 0; bj < 2; ++bj) { u32x4 w; w.x = pk_bf16(v[bj][0][0], v[bj][0][1]); w.y = pk_bf16(v[bj][0][2], v[bj][0][3]); w.z = pk_bf16(v[bj][1][0], v[bj][1][1]); w.w = pk_bf16(v[bj][1][2], v[bj][1][3]); *(u32x4*)(O + off + 8 * bj) = w; } }
                else { u32x4 w;
#pragma unroll
                    for (int q = 0; q < 4; ++q) w[q] = pk4_fp8(v[q >> 1][q & 1][0], v[q >> 1][q & 1][1], v[q >> 1][q & 1][2], v[q >> 1][q & 1][3]);
                    const size_t offo = MODE == 2 ? (size_t)(pm * 256 + wr * 64 + fr + ai * 128 + m * 16) * ldo + pn * 256 + wc * 64 + 16 * fq : off;
                    *(u32x4*)(O8 + offo) = w; } }
            asm volatile("" ::: "memory");
        }
    }
};
struct EpiMerge {
    static constexpr bool PERM = true, PERM16 = true, SEG2 = true;
    unsigned char* M8; const unsigned char* GZF; const unsigned char* GZS;
    __device__ __forceinline__ void operator()(f32x4 (&acc)[2][2][4][2], const GUnit& u, int wr, int wc, int fr, int fq) const {
        const size_t off0 = (size_t)(u.x0 * 256 + wr * 64 + fr) * D + u.x1 * 256 + wc * 64 + 16 * fq;
        if (u.x2 == 0) {
#pragma unroll
            for (int ai = 0; ai < 2; ++ai) {
                u32x4 qs[4], qf[4];
#pragma unroll
                for (int m = 0; m < 4; ++m) { const size_t off = off0 + (size_t)(ai * 128 + m * 16) * D; qs[m] = __builtin_nontemporal_load((const u32x4*)(GZS + off)); qf[m] = *(const u32x4*)(GZF + off); }
#pragma unroll
                for (int m = 0; m < 4; ++m)
#pragma unroll
                    for (int q = 0; q < 4; ++q) { const f32x4 s = u8x4_f32(qs[m][q]), f = u8x4_f32(qf[m][q]); f32x4 r;
#pragma unroll
                        for (int j = 0; j < 4; ++j) r[j] = s[j] * S8_INV * __builtin_amdgcn_rcpf(fmaxf(f[j], 0.5f));
                        acc[ai][q >> 1][m][q & 1] *= r; }
                asm volatile("" ::: "memory");
            }
            return;
        }
#pragma unroll
        for (int ai = 0; ai < 2; ++ai) {
            u32x4 qf[4];
#pragma unroll
            for (int m = 0; m < 4; ++m) qf[m] = __builtin_nontemporal_load((const u32x4*)(GZF + off0 + (size_t)(ai * 128 + m * 16) * D));
#pragma unroll
            for (int m = 0; m < 4; ++m) { u32x4 w;
#pragma unroll
                for (int q = 0; q < 4; ++q) { const f32x4 f = u8x4_f32(qf[m][q]); const f32x4 a = acc[ai][q >> 1][m][q & 1]; f32x4 v;
#pragma unroll
                    for (int j = 0; j < 4; ++j) v[j] = a[j] * (fmaxf(f[j], 0.5f) * (W8_INV / 255.0f));
                    w[q] = pk4_fp8(v[0], v[1], v[2], v[3]); }
                *(u32x4*)(M8 + off0 + (size_t)(ai * 128 + m * 16) * D) = w; }
            asm volatile("" ::: "memory");
        }
    }
};
struct EpiOut {
    static constexpr bool PERM = true, PERM16 = true;
    const float* modv; bf16* MG;
    __device__ __forceinline__ void operator()(AccRef acc, const GUnit& u, int wr, int wc, int fr, int fq) const {
        const int pm = u.x0, pn = u.x1; const float* gate = modv + (size_t)(pm >> 5) * 12288 + 2 * D;
        const int col0 = pn * 256 + wc * 64 + 16 * fq;
        const f32x4 gv0 = *(const f32x4*)(gate + col0) * W8_INV, gv1 = *(const f32x4*)(gate + col0 + 4) * W8_INV, gv2 = *(const f32x4*)(gate + col0 + 8) * W8_INV, gv3 = *(const f32x4*)(gate + col0 + 12) * W8_INV;
#pragma unroll
        for (int ai = 0; ai < 2; ++ai)
#pragma unroll
            for (int m = 0; m < 4; ++m) { bf16* rowp = MG + (size_t)(pm * 256 + ai * 128 + wr * 64 + m * 16 + fr) * D + col0;
                st16_bf16(rowp, acc[ai][0][m][0] * gv0, acc[ai][0][m][1] * gv1, acc[ai][1][m][0] * gv2, acc[ai][1][m][1] * gv3); }
    }
};
struct EpiF1 {
    static constexpr bool PERM = true, PERM16 = true;
    bf16* Z1T;
    __device__ __forceinline__ void operator()(AccRef acc, const GUnit& u, int wr, int wc, int fr, int fq) const {
        const int reim = u.x0, br = u.x1;
#pragma unroll
        for (int ai = 0; ai < 2; ++ai)
#pragma unroll
            for (int m = 0; m < 4; ++m) { const int kp = ai * 128 + wr * 64 + m * 16 + fr;
                st16_bf16(Z1T + ((((size_t)br * 4 + wc) * 256 + kp) * 2 + reim) * 64 + 16 * fq, acc[ai][0][m][0], acc[ai][0][m][1], acc[ai][1][m][0], acc[ai][1][m][1]); }
    }
};
struct EpiF2 {
    static constexpr bool PERM = true, PERM16 = true;
    bf16* Z2T;
    __device__ __forceinline__ void operator()(AccRef acc, const GUnit& u, int wr, int wc, int fr, int fq) const {
        const int b = u.x0, g = u.x1, k0 = u.x2; const int kp = k0 + (wc >> 1), r0 = (wc & 1) * 64 + 16 * fq;
#pragma unroll
        for (int m = 0; m < 4; ++m) { const int mm = wr * 64 + m * 16 + fr, reim = mm >> 6, cp = mm & 63;
            st16_bf16(Z2T + (((((size_t)b * 4 + g) * 256 + kp) * 64 + cp) * 2 + reim) * 128 + r0, acc[0][0][m][0], acc[0][0][m][1], acc[0][1][m][0], acc[0][1][m][1]); }
    }
};
struct EpiF3 {
    static constexpr bool PERM = true, PERM16 = true;
    unsigned char* FO;
    __device__ __forceinline__ void operator()(AccRef acc, const GUnit& u, int wr, int wc, int fr, int fq) const {
        const int b = u.x0, cp = u.x1, g = u.x2;
#pragma unroll
        for (int m = 0; m < 4; ++m) { const int rr = wr * 64 + m * 16 + fr; const size_t tok = (size_t)b * SEQ + rr * 64 + cp; u32x4 w;
#pragma unroll
            for (int q = 0; q < 4; ++q) { const f32x4 v = acc[0][q >> 1][m][q & 1]; w[q] = pk4_fp8(v[0], v[1], v[2], v[3]); }
            *(u32x4*)(FO + tok * (SW + FW) + SW + g * 256 + wc * 64 + 16 * fq) = w; }
    }
};
struct EpiMoe1 {
    static constexpr bool PERM = true;
    unsigned char* HID; const int* rowlist;
    __device__ __forceinline__ void operator()(AccRef acc, const GUnit& u, int wr, int wc, int fr, int fq) const {
        const int e = u.x0, rt = u.x1, ct = u.x2, cnt = u.x3; const int* rl = rowlist + (size_t)e * ECAP; const int p0 = rt * 256 + wr * 64 + fr;
        const int odd = fq & 1;
        unsigned ent[2][2];
#pragma unroll
        for (int ai = 0; ai < 2; ++ai)
#pragma unroll
            for (int h = 0; h < 2; ++h) { int p = p0 + ai * 128 + (2 * h + odd) * 16; p = p < cnt ? p : cnt - 1; ent[ai][h] = (unsigned)rl[p]; }
#pragma unroll
        for (int ai = 0; ai < 2; ++ai)
#pragma unroll
            for (int mp = 0; mp < 4; mp += 2) {
                f32x4 v0, v1, w0, w1;
#pragma unroll
                for (int j = 0; j < 4; ++j) { const float a0 = acc[ai][0][mp][0][j] * W8_INV, a1 = acc[ai][0][mp][1][j] * W8_INV; v0[j] = a0 * fsigmoid(a0) * (acc[ai][1][mp][0][j] * W8_INV); v1[j] = a1 * fsigmoid(a1) * (acc[ai][1][mp][1][j] * W8_INV); }
#pragma unroll
                for (int j = 0; j < 4; ++j) { const float a0 = acc[ai][0][mp + 1][0][j] * W8_INV, a1 = acc[ai][0][mp + 1][1][j] * W8_INV; w0[j] = a0 * fsigmoid(a0) * (acc[ai][1][mp + 1][0][j] * W8_INV); w1[j] = a1 * fsigmoid(a1) * (acc[ai][1][mp + 1][1][j] * W8_INV); }
                const unsigned lo0 = pk4_fp8(v0[0], v0[1], v0[2], v0[3]), hi0 = pk4_fp8(v1[0], v1[1], v1[2], v1[3]), lo1 = pk4_fp8(w0[0], w0[1], w0[2], w0[3]), hi1 = pk4_fp8(w1[0], w1[1], w1[2], w1[3]);
                const auto sl = __builtin_amdgcn_permlane16_swap(lo0, lo1, false, false), sh = __builtin_amdgcn_permlane16_swap(hi0, hi1, false, false);
                const int p = p0 + ai * 128 + (mp + odd) * 16; const unsigned en = ent[ai][mp >> 1];
                if (p < cnt) *(u32x4*)(HID + (size_t)en * DE + ct * 128 + wc * 32 + 16 * (fq >> 1)) = (u32x4){sl[0], sh[0], sl[1], sh[1]}; }
    }
};
constexpr float Y8_SCALE = 16.0f, Y8_INV = 1.0f / 16.0f;
struct EpiMoe2 {
    static constexpr bool PERM = true, PERM16 = true;
    unsigned char* Y; const int* rowlist;
    __device__ __forceinline__ void operator()(AccRef acc, const GUnit& u, int wr, int wc, int fr, int fq) const {
        const int e = u.x0, rt = u.x1, ct = u.x2, cnt = u.x3; const int* rl = rowlist + (size_t)e * ECAP; const int p0 = rt * 256 + wr * 64 + fr;
        unsigned ent[2][4];
#pragma unroll
        for (int ai = 0; ai < 2; ++ai)
#pragma unroll
            for (int m = 0; m < 4; ++m) { int p = p0 + ai * 128 + m * 16; p = p < cnt ? p : cnt - 1; ent[ai][m] = (unsigned)rl[p]; }
#pragma unroll
        for (int ai = 0; ai < 2; ++ai)
#pragma unroll
            for (int m = 0; m < 4; ++m) { const int p = p0 + ai * 128 + m * 16;
                if (p < cnt) { u32x4 w;
#pragma unroll
                    for (int q = 0; q < 4; ++q) { const f32x4 v = acc[ai][q >> 1][m][q & 1] * (W8_INV * Y8_SCALE); w[q] = pk4_fp8(v[0], v[1], v[2], v[3]); }
                    *(u32x4*)(Y + (size_t)ent[ai][m] * D + ct * 256 + wc * 64 + 16 * fq) = w; } }
    }
};

enum { IX = 0, IC, ICTX, ICCTX, IWADA, IBADA, IWIN, IWF, ILAMRE, ILAMIM, ILOGDT, IBRE, IBIM, ICRE, ICIM, IDSKIP, IWGLU, IBGLU, IWS, IWOUT, ILN1G, ILN1B, IWGRP, IBGRP, IWEXP, IBEXP, IW1, IW3, IW2, ILN2G, ILN2B, NIN };
struct Args { const float* in[NIN]; float* out; unsigned char* ws; int ph_lo, ph_hi; };
constexpr int ARGS_OFF = MISC_OFF + 1024;
__device__ __forceinline__ unsigned long long ldp(LAS unsigned char* lds, int i) {
    const volatile LAS unsigned* p = (const volatile LAS unsigned*)(lds + ARGS_OFF) + 2 * i;
    const unsigned lo = __builtin_amdgcn_readfirstlane(p[0]), hi = __builtin_amdgcn_readfirstlane(p[1]);
    return ((unsigned long long)hi << 32) | lo;
}
#define AIN(i) ((const float*)ldp(lds, (i)))
#define AOUT ((float*)ldp(lds, NIN))
#define AWS ((unsigned char*)ldp(lds, NIN + 1))

template <int MAP>
__device__ __forceinline__ void transpose_item(const float* W, int K, int N, bf16* WT, LAS float* scr, int item, int lane) {
    const int nblk = N / 64, kb = item / nblk, nb = item % nblk, k0 = 64 * kb, n0 = 64 * nb;
    const int kr = lane >> 4, nc = (lane & 15) * 4;
    const float* src = W + (size_t)(k0 + kr) * N + n0 + nc;
    f32x4 v[16];
#pragma unroll
    for (int i = 0; i < 16; ++i) v[i] = __builtin_nontemporal_load((const f32x4*)(src + (size_t)(4 * i) * N));
#pragma unroll
    for (int i = 0; i < 16; ++i) { LAS float* d = scr + (4 * i + kr) * 65 + nc; d[0] = v[i].x; d[1] = v[i].y; d[2] = v[i].z; d[3] = v[i].w; }
    LDS_WAIT(); asm volatile("" ::: "memory");
    const int c = lane & 7;
#pragma unroll
    for (int j = 0; j < 8; ++j) { const int n = (lane >> 3) + 8 * j; const LAS float* s = scr + (8 * c) * 65 + n;
        u32x4 o; o.x = pk_bf16(s[0 * 65], s[1 * 65]); o.y = pk_bf16(s[2 * 65], s[3 * 65]); o.z = pk_bf16(s[4 * 65], s[5 * 65]); o.w = pk_bf16(s[6 * 65], s[7 * 65]);
        const int nn = n0 + n; const int row = MAP == 0 ? nn : ((nn >> 7) * 256 + (nn & 127) + (MAP == 2 ? 128 : 0));
        __builtin_nontemporal_store(o, (u32x4*)(WT + (size_t)row * K + k0 + 8 * c)); }
    LDS_WAIT(); asm volatile("" ::: "memory");
}
template <int MAP>
__device__ __forceinline__ void transpose_item_f8(const float* W, int K, int N, unsigned char* WT, LAS float* scr, int item, int lane, int pitch = 0) {
    const int nblk = N / 64, kb = item / nblk, nb = item % nblk, k0 = 64 * kb, n0 = 64 * nb;
    const int kr = lane >> 4, nc = (lane & 15) * 4;
    const float* src = W + (size_t)(k0 + kr) * N + n0 + nc;
    f32x4 v[16];
#pragma unroll
    for (int i = 0; i < 16; ++i) v[i] = __builtin_nontemporal_load((const f32x4*)(src + (size_t)(4 * i) * N));
#pragma unroll
    for (int i = 0; i < 16; ++i) { LAS float* d = scr + (4 * i + kr) * 65 + nc; d[0] = v[i].x * W8_SCALE; d[1] = v[i].y * W8_SCALE; d[2] = v[i].z * W8_SCALE; d[3] = v[i].w * W8_SCALE; }
    LDS_WAIT(); asm volatile("" ::: "memory");
    const int c = lane & 3;
#pragma unroll
    for (int j = 0; j < 4; ++j) { const int n = (lane >> 2) + 16 * j; const LAS float* s = scr + (16 * c) * 65 + n;
        u32x4 o; o.x = pk4_fp8(s[0 * 65], s[1 * 65], s[2 * 65], s[3 * 65]); o.y = pk4_fp8(s[4 * 65], s[5 * 65], s[6 * 65], s[7 * 65]);
        o.z = pk4_fp8(s[8 * 65], s[9 * 65], s[10 * 65], s[11 * 65]); o.w = pk4_fp8(s[12 * 65], s[13 * 65], s[14 * 65], s[15 * 65]);
        const int nn = n0 + n; const int row = MAP == 0 ? nn : ((nn >> 7) * 256 + (nn & 127) + (MAP == 2 ? 128 : 0));
        __builtin_nontemporal_store(o, (u32x4*)(WT + (size_t)row * (pitch ? pitch : K) + k0 + 16 * c)); }
    LDS_WAIT(); asm volatile("" ::: "memory");
}
__device__ __forceinline__ void ph0(LAS unsigned char* lds, int tid, int lane, int wave, int G, int bid) {
    unsigned char* ws = AWS;
    {
        LAS float* sv = (LAS float*)(lds + 81920);
        LAS f32x4* comb = (LAS f32x4*)(lds + 81920 + 4096);
        float* modpart = (float*)(ws + WS_MODPART);
        for (int task = bid; task < 256; task += G) {
            const int cb = task & 15, kr = task >> 4;
            __syncthreads();
            for (int i = tid; i < 5 * 128; i += 512) { const int r = i >> 7, k = kr * 128 + (i & 127); const float v = (r < 4) ? AIN(IC)[r * D + k] : AIN(ICCTX)[k]; sv[i] = v / (1.0f + expf(-v)); }
            __syncthreads();
            f32x4 acc[5];
#pragma unroll
            for (int r = 0; r < 5; ++r) acc[r] = (f32x4){0.f, 0.f, 0.f, 0.f};
            const int c4 = tid % 192, ks = tid / 192;
            if (tid < 384) {
                const float* wp = AIN(IWADA) + (size_t)(kr * 128 + ks * 64) * 12288 + cb * 768 + c4 * 4;
#pragma unroll 8
                for (int k = 0; k < 64; ++k) { const f32x4 w = __builtin_nontemporal_load((const f32x4*)(wp + (size_t)k * 12288));
#pragma unroll
                    for (int r = 0; r < 5; ++r) acc[r] += w * sv[r * 128 + ks * 64 + k]; }
                if (ks == 1) {
#pragma unroll
                    for (int r = 0; r < 5; ++r) comb[r * 192 + c4] = acc[r]; }
            }
            __syncthreads();
            if (tid < 192) {
#pragma unroll
                for (int r = 0; r < 5; ++r) { const f32x4 t = acc[r] + comb[r * 192 + tid]; *(f32x4*)(modpart + (size_t)(kr * 5 + r) * 12288 + cb * 768 + tid * 4) = t; } }
        }
        __syncthreads();
    }
    const int gt = bid * 512 + tid, NGT = G * 512;
    {
        f32x2* PW = (f32x2*)(ws + WS_PW); f32x2* BBAR = (f32x2*)(ws + WS_BBAR); f32x2* LAML = (f32x2*)(ws + WS_LAML); f32x2* LAMSEG = (f32x2*)(ws + WS_LAMSEG);
        const double TWO_PI = 6.283185307179586476925287;
        for (int idx = gt; idx < SG * 2 * SP * 34; idx += NGT) {
            const int i = idx / 34, j = idx - i * 34; const int g = i >> 7, dir = (i >> 6) & 1, p = i & 63; const int si = (dir * SG + g) * SP + p;
            const double lr = (double)AIN(ILAMRE)[si], li = (double)AIN(ILAMIM)[si], dt = exp((double)AIN(ILOGDT)[dir * SG + g]);
            const int jj = (j == 33) ? LC * 33 : j;
            const double mag = exp((double)jj * lr * dt); double ang = (double)jj * li * dt; ang -= TWO_PI * rint(ang / TWO_PI);
            const float fa = (float)ang; const double cr = mag * (double)cosf(fa), ci = mag * (double)sinf(fa);
            const f32x2 o = (f32x2){(float)cr, (float)ci};
            if (j <= 32) PW[(size_t)i * 33 + j] = o;
            if (j == 32) LAML[i] = o;
            if (j == 33) LAMSEG[i] = o;
        }
        for (int idx = gt; idx < SG * 2 * SP * SH; idx += NGT) {
            const int i = idx >> 4, h = idx & 15; const int g = i >> 7, dir = (i >> 6) & 1, p = i & 63; const int si = (dir * SG + g) * SP + p;
            const double lr = (double)AIN(ILAMRE)[si], li = (double)AIN(ILAMIM)[si], dt = exp((double)AIN(ILOGDT)[dir * SG + g]);
            const double mag = exp(lr * dt); double ang = li * dt; ang -= TWO_PI * rint(ang / TWO_PI);
            const float fa = (float)ang; const double l1r = mag * (double)cosf(fa), l1i = mag * (double)sinf(fa);
            const double nr = l1r - 1.0, ni = l1i, den = lr * lr + li * li; const double qr = (nr * lr + ni * li) / den, qi = (ni * lr - nr * li) / den;
            const double br = (double)AIN(IBRE)[(size_t)si * SH + h], bi = (double)AIN(IBIM)[(size_t)si * SH + h];
            BBAR[(size_t)i * SH + h] = (f32x2){(float)(qr * br - qi * bi), (float)(qr * bi + qi * br)};
        }
    }
    {
        bf16* FKT = (bf16*)(ws + WS_FKT); bf16* FCT = (bf16*)(ws + WS_FCT); bf16* FRT = (bf16*)(ws + WS_FRT); bf16* WHI = (bf16*)(ws + WS_WRTHI); bf16* WLO = (bf16*)(ws + WS_WRTLO);
        const float TWO_PI_F = 6.2831853071795864f;
        for (int i = gt; i < 512 * 256; i += NGT) { const int m = i >> 8, k = i & 255, kp = m & 255, reim = m >> 8; const float ang = TWO_PI_F * (float)((k * kp) & 255) * (1.0f / 256.0f);
            FKT[i] = f2bf((reim ? -sinf(ang) : cosf(ang)) * 0.0625f); }
        for (int i = gt; i < 256 * 128; i += NGT) { const int m = i >> 7, kk = i & 127; float v = 0.f;
            if (m < 128) { const int ro = m >> 6, cp = m & 63, ri = kk >> 6, c = kk & 63; const float ang = TWO_PI_F * (float)((c * cp) & 63) * (1.0f / 64.0f); const float co = cosf(ang), sn = sinf(ang);
                v = (ro == 0 ? (ri == 0 ? co : sn) : (ri == 0 ? -sn : co)) * 0.125f; }
            FCT[i] = f2bf(v); }
        for (int i = gt; i < 256 * 256; i += NGT) { const int m = i >> 8, kk = i & 255; float v = 0.f;
            if (m < 128) { const int ri = kk >> 7, r = kk & 127; const float ang = TWO_PI_F * (float)((r * m) & 127) * (1.0f / 128.0f); v = (ri ? sinf(ang) : cosf(ang)) * 0.08838834764831845f; }
            FRT[i] = f2bf(v); }
        for (int i = gt; i < 48 * D; i += NGT) { const int n = i >> 11, k = i & (D - 1); float w = 0.f;
            if (n < 4) w = AIN(IWGRP)[k * 4 + n]; else if (n < 36) w = AIN(IWEXP)[k * 32 + (n - 4)];
            const bf16 h = f2bf(w); WHI[i] = h; WLO[i] = f2bf(w - bf2f(h)); }
    }
    {
        LAS float* scr = (LAS float*)(lds + wave * 16640);
        const int gw = bid * NWAVES + wave, NGW = G * NWAVES;
        constexpr int I_IN = 32 * 88, I_IN2 = 32 * 8, I_F = 16 * 32, I_S = 8 * 32, I_O = 32 * 32, I_G = 8 * 8, I_E = 512;
        constexpr int NITEMS = I_IN + I_IN2 + I_F + I_S + I_O + I_G + 3 * NE * I_E;
        for (int it = gw; it < NITEMS; it += NGW) {
            int r = it;
            if (r < I_IN) { transpose_item_f8<0>(AIN(IWIN), D, INW, (unsigned char*)(ws + WS_WG8), scr, r, lane); continue; } r -= I_IN;
            if (r < I_IN2) { transpose_item<0>(AIN(IWIN), D, INW, (bf16*)(ws + WS_WINT), scr, (r >> 3) * 88 + 16 + (r & 7), lane); continue; } r -= I_IN2;
            if (r < I_F) { transpose_item_f8<0>(AIN(IWF), FW, D, (unsigned char*)(ws + WS_WFT) + SW, scr, r, lane, SW + FW); continue; } r -= I_F;
            if (r < I_S) { transpose_item_f8<0>(AIN(IWS), SW, D, (unsigned char*)(ws + WS_WFT), scr, r, lane, SW + FW); continue; } r -= I_S;
            if (r < I_O) { transpose_item_f8<0>(AIN(IWOUT), D, D, (unsigned char*)(ws + WS_WOT), scr, r, lane); continue; } r -= I_O;
            if (r < I_G) { transpose_item<0>(AIN(IWGLU), SW, SW, (bf16*)(ws + WS_WGLUT), scr, r, lane); continue; } r -= I_G;
            if (r < NE * I_E) { const int e = r >> 9; transpose_item_f8<1>(AIN(IW1) + (size_t)e * D * DE, D, DE, (unsigned char*)(ws + WS_W13T) + (size_t)e * 2048 * D, scr, r & 511, lane); continue; } r -= NE * I_E;
            if (r < NE * I_E) { const int e = r >> 9; transpose_item_f8<2>(AIN(IW3) + (size_t)e * D * DE, D, DE, (unsigned char*)(ws + WS_W13T) + (size_t)e * 2048 * D, scr, r & 511, lane); continue; } r -= NE * I_E;
            { const int e = r >> 9; transpose_item_f8<0>(AIN(IW2) + (size_t)e * DE * D, DE, D, (unsigned char*)(ws + WS_W2T) + (size_t)e * D * DE, scr, r & 511, lane); }
        }
    }
}

__device__ __forceinline__ void ph1(LAS unsigned char* lds, int tid, int G, int bid) {
    unsigned char* ws = AWS; const int gt = bid * 512 + tid, NGT = G * 512;
    const f32x2* PW = (const f32x2*)(ws + WS_PW); const f32x2* BBAR = (const f32x2*)(ws + WS_BBAR);
    { const float* modpart = (const float*)(ws + WS_MODPART); float* modv = (float*)(ws + WS_MODV);
      for (int i = gt; i < 5 * 12288; i += NGT) { float s = AIN(IBADA)[i % 12288];
#pragma unroll
          for (int kr = 0; kr < 16; ++kr) s += modpart[(size_t)kr * 5 * 12288 + i];
          modv[i] = s; } }
    { float* KLAG = (float*)(ws + WS_KLAG);
      for (int i = gt; i < SG * 2 * LC * 64; i += NGT) { const int hq = i & 3, ho = (i >> 2) & 15, k = (i >> 6) & 31, gd = i >> 11, g = gd >> 1, dir = gd & 1;
          const float* cre = AIN(ICRE) + ((size_t)(dir * SG + g) * SH + ho) * SP; const float* cim = AIN(ICIM) + ((size_t)(dir * SG + g) * SH + ho) * SP;
          f32x4 s = (f32x4){0.f, 0.f, 0.f, 0.f};
#pragma unroll 4
          for (int p = 0; p < SP; ++p) { const f32x2 pw = PW[((size_t)gd * SP + p) * 33 + k]; const f32x4* bq = (const f32x4*)(BBAR + ((size_t)gd * SP + p) * SH + 4 * hq); const f32x4 b01 = bq[0], b23 = bq[1]; const float cr = cre[p], ci = cim[p];
              const float tr = cr * pw.x - ci * pw.y, ti = cr * pw.y + ci * pw.x;
              s.x += tr * b01.x - ti * b01.y; s.y += tr * b01.z - ti * b01.w; s.z += tr * b23.x - ti * b23.y; s.w += tr * b23.z - ti * b23.w; }
          *(f32x4*)(KLAG + (((size_t)gd * LC + k) << 8) + ho * 16 + 4 * hq) = s; } }
    { bf16* WET = (bf16*)(ws + WS_WET);
      for (int i = gt; i < SG * 256 * LC; i += NGT) { const int jj = i & 31, n = (i >> 5) & 255, g = i >> 13; const int dir = n >> 7, reim = (n >> 6) & 1, p = n & 63;
          const int gd = g * 2 + dir; const f32x2 pw = PW[((size_t)gd * SP + p) * 33 + (dir == 0 ? (LC - 1 - jj) : jj)]; const f32x4* bb = (const f32x4*)(BBAR + ((size_t)gd * SP + p) * SH);
          unsigned o[8];
#pragma unroll
          for (int q = 0; q < 8; ++q) { const f32x4 b2 = bb[q];
              const float v0 = reim ? (pw.x * b2.y + pw.y * b2.x) : (pw.x * b2.x - pw.y * b2.y), v1 = reim ? (pw.x * b2.w + pw.y * b2.z) : (pw.x * b2.z - pw.y * b2.w); o[q] = pk_bf16(v0, v1); }
          u32x4* dst = (u32x4*)(WET + ((size_t)g * 256 + n) * 512 + jj * 16); dst[0] = (u32x4){o[0], o[1], o[2], o[3]}; dst[1] = (u32x4){o[4], o[5], o[6], o[7]}; } }
    { bf16* TV = (bf16*)(ws + WS_TV);
      for (int i = gt; i < SG * 512 * 32; i += NGT) { const int p8 = i & 7, reim = (i >> 3) & 1, dir = (i >> 4) & 1, n = (i >> 5) & 511, g = i >> 14; const int tt = n >> 4, ho = n & 15;
          const int gd = g * 2 + dir, pj = dir == 0 ? (tt + 1) : (LC - tt); const size_t ci = ((size_t)(dir * SG + g) * SH + ho) * SP + p8 * 8;
          const f32x4 cr0 = *(const f32x4*)(AIN(ICRE) + ci), cr1 = *(const f32x4*)(AIN(ICRE) + ci + 4), ci0 = *(const f32x4*)(AIN(ICIM) + ci), ci1 = *(const f32x4*)(AIN(ICIM) + ci + 4);
          float v[8];
#pragma unroll
          for (int q = 0; q < 8; ++q) { const f32x2 pw = PW[((size_t)gd * SP + p8 * 8 + q) * 33 + pj]; const float cr = q < 4 ? cr0[q & 3] : cr1[q & 3], cim = q < 4 ? ci0[q & 3] : ci1[q & 3];
              v[q] = reim ? -(cr * pw.y + cim * pw.x) : (cr * pw.x - cim * pw.y); }
          *(u32x4*)(TV + ((size_t)g * 512 + n) * A2LD + 512 + dir * 128 + reim * 64 + p8 * 8) = (u32x4){pk_bf16(v[0], v[1]), pk_bf16(v[2], v[3]), pk_bf16(v[4], v[5]), pk_bf16(v[6], v[7])}; } }
}

__device__ __forceinline__ void ph2(LAS unsigned char* lds, int tid, int lane, int wave, int G, int bid) {
    unsigned char* ws = AWS; const float* modv = (const float*)(ws + WS_MODV);
    const int gt = bid * 512 + tid, NGT = G * 512; bf16* TV = (bf16*)(ws + WS_TV); const float* KLAG = (const float*)(ws + WS_KLAG); const float* dsk = AIN(IDSKIP);
    auto toep = [&](int i) { { const int jj = i & 31, n = (i >> 5) & 511, g = i >> 14; const int tt = n >> 4, ho = n & 15;
          const int dir = jj > tt ? 1 : 0, lag = jj > tt ? jj - tt : tt - jj;
          const f32x4* k0 = (const f32x4*)(KLAG + (((size_t)(g * 2 + dir) * LC + lag) << 8) + ho * 16);
          f32x4 a[4];
#pragma unroll
          for (int q = 0; q < 4; ++q) a[q] = k0[q];
          if (jj == tt) { const f32x4* k1 = (const f32x4*)(KLAG + (((size_t)(g * 2 + 1) * LC) << 8) + ho * 16);
#pragma unroll
              for (int q = 0; q < 4; ++q) a[q] += k1[q];
              const float dv = dsk[g * SH + ho];
#pragma unroll
              for (int q = 0; q < 4; ++q) { a[q].x += (ho == 4 * q + 0) ? dv : 0.f; a[q].y += (ho == 4 * q + 1) ? dv : 0.f; a[q].z += (ho == 4 * q + 2) ? dv : 0.f; a[q].w += (ho == 4 * q + 3) ? dv : 0.f; } }
          u32x4* dst = (u32x4*)(TV + ((size_t)g * 512 + n) * A2LD + jj * 16);
          dst[0] = (u32x4){pk_bf16(a[0].x, a[0].y), pk_bf16(a[0].z, a[0].w), pk_bf16(a[1].x, a[1].y), pk_bf16(a[1].z, a[1].w)};
          dst[1] = (u32x4){pk_bf16(a[2].x, a[2].y), pk_bf16(a[2].z, a[2].w), pk_bf16(a[3].x, a[3].y), pk_bf16(a[3].z, a[3].w)}; } };
    int ti = gt;
    LAS f32x4* MV = (LAS f32x4*)lds;
    for (int i = tid; i < 5 * 2 * 512; i += NWAVES * 64) { const int b = i >> 10, which = (i >> 9) & 1, q = i & 511; f32x4 t = *((const f32x4*)(modv + (size_t)b * 12288 + which * D) + q); if (which) t = t + 1.0f; MV[i] = t; }
    __syncthreads();
    const int gw = bid * NWAVES + wave, NGW = G * NWAVES; const float* XP = AIN(IX); const float* CP = AIN(ICTX);
    f32x4 v[8];
    { const int m = gw; const f32x4* xq = (const f32x4*)(m < T ? XP + (size_t)m * D : CP + (size_t)(m - T) * D) + lane;
#pragma unroll
      for (int j = 0; j < 8; ++j) v[j] = __builtin_nontemporal_load(xq + 64 * j); }
    for (int m = gw; m < T + TC; m += NGW) {
        f32x4 vn[8]; const int mn = m + NGW;
        if (mn < T + TC) { const f32x4* xq = (const f32x4*)(mn < T ? XP + (size_t)mn * D : CP + (size_t)(mn - T) * D) + lane;
#pragma unroll
            for (int j = 0; j < 8; ++j) vn[j] = __builtin_nontemporal_load(xq + 64 * j); }
        else {
#pragma unroll
            for (int j = 0; j < 8; ++j) vn[j] = (f32x4){0.f, 0.f, 0.f, 0.f}; }
        if (ti < SG * 512 * LC) { toep(ti); ti += NGT; }
        bf16* orow; int bsel;
        if (m < T) { orow = (bf16*)(ws + WS_R3) + (size_t)m * D; bsel = m >> 13; }
        else { orow = (bf16*)(ws + WS_HC) + (size_t)(m - T) * D; bsel = 4; }
        float s = 0.f;
#pragma unroll
        for (int j = 0; j < 8; ++j) s += (v[j].x + v[j].y) + (v[j].z + v[j].w);
        const float mean = wave_sum(s) * (1.f / D); float s2 = 0.f;
#pragma unroll
        for (int j = 0; j < 8; ++j) { v[j] = v[j] - mean; s2 += (v[j].x * v[j].x + v[j].y * v[j].y) + (v[j].z * v[j].z + v[j].w * v[j].w); }
        const float rstd = 1.f / sqrtf(wave_sum(s2) * (1.f / D) + LN_EPS);
        const LAS f32x4* shq = MV + bsel * 1024 + lane; const LAS f32x4* scq = shq + 512; u32x2* o8 = (u32x2*)orow + lane;
        unsigned* o4 = (unsigned*)(ws + WS_RA + (size_t)(m < T ? m : 0) * D) + lane;
#pragma unroll
        for (int j = 0; j < 8; ++j) { const f32x4 sh = shq[64 * j], sc = scq[64 * j]; const f32x4 y = v[j] * rstd * sc + sh; if (m < T) o4[64 * j] = pk4_fp8(y.x, y.y, y.z, y.w); else o8[64 * j] = (u32x2){pk_bf16(y.x, y.y), pk_bf16(y.z, y.w)}; }
#pragma unroll
        for (int j = 0; j < 8; ++j) v[j] = vn[j];
    }
    for (; ti < SG * 512 * LC; ti += NGT) toep(ti);
}

__device__ __forceinline__ void ctx_inproj(LAS unsigned char* lds, int lane, int wave, int G, int bid) {
    unsigned char* ws = AWS; const bf16* HC = (const bf16*)(ws + WS_HC); const bf16* WINT = (const bf16*)(ws + WS_WINT); bf16* A2 = (bf16*)(ws + WS_A2);
    const int fr = lane & 15, fq = lane >> 4;
    for (int wt = bid * NWAVES + wave; wt < 2048; wt += G * NWAVES) {
        const int rt = wt >> 5, ct = wt & 31;
        const bf16* ap = HC + (size_t)(16 * rt + fr) * D + 8 * fq; const bf16* bp = WINT + (size_t)(FW + 16 * ct + fr) * D + 8 * fq;
        f32x4 acc = (f32x4){0.f, 0.f, 0.f, 0.f};
#pragma unroll 8
        for (int ks = 0; ks < 64; ++ks) { const bf16x8 av = *(const bf16x8*)(ap + 32 * ks), bv = *(const bf16x8*)(bp + 32 * ks); acc = __builtin_amdgcn_mfma_f32_16x16x32_bf16(av, bv, acc, 0, 0, 0); }
#pragma unroll
        for (int j = 0; j < 4; ++j) { const int row = 16 * rt + 4 * fq + j, b = row >> 8, tp = row & 255;
            A2[((size_t)((ct * 4 + b) * NCH + (tp >> 5))) * A2LD + (tp & 31) * 16 + fr] = f2bf(acc[j]); }
    }
}
__device__ __forceinline__ void ctx_E(LAS unsigned char* lds, int lane, int wave, int G, int bid) {
    unsigned char* ws = AWS; const bf16* A2 = (const bf16*)(ws + WS_A2); const bf16* WET = (const bf16*)(ws + WS_WET); float* E = (float*)(ws + WS_E);
    const int fr = lane & 15, fq = lane >> 4;
    for (int task = (bid + G - (128 % G)) % G; task < 128; task += G) {
        const int g = task >> 2, b = task & 3;
        const bf16* ap = A2 + (size_t)((g * 4 + b) * NCH + fr) * A2LD + 8 * fq;
        const bf16* bp0 = WET + (size_t)(g * 256 + 32 * wave + fr) * 512 + 8 * fq; const bf16* bp1 = bp0 + 16 * 512;
        f32x4 acc0 = (f32x4){0.f, 0.f, 0.f, 0.f}, acc1 = acc0;
#pragma unroll 4
        for (int ks = 0; ks < 16; ++ks) { const bf16x8 av = *(const bf16x8*)(ap + 32 * ks), b0 = *(const bf16x8*)(bp0 + 32 * ks), b1 = *(const bf16x8*)(bp1 + 32 * ks);
            acc0 = __builtin_amdgcn_mfma_f32_16x16x32_bf16(av, b0, acc0, 0, 0, 0); acc1 = __builtin_amdgcn_mfma_f32_16x16x32_bf16(av, b1, acc1, 0, 0, 0); }
        if (fq < 2) {
#pragma unroll
            for (int j = 0; j < 4; ++j) { float* er = E + (size_t)((g * 4 + b) * NCH + 4 * fq + j) * 256 + 32 * wave + fr; er[0] = acc0[j]; er[16] = acc1[j]; } }
    }
}

__device__ __forceinline__ void chunk_scan(LAS unsigned char* lds, int lane, int wave, int G, int bid) {
    unsigned char* ws = AWS; const float* E = (const float*)(ws + WS_E); bf16* A2 = (bf16*)(ws + WS_A2);
    const f32x2* LAML = (const f32x2*)(ws + WS_LAML); const f32x2* LAMSEG = (const f32x2*)(ws + WS_LAMSEG);
    LAS f32x2* segEnd = (LAS f32x2*)lds;
    for (int task = bid; task < 256; task += G) {
        const int g = task >> 3, b = (task >> 1) & 3, dir = task & 1, p = lane;
        const f32x2 lamL = LAML[(g * 2 + dir) * SP + p], lamS = LAMSEG[(g * 2 + dir) * SP + p];
        const float* Eb = E + (size_t)((g * 4 + b) * NCH) * 256 + dir * 128 + p;
        const int v0 = 33 * wave;
        float sr = 0.f, si = 0.f;
#pragma unroll 11
        for (int i = 0; i < 33; ++i) { const int vi = v0 + i; const int cr = dir == 0 ? vi : (vi < NCTXCH ? NCTXCH - 1 - vi : (NCH - 1 + NCTXCH) - vi);
            const float er = Eb[(size_t)cr * 256], ei = Eb[(size_t)cr * 256 + 64];
            const float tr = lamL.x * sr - lamL.y * si + er, ti = lamL.x * si + lamL.y * sr + ei; sr = tr; si = ti; }
        __syncthreads();
        segEnd[wave * 64 + p] = (f32x2){sr, si};
        __syncthreads();
        sr = 0.f; si = 0.f;
        for (int w = 0; w < wave; ++w) { const f32x2 se = segEnd[w * 64 + p]; const float tr = lamS.x * sr - lamS.y * si + se.x, ti = lamS.x * si + lamS.y * sr + se.y; sr = tr; si = ti; }
        bf16* Ab = A2 + (size_t)((g * 4 + b) * NCH) * A2LD + 512 + dir * 128 + p;
#pragma unroll 11
        for (int i = 0; i < 33; ++i) { const int vi = v0 + i; const int cr = dir == 0 ? vi : (vi < NCTXCH ? NCTXCH - 1 - vi : (NCH - 1 + NCTXCH) - vi);
            const float er = Eb[(size_t)cr * 256], ei = Eb[(size_t)cr * 256 + 64];
            if (cr >= NCTXCH) { Ab[(size_t)cr * A2LD] = f2bf(sr); Ab[(size_t)cr * A2LD + 64] = f2bf(si); }
            const float tr = lamL.x * sr - lamL.y * si + er, ti = lamL.x * si + lamL.y * sr + ei; sr = tr; si = ti; }
    }
    __syncthreads();
}

__device__ __forceinline__ void ph10(LAS unsigned char* lds, int tid, int lane, int wave, int G, int bid) {
    unsigned char* ws = AWS; bf16* XM = (bf16*)(ws + WS_XMID); unsigned char* H2 = (unsigned char*)(ws + WS_RB); const float* modv = (const float*)(ws + WS_MODV);
    const bf16* WHI = (const bf16*)(ws + WS_WRTHI); const bf16* WLO = (const bf16*)(ws + WS_WRTLO);
    unsigned* ctl = (unsigned*)(ws + WS_CTL); int* rowlist = (int*)(ws + WS_ROWLIST); float* rw = (float*)(ws + WS_RW);
    constexpr int RS = 4112;
    LAS unsigned char* Hhi = lds; LAS unsigned char* Hlo = lds + 16 * RS;
    LAS float* Pp = (LAS float*)lds;
    LAS float* Lg = (LAS float*)(lds + 2 * 16 * RS);
    LAS int* tokE = (LAS int*)(lds + 2 * 16 * RS + 2304);
    LAS float* tokW = (LAS float*)(lds + 2 * 16 * RS + 3328);
    LAS int* tokLi = (LAS int*)(lds + 2 * 16 * RS + 4352);
    LAS int* lcnt = (LAS int*)(lds + 2 * 16 * RS + 5376);
    LAS int* lbase = (LAS int*)(lds + 2 * 16 * RS + 5504);
    const int fr = lane & 15, fq = lane >> 4;
    const float* XIN = AIN(IX); const bf16* MG = (const bf16*)(ws + WS_R3);
    const float* bgrp = AIN(IBGRP); const float* bexp = AIN(IBEXP); const float* ln1g = AIN(ILN1G); const float* ln1b = AIN(ILN1B);
    bf16x8 wf[8][3];
#pragma unroll
    for (int ks = 0; ks < 8; ++ks)
#pragma unroll
        for (int nt = 0; nt < 3; ++nt) wf[ks][nt] = *(const bf16x8*)(WHI + (size_t)(16 * nt + fr) * D + 256 * wave + 32 * ks + 8 * fq);
    LAS f32x4* VEC = (LAS f32x4*)(lds + 16 * RS);
    const f32x4* XIN4 = (const f32x4*)XIN + lane; const u32x2* MG2 = (const u32x2*)MG + lane;
    auto load_row = [&](size_t gtok, f32x4 (&xv)[8], u32x2 (&mv_)[8]) {
        const f32x4* xin = XIN4 + gtok * (D / 4); const u32x2* mgq = MG2 + gtok * (D / 4);
#pragma unroll
        for (int j = 0; j < 8; ++j) { mv_[j] = __builtin_nontemporal_load(mgq + 64 * j); xv[j] = __builtin_nontemporal_load(xin + 64 * j); } };
    auto do_row = [&](f32x4 (&v)[8], const u32x2 (&mg)[8], size_t gtok, int row) {
        u32x2* xq = (u32x2*)(XM + gtok * D) + lane; float s = 0.f;
#pragma unroll
        for (int j = 0; j < 8; ++j) { v[j] = v[j] * DN_ALPHA + (f32x4){bf_lo(mg[j].x), bf_hi(mg[j].x), bf_lo(mg[j].y), bf_hi(mg[j].y)}; s += (v[j].x + v[j].y) + (v[j].z + v[j].w); }
        float mean = wave_sum(s) * (1.f / D), s2 = 0.f;
#pragma unroll
        for (int j = 0; j < 8; ++j) { v[j] = v[j] - mean; s2 += (v[j].x * v[j].x + v[j].y * v[j].y) + (v[j].z * v[j].z + v[j].w * v[j].w); }
        float rstd = 1.f / sqrtf(wave_sum(s2) * (1.f / D) + LN_EPS);
        const LAS f32x4* gq = VEC + lane; const LAS f32x4* bq = VEC + 512 + lane; s = 0.f;
#pragma unroll
        for (int j = 0; j < 8; ++j) { v[j] = v[j] * rstd * gq[64 * j] + bq[64 * j]; xq[64 * j] = (u32x2){pk_bf16(v[j].x, v[j].y), pk_bf16(v[j].z, v[j].w)}; s += (v[j].x + v[j].y) + (v[j].z + v[j].w); }
        mean = wave_sum(s) * (1.f / D); s2 = 0.f;
#pragma unroll
        for (int j = 0; j < 8; ++j) { v[j] = v[j] - mean; s2 += (v[j].x * v[j].x + v[j].y * v[j].y) + (v[j].z * v[j].z + v[j].w * v[j].w); }
        rstd = 1.f / sqrtf(wave_sum(s2) * (1.f / D) + LN_EPS);
        const LAS f32x4* scq = VEC + 1024 + lane; const LAS f32x4* shq = VEC + 1536 + lane; unsigned* o8 = (unsigned*)(H2 + gtok * D) + lane;
#pragma unroll
        for (int j = 0; j < 8; ++j) { const f32x4 y = v[j] * rstd * scq[64 * j] + shq[64 * j];
            const u32x2 hi = (u32x2){pk_bf16(y.x, y.y), pk_bf16(y.z, y.w)};
            o8[64 * j] = pk4_fp8(y.x, y.y, y.z, y.w);
            *(LAS u32x2*)(Hhi + row * RS + (256 * j + 4 * lane) * 2) = hi; } };
    for (int batch = bid; batch < 256; batch += G) {
        if (tid < 32) lcnt[tid] = 0;
        { const float* mv = modv + (size_t)((batch * 128) >> 13) * 12288;
          for (int i = tid; i < 4 * 512; i += NWAVES * 64) { const int r = i >> 9, q = i & 511;
              f32x4 t = *((const f32x4*)(r == 0 ? ln1g : r == 1 ? ln1b : r == 2 ? mv + 4 * D : mv + 3 * D) + q); if (r == 2) t = t + 1.0f; VEC[i] = t; } }
        __syncthreads();
        const size_t tokB = (size_t)batch * 128 + 2 * wave;
        f32x4 xa[8], xb[8]; u32x2 ma[8], mb[8];
        load_row(tokB, xa, ma);
        for (int grp = 0; grp < 8; ++grp) {
            const size_t g0 = tokB + grp * 16;
            load_row(g0 + 1, xb, mb);
            do_row(xa, ma, g0, 2 * wave);
            if (grp < 7) load_row(g0 + 16, xa, ma);
            do_row(xb, mb, g0 + 1, 2 * wave + 1);
            __syncthreads();
            f32x4 acc[3];
#pragma unroll
            for (int nt = 0; nt < 3; ++nt) acc[nt] = (f32x4){0.f, 0.f, 0.f, 0.f};
#pragma unroll
            for (int ks = 0; ks < 8; ++ks) { const int k = 256 * wave + 32 * ks + 8 * fq;
                const bf16x8 ahi = *(const LAS bf16x8*)(Hhi + fr * RS + k * 2);
#pragma unroll
                for (int nt = 0; nt < 3; ++nt) acc[nt] = __builtin_amdgcn_mfma_f32_16x16x32_bf16(ahi, wf[ks][nt], acc[nt], 0, 0, 0); }
            __syncthreads();
#pragma unroll
            for (int nt = 0; nt < 3; ++nt)
#pragma unroll
                for (int j = 0; j < 4; ++j) Pp[(wave * 16 + 4 * fq + j) * 48 + 16 * nt + fr] = acc[nt][j];
            __syncthreads();
            for (int i = tid; i < 16 * 36; i += 512) { const int tk = i / 36, n = i % 36; float s = 0.f;
#pragma unroll
                for (int w = 0; w < 8; ++w) s += Pp[(w * 16 + tk) * 48 + n];
                Lg[i] = s; }
            __syncthreads();
            if (tid < 16) {
                const LAS float* L = Lg + tid * 36;
                float lg[4]; int gi = 0; float gm;
#pragma unroll
                for (int i = 0; i < 4; ++i) lg[i] = L[i] + bgrp[i];
                gm = lg[0];
#pragma unroll
                for (int i = 1; i < 4; ++i) if (lg[i] > gm) { gm = lg[i]; gi = i; }
                float gz = 0.f;
#pragma unroll
                for (int i = 0; i < 4; ++i) gz += expf(lg[i] - gm);
                const float gtop = 1.0f / gz;
                float le[8]; int j0 = 0; float m0;
#pragma unroll
                for (int j = 0; j < 8; ++j) le[j] = L[4 + gi * 8 + j] + bexp[gi * 8 + j];
                m0 = le[0];
#pragma unroll
                for (int j = 1; j < 8; ++j) if (le[j] > m0) { m0 = le[j]; j0 = j; }
                int j1 = (j0 == 0) ? 1 : 0; float m1 = -3.0e38f;
#pragma unroll
                for (int j = 0; j < 8; ++j) if (j != j0 && le[j] > m1) { m1 = le[j]; j1 = j; }
                const float e1 = expf(m1 - m0), w0 = gtop / (1.0f + e1), w1 = gtop * e1 / (1.0f + e1);
                const int ex0 = gi * 8 + j0, ex1 = gi * 8 + j1; const int sl = (grp * 16 + tid) * 2;
                tokE[sl] = ex0; tokE[sl + 1] = ex1; tokW[sl] = w0; tokW[sl + 1] = w1;
                tokLi[sl] = __hip_atomic_fetch_add(lcnt + ex0, 1, __ATOMIC_RELAXED, __HIP_MEMORY_SCOPE_WORKGROUP);
                tokLi[sl + 1] = __hip_atomic_fetch_add(lcnt + ex1, 1, __ATOMIC_RELAXED, __HIP_MEMORY_SCOPE_WORKGROUP);
            }
            __syncthreads();
        }
        if (tid < 32) { const int n = lcnt[tid]; lbase[tid] = n ? (int)__hip_atomic_fetch_add(ctl + CW_CNT + 64 * tid, (unsigned)n, RLX_AGENT) : 0; }
        __syncthreads();
        if (tid < 256) { const int e = tokE[tid], pos = lbase[e] + tokLi[tid], ent = (batch * 128 + (tid >> 1)) * 2 + (tid & 1); rowlist[(size_t)e * ECAP + pos] = ent; rw[ent] = tokW[tid]; }
        __syncthreads();
    }
}

__device__ __forceinline__ void ph13(LAS unsigned char* lds, int tid, int lane_, int wave, int G, int bid) {
    const int lane = (int)__builtin_amdgcn_mbcnt_hi(~0u, __builtin_amdgcn_mbcnt_lo(~0u, 0u));
    unsigned char* ws = AWS; float* X = AOUT; const bf16* XM = (const bf16*)(ws + WS_XMID); const unsigned char* Y = (const unsigned char*)(ws + WS_RB); const float* rw = (const float*)(ws + WS_RW); const float* modv = (const float*)(ws + WS_MODV);
    LAS f32x4* VG = (LAS f32x4*)lds;
    { const f32x4* g2 = (const f32x4*)AIN(ILN2G); const f32x4* b2 = (const f32x4*)AIN(ILN2B);
      for (int i = tid; i < 6 * 512; i += NWAVES * 64) { const int r = i >> 9, q = i & 511; VG[i] = r < 4 ? *((const f32x4*)(modv + (size_t)r * 12288 + 5 * D) + q) : (r == 4 ? g2[q] : b2[q]); } }
    __syncthreads();
    const int gw = bid * NWAVES + wave, NGW = G * NWAVES;
    unsigned p0[8], p1[8]; u32x2 xb[8]; float w0, w1;
    { const int m = gw; const u32x2* xm = (const u32x2*)(XM + (size_t)m * D) + lane; const unsigned* y0 = (const unsigned*)(Y + (size_t)(2 * m) * D) + lane; const unsigned* y1 = y0 + D / 4;
#pragma unroll
      for (int j = 0; j < 8; ++j) { p0[j] = __builtin_nontemporal_load(y0 + 64 * j); p1[j] = __builtin_nontemporal_load(y1 + 64 * j); xb[j] = __builtin_nontemporal_load(xm + 64 * j); }
      w0 = rw[2 * m]; w1 = rw[2 * m + 1]; }
    for (int m = gw; m < T; m += NGW) {
        unsigned q0[8], q1[8]; u32x2 xn[8]; float wn0 = 0.f, wn1 = 0.f; const int mn = m + NGW;
        if (mn < T) { const u32x2* xm = (const u32x2*)(XM + (size_t)mn * D) + lane; const unsigned* y0 = (const unsigned*)(Y + (size_t)(2 * mn) * D) + lane; const unsigned* y1 = y0 + D / 4;
#pragma unroll
            for (int j = 0; j < 8; ++j) { q0[j] = __builtin_nontemporal_load(y0 + 64 * j); q1[j] = __builtin_nontemporal_load(y1 + 64 * j); xn[j] = __builtin_nontemporal_load(xm + 64 * j); }
            wn0 = rw[2 * mn]; wn1 = rw[2 * mn + 1]; }
        else {
#pragma unroll
            for (int j = 0; j < 8; ++j) { q0[j] = 0u; q1[j] = 0u; xn[j] = (u32x2){0u, 0u}; } }
        f32x4* xq = (f32x4*)(X + (size_t)m * D) + lane; const LAS f32x4* gq = VG + (m >> 13) * 512 + lane;
        const float c0 = w0 * Y8_INV, c1 = w1 * Y8_INV;
        f32x4 v[8]; float s = 0.f;
#pragma unroll
        for (int j = 0; j < 8; ++j) {
            const f32x2 a0 = __builtin_amdgcn_cvt_pk_f32_fp8((int)p0[j], false), a1 = __builtin_amdgcn_cvt_pk_f32_fp8((int)p0[j], true), b0 = __builtin_amdgcn_cvt_pk_f32_fp8((int)p1[j], false), b1 = __builtin_amdgcn_cvt_pk_f32_fp8((int)p1[j], true);
            const f32x4 yy = (f32x4){a0.x, a0.y, a1.x, a1.y} * c0 + (f32x4){b0.x, b0.y, b1.x, b1.y} * c1;
            v[j] = (f32x4){bf_lo(xb[j].x), bf_hi(xb[j].x), bf_lo(xb[j].y), bf_hi(xb[j].y)} * DN_ALPHA + gq[64 * j] * yy; s += (v[j].x + v[j].y) + (v[j].z + v[j].w); }
        const float mean = wave_sum(s) * (1.f / D); float s2 = 0.f;
#pragma unroll
        for (int j = 0; j < 8; ++j) { v[j] = v[j] - mean; s2 += (v[j].x * v[j].x + v[j].y * v[j].y) + (v[j].z * v[j].z + v[j].w * v[j].w); }
        const float rstd = 1.f / sqrtf(wave_sum(s2) * (1.f / D) + LN_EPS);
        const LAS f32x4* g2 = VG + 4 * 512 + lane; const LAS f32x4* b2 = VG + 5 * 512 + lane;
#pragma unroll
        for (int j = 0; j < 8; ++j) __builtin_nontemporal_store(v[j] * rstd * g2[64 * j] + b2[64 * j], xq + 64 * j);
#pragma unroll
        for (int j = 0; j < 8; ++j) { p0[j] = q0[j]; p1[j] = q1[j]; xb[j] = xn[j]; }
        w0 = wn0; w1 = wn1;
    }
}

__global__ void __launch_bounds__(NWAVES * 64, 2) fwd_kernel(Args a) {
    extern __shared__ __attribute__((aligned(16))) unsigned char lds_raw[];
    LAS unsigned char* lds = (LAS unsigned char*)lds_raw;
    const int tid = threadIdx.x, lane = tid & 63, wave = __builtin_amdgcn_readfirstlane(tid >> 6), G = gridDim.x, bid = blockIdx.x;
    for (int u = tid; u < (LDS_BYTES - MISC_OFF) / 4; u += NWAVES * 64) ((LAS unsigned*)(lds + MISC_OFF))[u] = 0u;
    __syncthreads();
    if (tid < NIN + 2) { const unsigned long long* kp = (const unsigned long long*)&a; const unsigned long long v = kp[tid];
        volatile LAS unsigned* tab = (volatile LAS unsigned*)(lds + ARGS_OFF); tab[2 * tid] = (unsigned)v; tab[2 * tid + 1] = (unsigned)(v >> 32); }
    __syncthreads();
    unsigned char* ws = AWS;
    const int lo = a.ph_lo, hi = a.ph_hi;
    XcdBarrier bar; bar.bar = (unsigned*)(ws + WS_CTL) + CW_BAR; bar.x = 0; bar.st = nullptr;
    if (hi - lo > 1) bar = xcd_barrier_post((unsigned*)(ws + WS_CTL) + CW_BAR, (volatile LAS unsigned*)(lds + MISC_OFF));
#ifndef PHASE_MASK
#define PHASE_MASK 0x3fff
#endif
#define IN(k) (((PHASE_MASK >> (k)) & 1) && lo <= (k) && (k) < hi)
#define SEAM(k) do { if (IN(k) && IN((k) + 1)) xcd_barrier(bar); } while (0)
    LAS int* moe_pre = (LAS int*)(lds + MISC_OFF + 256);
    LAS int* moe_cnt = (LAS int*)(lds + MISC_OFF + 512);

    if (IN(0)) { ph0(lds, tid, lane, wave, G, bid); } SEAM(0);
    if (IN(1)) { ph1(lds, tid, G, bid); } SEAM(1);
    if (IN(2)) { ph2(lds, tid, lane, wave, G, bid); } SEAM(2);
    if (IN(3)) {
        ctx_inproj(lds, lane, wave, G, bid);
        { SchedRect S; S.o.init(T / 256, 6, G, bid); S.A = (const char*)(ws + WS_RA); S.B = (const char*)(ws + WS_WG8); S.lda = D / 2; S.ldb = D / 2; S.nt = D / 128;
          EpiInProjT<true> E{(bf16*)(ws + WS_UF), (bf16*)(ws + WS_A2), nullptr, nullptr};
          pg8::gemm_phase<EpiInProjT<true>, SchedRect, true, true>(lds, S, E); }
        { SchedRect S; S.o.init(T / 256, 16, G, bid); S.A = (const char*)(ws + WS_RA); S.B = (const char*)(ws + WS_WG8) + (size_t)1536 * D; S.lda = D / 2; S.ldb = D / 2; S.nt = D / 128;
          EpiGates8 E{(unsigned char*)AOUT, (unsigned char*)AOUT + (size_t)T * D};
          pg8::gemm_phase<EpiGates8, SchedRect, true, true>(lds, S, E); }
    } SEAM(3);
    if (IN(4)) {
#ifndef NO_P4A
        { SchedE S{G, bid, (const char*)(ws + WS_A2), (const char*)(ws + WS_WET)}; EpiE E{(float*)(ws + WS_E)}; pg8::gemm_phase<EpiE, SchedE>(lds, S, E); }
#endif
#ifndef NO_P4B
        ctx_E(lds, lane, wave, G, bid);
#endif
#ifndef NO_P4C
        { SchedF1 S{G, bid, (const char*)(ws + WS_FKT), (const char*)(ws + WS_UF)}; EpiF1 E{(bf16*)(ws + WS_R3)}; pg8::gemm_phase<EpiF1, SchedF1>(lds, S, E); }
#endif
    } SEAM(4);
    if (IN(5)) {
        chunk_scan(lds, lane, wave, G, bid);
        { SchedF2 S{G, bid, (const char*)(ws + WS_FCT), (const char*)(ws + WS_R3)}; EpiF2 E{(bf16*)(ws + WS_RA)}; pg8::gemm_phase<EpiF2, SchedF2>(lds, S, E); }
    } SEAM(5);
    if (IN(6)) {
#ifndef NO_P6A
        { SchedSSM S{G, bid, (const char*)(ws + WS_A2), (const char*)(ws + WS_TV)}; EpiSSM E{(bf16*)(ws + WS_YS)}; pg8::gemm_phase<EpiSSM, SchedSSM>(lds, S, E); }
#endif
#ifndef NO_P6B
        { SchedF3 S{G, bid, (const char*)(ws + WS_FRT), (const char*)(ws + WS_RA)}; EpiF3 E{(unsigned char*)(ws + WS_R3)}; pg8::gemm_phase<EpiF3, SchedF3>(lds, S, E); }
#endif
    } SEAM(6);
    if (IN(7)) {
        SchedRect S; S.o.init(T / 256, SW / 256, G, bid); S.A = (const char*)(ws + WS_YS); S.B = (const char*)(ws + WS_WGLUT); S.lda = SW; S.ldb = SW; S.nt = SW / 64;
        EpiGate<2> E{nullptr, (const void*)(ws + WS_YS), AIN(IBGLU), SW, (unsigned char*)(ws + WS_R3), SW + FW};
        pg8::gemm_phase<EpiGate<2>, SchedRect>(lds, S, E);
    } SEAM(7);
    if (IN(8)) {
        SchedMerge S; S.o.init(T / 256, D / 256, G, bid); S.A = (const char*)(ws + WS_R3); S.B = (const char*)(ws + WS_WFT);
        EpiMerge E{(unsigned char*)(ws + WS_RA), (const unsigned char*)AOUT, (const unsigned char*)AOUT + (size_t)T * D};
        pg8::gemm_phase<EpiMerge, SchedMerge, true, true>(lds, S, E);
    } SEAM(8);
    if (IN(9)) {
        SchedRect S; S.o.init(T / 256, D / 256, G, bid); S.A = (const char*)(ws + WS_RA); S.B = (const char*)(ws + WS_WOT); S.lda = D / 2; S.ldb = D / 2; S.nt = D / 128;
        EpiOut E{(const float*)(ws + WS_MODV), (bf16*)(ws + WS_R3)};
        pg8::gemm_phase<EpiOut, SchedRect, true, true>(lds, S, E);
    } SEAM(9);
    if (IN(10)) { ph10(lds, tid, lane, wave, G, bid); } SEAM(10);
    if (IN(11) || IN(12)) {
        if (tid < 64) { const int cnt = tid < NE ? (int)__hip_atomic_load((unsigned*)(ws + WS_CTL) + CW_CNT + 64 * tid, RLX_AGENT) : 0; const int tiles = (cnt + 255) >> 8; int incl = tiles;
#pragma unroll
            for (int o = 1; o < 32; o <<= 1) { const int t = __shfl_up(incl, o); if (lane >= o) incl += t; }
            if (tid < NE) { moe_pre[tid] = incl - tiles; moe_cnt[tid] = cnt; } if (tid == NE - 1) moe_pre[NE] = incl; }
        __syncthreads();
    }
    if (IN(11)) {
        SchedMoe<1, D, D, D / 128> S{G, bid, (const char*)(ws + WS_RB), (const char*)(ws + WS_W13T), (const int*)(ws + WS_ROWLIST), moe_pre, moe_cnt};
        EpiMoe1 E{(unsigned char*)(ws + WS_RA), (const int*)(ws + WS_ROWLIST)};
        pg8::gemm_phase<EpiMoe1, SchedMoe<1, D, D, D / 128>, true, true>(lds, S, E);
    } SEAM(11);
    if (IN(12)) {
        SchedMoe<0, DE, DE, DE / 128> S{G, bid, (const char*)(ws + WS_RA), (const char*)(ws + WS_W2T), (const int*)(ws + WS_ROWLIST), moe_pre, moe_cnt};
        EpiMoe2 E{(unsigned char*)(ws + WS_RB), (const int*)(ws + WS_ROWLIST)};
        pg8::gemm_phase<EpiMoe2, SchedMoe<0, DE, DE, DE / 128>, true, true>(lds, S, E);
    } SEAM(12);
    if (IN(13)) { ph13(lds, tid, lane, wave, G, bid); }
#undef IN
#undef SEAM
}

extern "C" void kernel_launch(void* const* d_in, const int* in_sizes, int n_in, void* d_out, int out_size, void* d_ws, size_t ws_size, hipStream_t stream) {
    static int grid = 0;
    if (grid == 0) {
        if (n_in != NIN || out_size != T * D || ws_size < WS_END) { fprintf(stderr, "kernel_launch: unexpected problem (n_in %d, out %d, ws %zu); nothing launched\n", n_in, out_size, ws_size); grid = -1; return; }
        int dev = 0, cus = 0, per_cu = 0;
        if (hipGetDevice(&dev) != hipSuccess || hipDeviceGetAttribute(&cus, hipDeviceAttributeMultiprocessorCount, dev) != hipSuccess) { grid = -1; return; }
        if (hipFuncSetAttribute((const void*)fwd_kernel, hipFuncAttributeMaxDynamicSharedMemorySize, LDS_BYTES) != hipSuccess) { fprintf(stderr, "kernel_launch: hipFuncSetAttribute failed\n"); grid = -1; return; }
        if (hipOccupancyMaxActiveBlocksPerMultiprocessor(&per_cu, (const void*)fwd_kernel, NWAVES * 64, LDS_BYTES) != hipSuccess || per_cu < 1) { fprintf(stderr, "kernel_launch: occupancy query says %d\n", per_cu); (void)hipGetLastError(); }
        grid = cus > 256 ? 256 : cus;
    }
    if (grid < 0) return;
    (void)hipMemsetAsync((char*)d_ws + WS_CTL, 0, CTL_ZERO_BYTES, stream);
    Args a{};
    for (int i = 0; i < NIN; ++i) a.in[i] = (const float*)d_in[i];
    a.out = (float*)d_out; a.ws = (unsigned char*)d_ws;
#if MK_ONE_LAUNCH
    a.ph_lo = 0; a.ph_hi = NPHASE;
    hipLaunchKernelGGL(fwd_kernel, dim3(grid), dim3(NWAVES * 64), LDS_BYTES, stream, a);
#else
#ifndef RUN_PHASES
#define RUN_PHASES NPHASE
#endif
    for (int p = 0; p < RUN_PHASES; ++p) { a.ph_lo = p; a.ph_hi = p + 1; hipLaunchKernelGGL(fwd_kernel, dim3(grid), dim3(NWAVES * 64), LDS_BYTES, stream, a); }
#endif
}
```

```cpp
#include <hip/hip_runtime.h>
#include <cstdio>
#include <cstdint>

#ifndef MK_ONE_LAUNCH
#define MK_ONE_LAUNCH 1
#endif

#define GAS __attribute__((address_space(1)))
#define LAS __attribute__((address_space(3)))
typedef unsigned short bf16;
typedef float f32x4 __attribute__((ext_vector_type(4)));
typedef float f32x2 __attribute__((ext_vector_type(2)));
typedef short bf16x8 __attribute__((ext_vector_type(8)));
typedef unsigned u32x4 __attribute__((ext_vector_type(4)));
typedef unsigned u32x2 __attribute__((ext_vector_type(2)));
typedef int i32x4 __attribute__((ext_vector_type(4)));
typedef int i32x8 __attribute__((ext_vector_type(8)));
typedef GAS unsigned gu32;
#define RLX_AGENT __ATOMIC_RELAXED, __HIP_MEMORY_SCOPE_AGENT

constexpr int D = 2048, NB = 4, SEQ = 8192, T = NB * SEQ, CTXL = 256, TC = NB * CTXL;
constexpr int FW = 1024, SW = 512, INW = 5632;
constexpr int SG = 32, SH = 16, SP = 64, LC = 32, NCH = 264, NCTXCH = 8, A2LD = 768;
constexpr int NE = 32, DE = 1024, ECAP = 32768;
constexpr float LN_EPS = 1e-5f;
constexpr float DN_ALPHA = 1.189207115002721f;
constexpr int NPHASE = 14;

constexpr size_t MiB = 1u << 20;
constexpr size_t WS_CTL = 0, CTL_ZERO_BYTES = 64 * 1024;
constexpr size_t WS_MODPART = 1 * MiB;
constexpr size_t WS_MODV = 5 * MiB;
constexpr size_t WS_PW = 6 * MiB;
constexpr size_t WS_BBAR = 8 * MiB;
constexpr size_t WS_LAML = 9 * MiB;
constexpr size_t WS_LAMSEG = 9 * MiB + 512 * 1024;
constexpr size_t WS_KLAG = 10 * MiB;
constexpr size_t WS_RW = 12 * MiB;
constexpr size_t WS_ROWLIST = 13 * MiB;
constexpr size_t WS_FKT = 17 * MiB;
constexpr size_t WS_FCT = 17 * MiB + 256 * 1024;
constexpr size_t WS_FRT = 17 * MiB + 512 * 1024;
constexpr size_t WS_WRTHI = 17 * MiB + 768 * 1024;
constexpr size_t WS_WRTLO = 18 * MiB;
constexpr size_t WS_HC = 19 * MiB;
constexpr size_t WS_WINT = 24 * MiB;
constexpr size_t WS_WG8 = 32 * MiB;
constexpr size_t WS_WFT = 46 * MiB;
constexpr size_t WS_WST = 50 * MiB;
constexpr size_t WS_WOT = 52 * MiB;
constexpr size_t WS_WGLUT = 60 * MiB;
constexpr size_t WS_WET = 61 * MiB;
constexpr size_t WS_TV = 69 * MiB;
constexpr size_t WS_W13T = 96 * MiB;
constexpr size_t WS_XMID = 224 * MiB;
constexpr size_t WS_W2T = 352 * MiB;
constexpr size_t WS_R3 = 480 * MiB;
constexpr size_t WS_RA = 608 * MiB;
constexpr size_t WS_RB = 736 * MiB;
constexpr size_t WS_UF = WS_RB;
constexpr size_t WS_A2 = WS_RB + 64 * MiB;
constexpr size_t WS_E = WS_RB + 114 * MiB;
constexpr size_t WS_YS = WS_RB + 148 * MiB;
constexpr size_t WS_SOUT = WS_RB + 180 * MiB;
constexpr size_t WS_END = 992 * MiB;
constexpr int CW_TMO = 0, CW_BAR = 4096, CW_CNT = 8192;

constexpr int RING_BYTES = 131072;
constexpr int MISC_OFF = 147456;
constexpr int LDS_BYTES = 155648;
constexpr int NWAVES = 8;

typedef __bf16 bf16x2_t __attribute__((ext_vector_type(2)));
__device__ __forceinline__ unsigned pk_bf16(float lo, float hi) { const bf16x2_t r = __builtin_convertvector((f32x2){lo, hi}, bf16x2_t); return __builtin_bit_cast(unsigned, r); }
__device__ __forceinline__ float bf_lo(unsigned u) { return __uint_as_float(u << 16); }
__device__ __forceinline__ float bf_hi(unsigned u) { return __uint_as_float(u & 0xffff0000u); }
__device__ __forceinline__ bf16 f2bf(float f) { unsigned u = __float_as_uint(f); return (bf16)((u + 0x7fffu + ((u >> 16) & 1u)) >> 16); }
__device__ __forceinline__ float bf2f(bf16 b) { return __uint_as_float(((unsigned)b) << 16); }
__device__ __forceinline__ float fsigmoid(float x) { return __builtin_amdgcn_rcpf(1.0f + __builtin_amdgcn_exp2f(-1.44269504f * x)); }
__device__ __forceinline__ void st16_bf16(bf16* dst, f32x4 a, f32x4 b, f32x4 c, f32x4 d) {
    u32x4 w0, w1; w0.x = pk_bf16(a[0], a[1]); w0.y = pk_bf16(a[2], a[3]); w0.z = pk_bf16(b[0], b[1]); w0.w = pk_bf16(b[2], b[3]);
    w1.x = pk_bf16(c[0], c[1]); w1.y = pk_bf16(c[2], c[3]); w1.z = pk_bf16(d[0], d[1]); w1.w = pk_bf16(d[2], d[3]);
    *(u32x4*)dst = w0; *(u32x4*)(dst + 8) = w1; }
__device__ __forceinline__ unsigned pk4_u8(float a, float b, float c, float d) {
    const unsigned ya = __builtin_bit_cast(unsigned, a * 255.0f + 8388608.0f), yb = __builtin_bit_cast(unsigned, b * 255.0f + 8388608.0f), yc = __builtin_bit_cast(unsigned, c * 255.0f + 8388608.0f), yd = __builtin_bit_cast(unsigned, d * 255.0f + 8388608.0f);
    const unsigned w01 = __builtin_amdgcn_perm(yb, ya, 0x0c0c0400u), w23 = __builtin_amdgcn_perm(yd, yc, 0x0c0c0400u);
    return __builtin_amdgcn_perm(w23, w01, 0x05040100u); }
__device__ __forceinline__ f32x4 u8x4_f32(unsigned w) { return (f32x4){(float)(w & 0xffu), (float)((w >> 8) & 0xffu), (float)((w >> 16) & 0xffu), (float)(w >> 24)}; }
__device__ __forceinline__ float gelu_tanh(float x) { return x * fsigmoid(1.5957691216f * (x + 0.044715f * x * x * x)); }
__device__ __forceinline__ float wave_sum(float v) {
#pragma unroll
    for (int o = 1; o < 64; o <<= 1) v += __shfl_xor(v, o);
    return v;
}
constexpr float W8_SCALE = 64.0f, W8_INV = 1.0f / 64.0f;
__device__ __forceinline__ float clamp8(float x) { return __builtin_amdgcn_fmed3f(x, -448.0f, 448.0f); }
__device__ __forceinline__ unsigned pk4_fp8(float a, float b, float c, float d) { int w = 0; w = __builtin_amdgcn_cvt_pk_fp8_f32(clamp8(a), clamp8(b), w, false); w = __builtin_amdgcn_cvt_pk_fp8_f32(clamp8(c), clamp8(d), w, true); return (unsigned)w; }
#define LDS_WAIT() asm volatile("s_waitcnt lgkmcnt(0)" ::: "memory")
#define VM_WAIT() asm volatile("s_waitcnt vmcnt(0)" ::: "memory")

#define XB_TMO      128
#define XB_XCNT(j)  (256  + 64 * (j))
#define XB_XSUB(j)  (1280 + 64 * (j))
#define XB_XGEN(j)  (2304 + 64 * (j))
#define XB_TOP      3328
#define XB_TOPGEN   3392
#define XCD_BAR_WORDS 3456
#define XB_SPIN_CAP (1u << 18)
__device__ __forceinline__ unsigned xb_ld(unsigned* p)              { return __hip_atomic_load(p, __ATOMIC_RELAXED, __HIP_MEMORY_SCOPE_AGENT); }
__device__ __forceinline__ unsigned xb_add(unsigned* p, unsigned v) { return __hip_atomic_fetch_add(p, v, __ATOMIC_RELAXED, __HIP_MEMORY_SCOPE_AGENT); }
__device__ __forceinline__ unsigned xb_xcc_id() { return (unsigned)__builtin_amdgcn_s_getreg((3 << 11) | 20) & 0xFu; }
#define XB_SPIN(cond, bar) do { unsigned _sp = 0; while (cond) { __builtin_amdgcn_s_sleep(1); \
    if ((++_sp & 255u) == 0u) { if (xb_ld(&(bar)[XB_TMO])) break; if (_sp > XB_SPIN_CAP) { atomicAdd(&(bar)[XB_TMO], 1u); break; } } } } while (0)
struct XcdBarrier { unsigned* bar; unsigned x; volatile LAS unsigned* st; };
__device__ __forceinline__ XcdBarrier xcd_barrier_post(unsigned* bar, volatile LAS unsigned* st) {
    XcdBarrier b; b.bar = bar; b.x = xb_xcc_id(); b.st = st;
    if (threadIdx.x == 0) (void)xb_add(&bar[XB_XCNT(b.x)], 1u);
    return b;
}
__device__ __forceinline__ void xcd_barrier_complete(unsigned* bar, unsigned x, unsigned& nloc, unsigned& nx) {
    const unsigned G = gridDim.x * gridDim.y * gridDim.z;
    unsigned sum, cnt, mine, sp = 0u;
    for (;;) {
        sum = 0u; cnt = 0u; mine = 0u;
#pragma unroll
        for (unsigned j = 0; j < 16; ++j) { const unsigned c = xb_ld(&bar[XB_XCNT(j)]); sum += c; cnt += (c > 0u) ? 1u : 0u; mine = (j == x) ? c : mine; }
        if (sum == G) break;
        __builtin_amdgcn_s_sleep(1);
        if ((++sp & 255u) == 0u) { if (xb_ld(&bar[XB_TMO])) break; if (sp > XB_SPIN_CAP) { atomicAdd(&bar[XB_TMO], 1u); break; } }
    }
    nloc = mine > 0u ? mine : 1u; nx = cnt > 0u ? cnt : 1u;
}
__device__ __forceinline__ void xcd_barrier(const XcdBarrier& b) {
    asm volatile("s_waitcnt vmcnt(0)" ::: "memory");
    __syncthreads();
    if (threadIdx.x == 0) {
        unsigned* bar = b.bar;
        __builtin_amdgcn_s_waitcnt(0);
        unsigned nloc = b.st[0], nx = b.st[1];
        if (nloc == 0u) { xcd_barrier_complete(bar, b.x, nloc, nx); b.st[0] = nloc; b.st[1] = nx; }
        const unsigned old = xb_add(&bar[XB_XSUB(b.x)], 1u);
        const unsigned gen = old / nloc;
        if (old + 1u == (gen + 1u) * nloc) {
            __builtin_amdgcn_fence(__ATOMIC_RELEASE, "agent");
            asm volatile("s_waitcnt vmcnt(0)" ::: "memory");
            const unsigned og = xb_add(&bar[XB_TOP], 1u);
            const unsigned tg = og / nx;
            if (og + 1u == (tg + 1u) * nx) xb_add(&bar[XB_TOPGEN], 1u);
            else XB_SPIN(xb_ld(&bar[XB_TOPGEN]) == tg, bar);
            __builtin_amdgcn_fence(__ATOMIC_ACQUIRE, "agent");
            xb_add(&bar[XB_XGEN(b.x)], 1u);
            asm volatile("s_waitcnt vmcnt(0)" ::: "memory");
        } else {
            XB_SPIN(xb_ld(&bar[XB_XGEN(b.x)]) == gen, bar);
            __builtin_amdgcn_fence(__ATOMIC_ACQUIRE, "agent");
            asm volatile("s_waitcnt vmcnt(0)" ::: "memory");
        }
    }
    __syncthreads();
}

namespace pg8 {
#define PG8_LAS __attribute__((address_space(3)))
constexpr int BM = 256, BK = 64, HALF = 128, HTB = HALF * BK * 2, STAGE_BYTES = 8 * HTB, NXCD = 8, WGM = 8;
__host__ __device__ __forceinline__ int lds_byte(int r, int c) { const int st = (r >> 4) * 2 + (c >> 5), rr = r & 15, cc = c & 31, ob = rr * 64 + cc * 2; return st * 1024 + (ob ^ (((ob >> 9) & 1) << 5)); }
__host__ __device__ __forceinline__ void stage_rc(int b, int& R, int& C) { const int st = b / 1024, sb = b % 1024, swz = sb ^ (((sb >> 9) & 1) << 5); R = (st >> 1) * 16 + swz / 64; C = (st & 1) * 32 + (swz % 64) / 2; }
__host__ __device__ __forceinline__ int perm32(int rho) { const int n = rho >> 4, i = rho & 15; return 8 * (i >> 2) + 4 * n + (i & 3); }

struct GUnit { const char* A; const char* B; int nt, x0, x1, x2, x3; };
template <class E, class = void> struct HasSeg { static constexpr bool v = false; };
template <class E> struct HasSeg<E, decltype((void)E::SEG2)> { static constexpr bool v = E::SEG2; };
template <class E, class = void> struct HasP16 { static constexpr bool v = false; };
template <class E> struct HasP16<E, decltype((void)E::PERM16)> { static constexpr bool v = E::PERM16; };

struct RectOrder {
    int nM, nN, nwg, G, c;
    __device__ __forceinline__ void init(int nM_, int nN_, int G_, int c_) { nM = nM_; nN = nN_; nwg = nM * nN; G = G_; c = c_; }
    __device__ __forceinline__ bool get(int i, int& pm, int& pn) const {
        const long L = (long)i * G + c; if (L >= nwg) return false;
        int wgid = (int)L; { const int q = nwg / NXCD, r = nwg % NXCD, xcd = wgid % NXCD, off = wgid / NXCD; wgid = (xcd < r ? xcd * (q + 1) : r * (q + 1) + (xcd - r) * q) + off; }
        const int nig = WGM * nN, gid = wgid / nig, fm = gid * WGM, gsz = (nM - fm) < WGM ? (nM - fm) : WGM;
        pm = fm + ((wgid % nig) % gsz); pn = (wgid % nig) / gsz; return true;
    }
};

template <class Epi, class Sched, bool ALIGN_EPI = true, bool F8 = false>
__device__ __forceinline__ void gemm_phase(PG8_LAS unsigned char* lds, const Sched& S, const Epi& E) {
    const int tid = threadIdx.x, wid = __builtin_amdgcn_readfirstlane(tid >> 6), lane = tid & 63, wr = wid >> 2, wc = wid & 3, fr = lane & 15, fq = lane >> 4;
    int Rs[2], Cs[2];
#pragma unroll
    for (int i = 0; i < 2; ++i) stage_rc(tid * 16 + i * 8192, Rs[i], Cs[i]);
    unsigned voffB[2][2], voffA[2][2], voffAn[2][2];
#pragma unroll
    for (int h = 0; h < 2; ++h)
#pragma unroll
        for (int i = 0; i < 2; ++i) {
            if constexpr (HasP16<Epi>::v) { const int r = Rs[i]; voffB[h][i] = S.b_off(64 * (r >> 5) + 16 * ((r & 15) >> 2) + 8 * h + 4 * ((r >> 4) & 1) + (r & 3), Cs[i]); }
            else { const int Rb = Epi::PERM ? ((Rs[i] & ~31) + perm32(Rs[i] & 31)) : Rs[i]; voffB[h][i] = S.b_off(h * HALF + Rb, Cs[i]); } }
    const size_t kstep = (size_t)(BK * 2);
    const unsigned ldsw = (unsigned)wid * 1024u;
    const int aoff = lds_byte(wr * 64 + fr, fq * 8), boff = lds_byte(wc * 32 + fr, fq * 8);
#define PG8_SA(b, h) (((b) * 2 + (h)) * HTB)
#define PG8_SB(b, h) ((4 + (b) * 2 + (h)) * HTB)
#define PG8_STAGE(bufoff, gbase, voff) do { _Pragma("unroll") for (int _i = 0; _i < 2; ++_i) \
        __builtin_amdgcn_global_load_lds((const unsigned*)((const char*)(gbase) + (voff)[_i]), (PG8_LAS unsigned*)(lds + (bufoff) + ldsw + _i * 8192), 16, 0, 0); } while (0)
#define PG8_LDA(dst, b, h) do { if constexpr (F8) { _Pragma("unroll") for (int m = 0; m < 4; ++m) dst##8[m] = __builtin_shufflevector(*(const PG8_LAS i32x4*)(lds + PG8_SA(b, h) + aoff + m * 2048), *(const PG8_LAS i32x4*)(lds + PG8_SA(b, h) + aoff + m * 2048 + 1024), 0, 1, 2, 3, 4, 5, 6, 7); } \
        else { _Pragma("unroll") for (int m = 0; m < 4; ++m) _Pragma("unroll") for (int k = 0; k < 2; ++k) dst[m][k] = *(const PG8_LAS bf16x8*)(lds + PG8_SA(b, h) + aoff + m * 2048 + k * 1024); } } while (0)
#define PG8_LDB(dst, b, h) do { if constexpr (F8) { _Pragma("unroll") for (int n = 0; n < 2; ++n) dst##8[n] = __builtin_shufflevector(*(const PG8_LAS i32x4*)(lds + PG8_SB(b, h) + boff + n * 2048), *(const PG8_LAS i32x4*)(lds + PG8_SB(b, h) + boff + n * 2048 + 1024), 0, 1, 2, 3, 4, 5, 6, 7); } \
        else { _Pragma("unroll") for (int n = 0; n < 2; ++n) _Pragma("unroll") for (int k = 0; k < 2; ++k) dst[n][k] = *(const PG8_LAS bf16x8*)(lds + PG8_SB(b, h) + boff + n * 2048 + k * 1024); } } while (0)
#define PG8_MMA(ai, bj, At, Bt) do { __builtin_amdgcn_s_setprio(1); _Pragma("unroll") for (int m = 0; m < 4; ++m) _Pragma("unroll") for (int n = 0; n < 2; ++n) { \
        if constexpr (F8) { asm volatile("v_mfma_scale_f32_16x16x128_f8f6f4 %0, %1, %2, %0, %3, %3 op_sel_hi:[0,0,0]" : "+v"(acc[ai][bj][m][n]) : "v"(Bt##8[n]), "v"(At##8[m]), "v"(f8scale)); } \
        else { _Pragma("unroll") for (int k = 0; k < 2; ++k) acc[ai][bj][m][n] = __builtin_amdgcn_mfma_f32_16x16x32_bf16(Bt[n][k], At[m][k], acc[ai][bj][m][n], 0, 0, 0); } } \
        if constexpr (F8) asm volatile("s_nop 3" ::: "memory");     \
        __builtin_amdgcn_s_setprio(0); } while (0)
#define PG8_WAIT_V(n) asm volatile("s_waitcnt vmcnt(" #n ")" ::: "memory")
#define PG8_WAIT_L(n) asm volatile("s_waitcnt lgkmcnt(" #n ")" ::: "memory")
#define PG8_BAR __builtin_amdgcn_s_barrier()
#define PG8_SCHED __builtin_amdgcn_sched_barrier(0)
    GUnit cur, nxt; int ui = 0;
    if (!S.next(0, cur)) return;
    S.a_off(cur, Rs, Cs, voffA);
#pragma unroll
    for (int h = 0; h < 2; ++h)
#pragma unroll
        for (int i = 0; i < 2; ++i) voffAn[h][i] = voffA[h][i];
    f32x4 acc[2][2][4][2];
#pragma unroll
    for (int a = 0; a < 2; ++a)
#pragma unroll
        for (int b = 0; b < 2; ++b)
#pragma unroll
            for (int m = 0; m < 4; ++m)
#pragma unroll
                for (int n = 0; n < 2; ++n) acc[a][b][m][n] = (f32x4){0.f, 0.f, 0.f, 0.f};
    bf16x8 At[4][2], B0[2][2], B1[2][2]; i32x8 At8[4], B08[2], B18[2];
    const int f8scale = 0x7F7F7F7F;
    const char* cA = cur.A; const char* cB = cur.B;
    PG8_STAGE(PG8_SB(0, 0), cB, voffB[0]); PG8_STAGE(PG8_SB(0, 1), cB, voffB[1]); PG8_STAGE(PG8_SA(0, 0), cA, voffA[0]); PG8_STAGE(PG8_SA(0, 1), cA, voffA[1]);
    if (wr == 1) PG8_BAR;
    PG8_WAIT_V(2); PG8_BAR;
    PG8_STAGE(PG8_SB(1, 0), cB + kstep, voffB[0]); PG8_STAGE(PG8_SA(1, 0), cA + kstep, voffA[0]); PG8_STAGE(PG8_SB(1, 1), cB + kstep, voffB[1]);
    PG8_WAIT_V(6); PG8_BAR;
    for (;;) {
        const bool has_next = S.next(ui + 1, nxt);
        const char* nA = has_next ? nxt.A : cA; const char* nB = has_next ? nxt.B : cB;
        const int nt = cur.nt;
#pragma unroll 1
        for (int t = 0; t < nt; t += 2) {
            const bool last = (t == nt - 2);
            if constexpr (Sched::GATHER) { if (last && has_next) S.a_off(nxt, Rs, Cs, voffAn); }
            const char* a1 = cA + (size_t)(t + 1) * kstep;
            const char* a2 = last ? nA : cA + (size_t)(t + 2) * kstep; const char* b2 = last ? nB : cB + (size_t)(t + 2) * kstep;
            const char* a3 = a2 + kstep; const char* b3 = b2 + kstep;
            unsigned vA2[2][2];
#pragma unroll
            for (int h = 0; h < 2; ++h)
#pragma unroll
                for (int i = 0; i < 2; ++i) { if constexpr (Sched::GATHER) vA2[h][i] = (last && has_next) ? voffAn[h][i] : voffA[h][i]; else vA2[h][i] = voffA[h][i]; }
            PG8_LDB(B0, 0, 0); PG8_LDB(B1, 0, 1); PG8_SCHED; PG8_LDA(At, 0, 0); PG8_STAGE(PG8_SA(1, 1), a1, voffA[1]);
            PG8_WAIT_V(8); PG8_WAIT_L(0); PG8_BAR; PG8_MMA(0, 0, At, B0); PG8_MMA(0, 1, At, B1); PG8_BAR; PG8_SCHED;
            PG8_LDA(At, 0, 1); PG8_STAGE(PG8_SB(0, 0), b2, voffB[0]); PG8_STAGE(PG8_SB(0, 1), b2, voffB[1]); PG8_STAGE(PG8_SA(0, 0), a2, vA2[0]);
            PG8_WAIT_V(8); PG8_WAIT_L(0); PG8_BAR; PG8_MMA(1, 0, At, B0); PG8_MMA(1, 1, At, B1); PG8_BAR; PG8_SCHED;
            PG8_LDB(B0, 1, 0); PG8_LDB(B1, 1, 1); PG8_SCHED; PG8_LDA(At, 1, 0); PG8_STAGE(PG8_SA(0, 1), a2, vA2[1]);
            PG8_WAIT_V(8); PG8_WAIT_L(0); PG8_BAR; PG8_MMA(0, 0, At, B0); PG8_MMA(0, 1, At, B1); PG8_BAR; PG8_SCHED;
            PG8_LDA(At, 1, 1); PG8_STAGE(PG8_SB(1, 0), b3, voffB[0]); PG8_STAGE(PG8_SB(1, 1), b3, voffB[1]); PG8_STAGE(PG8_SA(1, 0), a3, vA2[0]);
            PG8_WAIT_V(8); PG8_WAIT_L(0); PG8_BAR; PG8_MMA(1, 0, At, B0); PG8_MMA(1, 1, At, B1); PG8_BAR; PG8_SCHED;
        }
        if constexpr (ALIGN_EPI) { if (wr == 0) PG8_BAR; }
        if constexpr (F8) {
#pragma unroll
            for (int a = 0; a < 2; ++a)
#pragma unroll
                for (int b = 0; b < 2; ++b)
                    asm volatile("s_nop 15\n\ts_nop 7" : "+v"(acc[a][b][0][0]), "+v"(acc[a][b][0][1]), "+v"(acc[a][b][1][0]), "+v"(acc[a][b][1][1]), "+v"(acc[a][b][2][0]), "+v"(acc[a][b][2][1]), "+v"(acc[a][b][3][0]), "+v"(acc[a][b][3][1]));
        }
        E(acc, cur, wr, wc, fr, fq);
        if (!has_next) break;
        if (!(HasSeg<Epi>::v && cur.x2 == 0)) {
#pragma unroll
        for (int a = 0; a < 2; ++a)
#pragma unroll
            for (int b = 0; b < 2; ++b)
#pragma unroll
                for (int m = 0; m < 4; ++m)
#pragma unroll
                    for (int n = 0; n < 2; ++n) acc[a][b][m][n] = (f32x4){0.f, 0.f, 0.f, 0.f};
        }
        cur = nxt; cA = nA; cB = nB; ++ui;
#pragma unroll
        for (int h = 0; h < 2; ++h)
#pragma unroll
            for (int i = 0; i < 2; ++i) voffA[h][i] = voffAn[h][i];
        if constexpr (ALIGN_EPI) { if (wr == 1) PG8_BAR; }
    }
    PG8_WAIT_V(0);
    if constexpr (!ALIGN_EPI) { if (wr == 0) PG8_BAR; }
    PG8_BAR;
#undef PG8_SA
#undef PG8_SB
#undef PG8_STAGE
#undef PG8_LDA
#undef PG8_LDB
#undef PG8_MMA
#undef PG8_WAIT_V
#undef PG8_WAIT_L
#undef PG8_BAR
#undef PG8_SCHED
}
}
using pg8::GUnit;
typedef const f32x4 (&AccRef)[2][2][4][2];


struct SchedRect {
    static constexpr bool GATHER = false;
    pg8::RectOrder o; const char* A; const char* B; int lda, ldb, nt;
    __device__ __forceinline__ bool next(int i, GUnit& u) const { int pm, pn; if (!o.get(i, pm, pn)) return false;
        u.A = A + (size_t)pm * 256 * lda * 2; u.B = B + (size_t)pn * 256 * ldb * 2; u.nt = nt; u.x0 = pm; u.x1 = pn; u.x2 = 0; u.x3 = 0; return true; }
    __device__ __forceinline__ unsigned b_off(int R, int C) const { return (unsigned)(R * ldb + C) * 2u; }
    __device__ __forceinline__ void a_off(const GUnit&, const int (&R)[2], const int (&C)[2], unsigned (&v)[2][2]) const {
#pragma unroll
        for (int h = 0; h < 2; ++h)
#pragma unroll
            for (int i = 0; i < 2; ++i) v[h][i] = (unsigned)((h * 128 + R[i]) * lda + C[i]) * 2u; }
};
struct SchedRectOff {
    static constexpr bool GATHER = false;
    pg8::RectOrder o; const char* A; const char* B; int lda, ldb, nt, pn0;
    __device__ __forceinline__ bool next(int i, GUnit& u) const { int pm, pn; if (!o.get(i, pm, pn)) return false;
        u.A = A + (size_t)pm * 256 * lda * 2; u.B = B + (size_t)pn * 256 * ldb * 2; u.nt = nt; u.x0 = pm; u.x1 = pn + pn0; u.x2 = 0; u.x3 = 0; return true; }
    __device__ __forceinline__ unsigned b_off(int R, int C) const { return (unsigned)(R * ldb + C) * 2u; }
    __device__ __forceinline__ void a_off(const GUnit&, const int (&R)[2], const int (&C)[2], unsigned (&v)[2][2]) const {
#pragma unroll
        for (int h = 0; h < 2; ++h)
#pragma unroll
            for (int i = 0; i < 2; ++i) v[h][i] = (unsigned)((h * 128 + R[i]) * lda + C[i]) * 2u; }
};
struct SchedMerge {
    static constexpr bool GATHER = false; static constexpr int PITCH = SW + FW;
    pg8::RectOrder o; const char* A; const char* B;
    __device__ __forceinline__ bool next(int i, GUnit& u) const { int pm, pn; if (!o.get(i >> 1, pm, pn)) return false; const int seg = i & 1;
        u.A = A + (size_t)pm * 256 * PITCH + seg * SW; u.B = B + (size_t)pn * 256 * PITCH + seg * SW; u.nt = seg ? FW / 128 : SW / 128; u.x0 = pm; u.x1 = pn; u.x2 = seg; u.x3 = 0; return true; }
    __device__ __forceinline__ unsigned b_off(int R, int C) const { return (unsigned)(R * PITCH + C * 2); }
    __device__ __forceinline__ void a_off(const GUnit&, const int (&R)[2], const int (&C)[2], unsigned (&v)[2][2]) const {
#pragma unroll
        for (int h = 0; h < 2; ++h)
#pragma unroll
            for (int i = 0; i < 2; ++i) v[h][i] = (unsigned)((h * 128 + R[i]) * PITCH + C[i] * 2); }
};
struct SchedE {
    static constexpr bool GATHER = false;
    int G, c; const char* A2; const char* WeT;
    __device__ __forceinline__ bool next(int i, GUnit& u) const { const int L = i * G + c; if (L >= 128) return false; const int g = L >> 2, b = L & 3;
        u.A = A2 + ((size_t)((g * 4 + b) * NCH + NCTXCH) * A2LD) * 2; u.B = WeT + (size_t)g * 256 * 512 * 2; u.nt = 8; u.x0 = g; u.x1 = b; u.x2 = 0; u.x3 = 0; return true; }
    __device__ __forceinline__ unsigned b_off(int R, int C) const { return (unsigned)(R * 512 + C) * 2u; }
    __device__ __forceinline__ void a_off(const GUnit&, const int (&R)[2], const int (&C)[2], unsigned (&v)[2][2]) const {
#pragma unroll
        for (int h = 0; h < 2; ++h)
#pragma unroll
            for (int i = 0; i < 2; ++i) v[h][i] = (unsigned)((h * 128 + R[i]) * A2LD + C[i]) * 2u; }
};
struct SchedSSM {
    static constexpr bool GATHER = false;
    int G, c; const char* A2; const char* TV;
    __device__ __forceinline__ bool next(int i, GUnit& u) const { const int L = i * G + c; if (L >= 256) return false; const int g = L >> 3, b = (L >> 1) & 3, pn = L & 1;
        u.A = A2 + ((size_t)((g * 4 + b) * NCH + NCTXCH) * A2LD) * 2; u.B = TV + ((size_t)(g * 512 + pn * 256) * A2LD) * 2; u.nt = 12; u.x0 = g; u.x1 = b; u.x2 = pn; u.x3 = 0; return true; }
    __device__ __forceinline__ unsigned b_off(int R, int C) const { return (unsigned)(R * A2LD + C) * 2u; }
    __device__ __forceinline__ void a_off(const GUnit&, const int (&R)[2], const int (&C)[2], unsigned (&v)[2][2]) const {
#pragma unroll
        for (int h = 0; h < 2; ++h)
#pragma unroll
            for (int i = 0; i < 2; ++i) v[h][i] = (unsigned)((h * 128 + R[i]) * A2LD + C[i]) * 2u; }
};
struct SchedF1 {
    static constexpr bool GATHER = false;
    int G, c; const char* FkT; const char* UF;
    __device__ __forceinline__ bool next(int i, GUnit& u) const { const int L = i * G + c; if (L >= 1024) return false; const int pn = L >> 1, pm = L & 1;
        u.A = FkT + (size_t)pm * 256 * 256 * 2; u.B = UF + (size_t)pn * 64 * FW * 2; u.nt = 4; u.x0 = pm; u.x1 = pn; u.x2 = 0; u.x3 = 0; return true; }
    __device__ __forceinline__ unsigned b_off(int R, int C) const { const int g = R >> 6, cc = R & 63; return (unsigned)(cc * FW + g * 256 + C) * 2u; }
    __device__ __forceinline__ void a_off(const GUnit&, const int (&R)[2], const int (&C)[2], unsigned (&v)[2][2]) const {
#pragma unroll
        for (int h = 0; h < 2; ++h)
#pragma unroll
            for (int i = 0; i < 2; ++i) v[h][i] = (unsigned)((h * 128 + R[i]) * 256 + C[i]) * 2u; }
};
struct SchedF2 {
    static constexpr bool GATHER = false;
    int G, c; const char* FcT; const char* Z1T;
    __device__ __forceinline__ bool next(int i, GUnit& u) const { const int L = i * G + c; if (L >= 2048) return false; const int b = L >> 9, g = (L >> 7) & 3, kp = L & 127;
        u.A = FcT; u.B = Z1T + ((size_t)((b * 128) * 4 + g) * 256 + 2 * kp) * 128 * 2; u.nt = 2; u.x0 = b; u.x1 = g; u.x2 = 2 * kp; u.x3 = 0; return true; }
    __device__ __forceinline__ unsigned b_off(int R, int C) const { const int dk = R >> 7, r = R & 127; return (unsigned)(r * (4 * 256 * 128) + dk * 128 + C) * 2u; }
    __device__ __forceinline__ void a_off(const GUnit&, const int (&R)[2], const int (&C)[2], unsigned (&v)[2][2]) const {
#pragma unroll
        for (int h = 0; h < 2; ++h)
#pragma unroll
            for (int i = 0; i < 2; ++i) v[h][i] = (unsigned)((h * 128 + R[i]) * 128 + C[i]) * 2u; }
};
struct SchedF3 {
    static constexpr bool GATHER = false;
    int G, c; const char* FrT; const char* Z2T;
    __device__ __forceinline__ bool next(int i, GUnit& u) const { const int L = i * G + c; if (L >= 1024) return false; const int b = L >> 8, cp = (L >> 2) & 63, g = L & 3;
        u.A = FrT; u.B = Z2T + ((size_t)((b * 4 + g) * 256) * 64 + cp) * 256 * 2; u.nt = 4; u.x0 = b; u.x1 = cp; u.x2 = g; u.x3 = 0; return true; }
    __device__ __forceinline__ unsigned b_off(int R, int C) const { return (unsigned)(R * (64 * 256) + C) * 2u; }
    __device__ __forceinline__ void a_off(const GUnit&, const int (&R)[2], const int (&C)[2], unsigned (&v)[2][2]) const {
#pragma unroll
        for (int h = 0; h < 2; ++h)
#pragma unroll
            for (int i = 0; i < 2; ++i) v[h][i] = (unsigned)((h * 128 + R[i]) * 256 + C[i]) * 2u; }
};
template <int SHIFT, int PA, int PB, int NT> struct SchedMoe {
    static constexpr bool GATHER = true;
    int G, c; const char* Abase; const char* Bbase; const int* rowlist; const LAS int* pre; const LAS int* cnt;
    __device__ __forceinline__ bool next(int i, GUnit& u) const { const int L = i * G + c; const int ti = L >> 3, ct = L & 7; if (ti >= __builtin_amdgcn_readfirstlane(pre[NE])) return false;
        int e = 0;
#pragma unroll 1
        for (int s = 16; s >= 1; s >>= 1) if (pre[e + s] <= ti) e += s;
        e = __builtin_amdgcn_readfirstlane(e);
        u.A = Abase; u.B = Bbase + (size_t)(e * 2048 + ct * 256) * PB; u.nt = NT; u.x0 = e; u.x1 = ti - __builtin_amdgcn_readfirstlane(pre[e]); u.x2 = ct; u.x3 = __builtin_amdgcn_readfirstlane(cnt[e]); return true; }
    __device__ __forceinline__ unsigned b_off(int R, int C) const { return (unsigned)(R * PB + C * 2); }
    __device__ __forceinline__ void a_off(const GUnit& u, const int (&R)[2], const int (&C)[2], unsigned (&v)[2][2]) const {
        const int* rl = rowlist + (size_t)u.x0 * ECAP; const int base = u.x1 * 256, cm = u.x3 - 1;
#pragma unroll
        for (int h = 0; h < 2; ++h)
#pragma unroll
            for (int i = 0; i < 2; ++i) { int p = base + h * 128 + R[i]; p = p < cm ? p : cm; const unsigned ent = (unsigned)rl[p]; v[h][i] = (ent >> SHIFT) * (unsigned)PA + (unsigned)C[i] * 2u; } }
};

template <bool S8> struct EpiInProjT {
    static constexpr bool PERM = true, PERM16 = true;
    bf16* UF; bf16* A2; bf16* GZF; bf16* GZS;
    __device__ __forceinline__ void operator()(AccRef acc, const GUnit& u, int wr, int wc, int fr, int fq) const {
        const int pm = u.x0, pn = u.x1; const int col = pn * 256 + wc * 64 + 16 * fq;
#pragma unroll
        for (int ai = 0; ai < 2; ++ai)
#pragma unroll
            for (int m = 0; m < 4; ++m) { const int row = pm * 256 + ai * 128 + wr * 64 + m * 16 + fr; bf16* dst;
                if (pn < 4) dst = UF + (size_t)row * FW + col;
                else { const int g = (col - FW) >> 4, b = row >> 13, t = row & (SEQ - 1); dst = A2 + ((size_t)((g * 4 + b) * NCH + NCTXCH + (t >> 5)) * A2LD + (t & 31) * 16); }
                constexpr float SC = S8 ? W8_INV : 1.0f; st16_bf16(dst, acc[ai][0][m][0] * SC, acc[ai][0][m][1] * SC, acc[ai][1][m][0] * SC, acc[ai][1][m][1] * SC); }
    }
};
typedef EpiInProjT<false> EpiInProj;
struct EpiGates8 {
    static constexpr bool PERM = true, PERM16 = true;
    unsigned char* GZF; unsigned char* GZS;
    __device__ __forceinline__ void operator()(AccRef acc, const GUnit& u, int wr, int wc, int fr, int fq) const {
        const int pm = u.x0, pn = u.x1; unsigned char* base = (pn < 8 ? GZF : GZS) + (size_t)(pm * 256 + wr * 64 + fr) * D + (pn & 7) * 256 + wc * 64 + 16 * fq;
#pragma unroll
        for (int ai = 0; ai < 2; ++ai)
#pragma unroll
            for (int m = 0; m < 4; ++m) { u32x4 w;
#pragma unroll
                for (int bj = 0; bj < 2; ++bj)
#pragma unroll
                    for (int n = 0; n < 2; ++n) { const f32x4 v = acc[ai][bj][m][n]; w[bj * 2 + n] = pk4_u8(fsigmoid(v[0] * W8_INV), fsigmoid(v[1] * W8_INV), fsigmoid(v[2] * W8_INV), fsigmoid(v[3] * W8_INV)); }
                *(u32x4*)(base + (size_t)(ai * 128 + m * 16) * D) = w; }
    }
};
struct EpiE {
    static constexpr bool PERM = false;
    float* E;
    __device__ __forceinline__ void operator()(AccRef acc, const GUnit& u, int wr, int wc, int fr, int fq) const {
        float* base = E + (size_t)((u.x0 * 4 + u.x1) * NCH + NCTXCH) * 256;
#pragma unroll
        for (int ai = 0; ai < 2; ++ai)
#pragma unroll
            for (int m = 0; m < 4; ++m) { float* rowp = base + (size_t)(ai * 128 + wr * 64 + m * 16 + fr) * 256 + wc * 32 + 4 * fq;
#pragma unroll
                for (int bj = 0; bj < 2; ++bj)
#pragma unroll
                    for (int n = 0; n < 2; ++n) *(f32x4*)(rowp + bj * 128 + n * 16) = acc[ai][bj][m][n]; }
    }
};
struct EpiSSM {
    static constexpr bool PERM = true, PERM16 = true;
    bf16* YS;
    __device__ __forceinline__ void operator()(AccRef acc, const GUnit& u, int wr, int wc, int fr, int fq) const {
        const int g = u.x0, b = u.x1, pn = u.x2; const int tt = (pn * 256 + wc * 64 + 16 * fq) >> 4;
#pragma unroll
        for (int ai = 0; ai < 2; ++ai)
#pragma unroll
            for (int m = 0; m < 4; ++m) { const int ch = ai * 128 + wr * 64 + m * 16 + fr; const size_t tok = (size_t)b * SEQ + ch * LC + tt;
                f32x4 v0 = acc[ai][0][m][0], v1 = acc[ai][0][m][1], v2 = acc[ai][1][m][0], v3 = acc[ai][1][m][1];
#pragma unroll
                for (int j = 0; j < 4; ++j) { v0[j] = gelu_tanh(v0[j]); v1[j] = gelu_tanh(v1[j]); v2[j] = gelu_tanh(v2[j]); v3[j] = gelu_tanh(v3[j]); }
                st16_bf16(YS + tok * SW + g * 16, v0, v1, v2, v3); }
    }
};
constexpr float S8_SCALE = 16.0f, S8_INV = 1.0f / 16.0f;
template <int MODE> struct EpiGate {
    static constexpr bool PERM = true, PERM16 = true; static constexpr float ASC = MODE == 0 ? W8_INV / 255.0f : (MODE == 1 ? W8_INV * S8_INV / 255.0f : 1.0f);
    bf16* O; const void* G0; const float* bias; int ld; unsigned char* O8; int ldo;
    __device__ __forceinline__ void operator()(AccRef acc, const GUnit& u, int wr, int wc, int fr, int fq) const {
        const int pm = u.x0, pn = u.x1;
        const size_t off0 = (size_t)(pm * 256 + wr * 64 + fr) * ld + pn * 256 + wc * 64 + 16 * fq;
        f32x4 bv[2][2];
        if (MODE == 2) {
#pragma unroll
            for (int q = 0; q < 4; ++q) bv[q >> 1][q & 1] = *(const f32x4*)(bias + pn * 256 + wc * 64 + 16 * fq + 4 * q); }
#pragma unroll
        for (int ai = 0; ai < 2; ++ai) {
            u32x4 gq[4], yq[4][2], oq[4][2];
#pragma unroll
            for (int m = 0; m < 4; ++m) { const size_t off = off0 + (size_t)(ai * 128 + m * 16) * ld;
                if (MODE == 2) { yq[m][0] = *(const u32x4*)((const bf16*)G0 + off); yq[m][1] = *(const u32x4*)((const bf16*)G0 + off + 8); }
                else gq[m] = __builtin_nontemporal_load((const u32x4*)((const unsigned char*)G0 + off));
                if (MODE == 1) { oq[m][0] = *(const u32x4*)(O + off); oq[m][1] = *(const u32x4*)(O + off + 8); } }
#pragma unroll
            for (int m = 0; m < 4; ++m) { const size_t off = off0 + (size_t)(ai * 128 + m * 16) * ld;
                f32x4 v[2][2];
#pragma unroll
                for (int bj = 0; bj < 2; ++bj)
#pragma unroll
                    for (int n = 0; n < 2; ++n) { const int q = bj * 2 + n; const f32x4 a = acc[ai][bj][m][n];
                        if (MODE == 2) { const unsigned lo = yq[m][bj][2 * n], hi = yq[m][bj][2 * n + 1]; const f32x4 y = (f32x4){bf_lo(lo), bf_hi(lo), bf_lo(hi), bf_hi(hi)};
#pragma unroll
                            for (int j = 0; j < 4; ++j) v[bj][n][j] = y[j] * fsigmoid(a[j] + bv[bj][n][j]) * S8_SCALE; }
                        else { const f32x4 g = u8x4_f32(gq[m][q]);
                            if (MODE == 0) v[bj][n] = a * g * ASC;
                            else { const unsigned lo = oq[m][bj][2 * n], hi = oq[m][bj][2 * n + 1]; v[bj][n] = (f32x4){bf_lo(lo), bf_hi(lo), bf_lo(hi), bf_hi(hi)} + a * g * ASC; } } }
                if (MODE == 0) {
#pragma unroll
                    for (int bj = 0; bj < 2; ++bj) { u32x4 w; w.x = pk_bf16(v[bj][0][0], v[bj][0][1]); w.y = pk_bf16(v[bj][0][2], v[bj][0][3]); w.z = pk_bf16(v[bj][1][0], v[bj][1][1]); w.w = pk_bf16(v[bj][1][2], v[bj][1][3]); *(u32x4*)(O + off + 8 * bj) = w; } }
                else { u32x4 w;
#pragma unroll
                    for (int q = 0; q < 4; ++q) w[q] = pk4_fp8(v[q >> 1][q & 1][0], v[q >> 1][q & 1][1], v[q >> 1][q & 1][2], v[q >> 1][q & 1][3]);
                    const size_t offo = MODE == 2 ? (size_t)(pm * 256 + wr * 64 + fr + ai * 128 + m * 16) * ldo + pn * 256 + wc * 64 + 16 * fq : off;
                    *(u32x4*)(O8 + offo) = w; } }
            asm volatile("" ::: "memory");
        }
    }
};
struct EpiMerge {
    static constexpr bool PERM = true, PERM16 = true, SEG2 = true;
    unsigned char* M8; const unsigned char* GZF; const unsigned char* GZS;
    __device__ __forceinline__ void operator()(f32x4 (&acc)[2][2][4][2], const GUnit& u, int wr, int wc, int fr, int fq) const {
        const size_t off0 = (size_t)(u.x0 * 256 + wr * 64 + fr) * D + u.x1 * 256 + wc * 64 + 16 * fq;
        if (u.x2 == 0) {
#pragma unroll
            for (int ai = 0; ai < 2; ++ai) {
                u32x4 qs[4], qf[4];
#pragma unroll
                for (int m = 0; m < 4; ++m) { const size_t off = off0 + (size_t)(ai * 128 + m * 16) * D; qs[m] = __builtin_nontemporal_load((const u32x4*)(GZS + off)); qf[m] = *(const u32x4*)(GZF + off); }
#pragma unroll
                for (int m = 0; m < 4; ++m)
#pragma unroll
                    for (int q = 0; q < 4; ++q) { const f32x4 s = u8x4_f32(qs[m][q]), f = u8x4_f32(qf[m][q]); f32x4 r;
#pragma unroll
                        for (int j = 0; j < 4; ++j) r[j] = s[j] * S8_INV * __builtin_amdgcn_rcpf(fmaxf(f[j], 0.5f));
                        acc[ai][q >> 1][m][q & 1] *= r; }
                asm volatile("" ::: "memory");
            }
            return;
        }
#pragma unroll
        for (int ai = 0; ai < 2; ++ai) {
            u32x4 qf[4];
#pragma unroll
            for (int m = 0; m < 4; ++m) qf[m] = __builtin_nontemporal_load((const u32x4*)(GZF + off0 + (size_t)(ai * 128 + m * 16) * D));
#pragma unroll
            for (int m = 0; m < 4; ++m) { u32x4 w;
#pragma unroll
                for (int q = 0; q < 4; ++q) { const f32x4 f = u8x4_f32(qf[m][q]); const f32x4 a = acc[ai][q >> 1][m][q & 1]; f32x4 v;
#pragma unroll
                    for (int j = 0; j < 4; ++j) v[j] = a[j] * (fmaxf(f[j], 0.5f) * (W8_INV / 255.0f));
                    w[q] = pk4_fp8(v[0], v[1], v[2], v[3]); }
                *(u32x4*)(M8 + off0 + (size_t)(ai * 128 + m * 16) * D) = w; }
            asm volatile("" ::: "memory");
        }
    }
};
struct EpiOut {
    static constexpr bool PERM = true, PERM16 = true;
    const float* modv; bf16* MG;
    __device__ __forceinline__ void operator()(AccRef acc, const GUnit& u, int wr, int wc, int fr, int fq) const {
        const int pm = u.x0, pn = u.x1; const float* gate = modv + (size_t)(pm >> 5) * 12288 + 2 * D;
        const int col0 = pn * 256 + wc * 64 + 16 * fq;
        const f32x4 gv0 = *(const f32x4*)(gate + col0) * W8_INV, gv1 = *(const f32x4*)(gate + col0 + 4) * W8_INV, gv2 = *(const f32x4*)(gate + col0 + 8) * W8_INV, gv3 = *(const f32x4*)(gate + col0 + 12) * W8_INV;
#pragma unroll
        for (int ai = 0; ai < 2; ++ai)
#pragma unroll
            for (int m = 0; m < 4; ++m) { bf16* rowp = MG + (size_t)(pm * 256 + ai * 128 + wr * 64 + m * 16 + fr) * D + col0;
                st16_bf16(rowp, acc[ai][0][m][0] * gv0, acc[ai][0][m][1] * gv1, acc[ai][1][m][0] * gv2, acc[ai][1][m][1] * gv3); }
    }
};
struct EpiF1 {
    static constexpr bool PERM = true, PERM16 = true;
    bf16* Z1T;
    __device__ __forceinline__ void operator()(AccRef acc, const GUnit& u, int wr, int wc, int fr, int fq) const {
        const int reim = u.x0, br = u.x1;
#pragma unroll
        for (int ai = 0; ai < 2; ++ai)
#pragma unroll
            for (int m = 0; m < 4; ++m) { const int kp = ai * 128 + wr * 64 + m * 16 + fr;
                st16_bf16(Z1T + ((((size_t)br * 4 + wc) * 256 + kp) * 2 + reim) * 64 + 16 * fq, acc[ai][0][m][0], acc[ai][0][m][1], acc[ai][1][m][0], acc[ai][1][m][1]); }
    }
};
struct EpiF2 {
    static constexpr bool PERM = true, PERM16 = true;
    bf16* Z2T;
    __device__ __forceinline__ void operator()(AccRef acc, const GUnit& u, int wr, int wc, int fr, int fq) const {
        const int b = u.x0, g = u.x1, k0 = u.x2; const int kp = k0 + (wc >> 1), r0 = (wc & 1) * 64 + 16 * fq;
#pragma unroll
        for (int m = 0; m < 4; ++m) { const int mm = wr * 64 + m * 16 + fr, reim = mm >> 6, cp = mm & 63;
            st16_bf16(Z2T + (((((size_t)b * 4 + g) * 256 + kp) * 64 + cp) * 2 + reim) * 128 + r0, acc[0][0][m][0], acc[0][0][m][1], acc[0][1][m][0], acc[0][1][m][1]); }
    }
};
struct EpiF3 {
    static constexpr bool PERM = true, PERM16 = true;
    unsigned char* FO;
    __device__ __forceinline__ void operator()(AccRef acc, const GUnit& u, int wr, int wc, int fr, int fq) const {
        const int b = u.x0, cp = u.x1, g = u.x2;
#pragma unroll
        for (int m = 0; m < 4; ++m) { const int rr = wr * 64 + m * 16 + fr; const size_t tok = (size_t)b * SEQ + rr * 64 + cp; u32x4 w;
#pragma unroll
            for (int q = 0; q < 4; ++q) { const f32x4 v = acc[0][q >> 1][m][q & 1]; w[q] = pk4_fp8(v[0], v[1], v[2], v[3]); }
            *(u32x4*)(FO + tok * (SW + FW) + SW + g * 256 + wc * 64 + 16 * fq) = w; }
    }
};
struct EpiMoe1 {
    static constexpr bool PERM = true;
    unsigned char* HID; const int* rowlist;
    __device__ __forceinline__ void operator()(AccRef acc, const GUnit& u, int wr, int wc, int fr, int fq) const {
        const int e = u.x0, rt = u.x1, ct = u.x2, cnt = u.x3; const int* rl = rowlist + (size_t)e * ECAP; const int p0 = rt * 256 + wr * 64 + fr;
        const int odd = fq & 1;
        unsigned ent[2][2];
#pragma unroll
        for (int ai = 0; ai < 2; ++ai)
#pragma unroll
            for (int h = 0; h < 2; ++h) { int p = p0 + ai * 128 + (2 * h + odd) * 16; p = p < cnt ? p : cnt - 1; ent[ai][h] = (unsigned)rl[p]; }
#pragma unroll
        for (int ai = 0; ai < 2; ++ai)
#pragma unroll
            for (int mp = 0; mp < 4; mp += 2) {
                f32x4 v0, v1, w0, w1;
#pragma unroll
                for (int j = 0; j < 4; ++j) { const float a0 = acc[ai][0][mp][0][j] * W8_INV, a1 = acc[ai][0][mp][1][j] * W8_INV; v0[j] = a0 * fsigmoid(a0) * (acc[ai][1][mp][0][j] * W8_INV); v1[j] = a1 * fsigmoid(a1) * (acc[ai][1][mp][1][j] * W8_INV); }
#pragma unroll
                for (int j = 0; j < 4; ++j) { const float a0 = acc[ai][0][mp + 1][0][j] * W8_INV, a1 = acc[ai][0][mp + 1][1][j] * W8_INV; w0[j] = a0 * fsigmoid(a0) * (acc[ai][1][mp + 1][0][j] * W8_INV); w1[j] = a1 * fsigmoid(a1) * (acc[ai][1][mp + 1][1][j] * W8_INV); }
                const unsigned lo0 = pk4_fp8(v0[0], v0[1], v0[2], v0[3]), hi0 = pk4_fp8(v1[0], v1[1], v1[2], v1[3]), lo1 = pk4_fp8(w0[0], w0[1], w0[2], w0[3]), hi1 = pk4_fp8(w1[0], w1[1], w1[2], w1[3]);
                const auto sl = __builtin_amdgcn_permlane16_swap(lo0, lo1, false, false), sh = __builtin_amdgcn_permlane16_swap(hi0, hi1, false, false);
                const int p = p0 + ai * 128 + (mp + odd) * 16; const unsigned en = ent[ai][mp >> 1];
                if (p < cnt) *(u32x4*)(HID + (size_t)en * DE + ct * 128 + wc * 32 + 16 * (fq >> 1)) = (u32x4){sl[0], sh[0], sl[1], sh[1]}; }
    }
};
constexpr float Y8_SCALE = 16.0f, Y8_INV = 1.0f / 16.0f;
struct EpiMoe2 {
    static constexpr bool PERM = true, PERM16 = true;
    unsigned char* Y; const int* rowlist;
    __device__ __forceinline__ void operator()(AccRef acc, const GUnit& u, int wr, int wc, int fr, int fq) const {
        const int e = u.x0, rt = u.x1, ct = u.x2, cnt = u.x3; const int* rl = rowlist + (size_t)e * ECAP; const int p0 = rt * 256 + wr * 64 + fr;
        unsigned ent[2][4];
#pragma unroll
        for (int ai = 0; ai < 2; ++ai)
#pragma unroll
            for (int m = 0; m < 4; ++m) { int p = p0 + ai * 128 + m * 16; p = p < cnt ? p : cnt - 1; ent[ai][m] = (unsigned)rl[p]; }
#pragma unroll
        for (int ai = 0; ai < 2; ++ai)
#pragma unroll
            for (int m = 0; m < 4; ++m) { const int p = p0 + ai * 128 + m * 16;
                if (p < cnt) { u32x4 w;
#pragma unroll
                    for (int q = 0; q < 4; ++q) { const f32x4 v = acc[ai][q >> 1][m][q & 1] * (W8_INV * Y8_SCALE); w[q] = pk4_fp8(v[0], v[1], v[2], v[3]); }
                    *(u32x4*)(Y + (size_t)ent[ai][m] * D + ct * 256 + wc * 64 + 16 * fq) = w; } }
    }
};

enum { IX = 0, IC, ICTX, ICCTX, IWADA, IBADA, IWIN, IWF, ILAMRE, ILAMIM, ILOGDT, IBRE, IBIM, ICRE, ICIM, IDSKIP, IWGLU, IBGLU, IWS, IWOUT, ILN1G, ILN1B, IWGRP, IBGRP, IWEXP, IBEXP, IW1, IW3, IW2, ILN2G, ILN2B, NIN };
struct Args { const float* in[NIN]; float* out; unsigned char* ws; int ph_lo, ph_hi; };
constexpr int ARGS_OFF = MISC_OFF + 1024;
__device__ __forceinline__ unsigned long long ldp(LAS unsigned char* lds, int i) {
    const volatile LAS unsigned* p = (const volatile LAS unsigned*)(lds + ARGS_OFF) + 2 * i;
    const unsigned lo = __builtin_amdgcn_readfirstlane(p[0]), hi = __builtin_amdgcn_readfirstlane(p[1]);
    return ((unsigned long long)hi << 32) | lo;
}
#define AIN(i) ((const float*)ldp(lds, (i)))
#define AOUT ((float*)ldp(lds, NIN))
#define AWS ((unsigned char*)ldp(lds, NIN + 1))

template <int MAP>
__device__ __forceinline__ void transpose_item(const float* W, int K, int N, bf16* WT, LAS float* scr, int item, int lane) {
    const int nblk = N / 64, kb = item / nblk, nb = item % nblk, k0 = 64 * kb, n0 = 64 * nb;
    const int kr = lane >> 4, nc = (lane & 15) * 4;
    const float* src = W + (size_t)(k0 + kr) * N + n0 + nc;
    f32x4 v[16];
#pragma unroll
    for (int i = 0; i < 16; ++i) v[i] = __builtin_nontemporal_load((const f32x4*)(src + (size_t)(4 * i) * N));
#pragma unroll
    for (int i = 0; i < 16; ++i) { LAS float* d = scr + (4 * i + kr) * 65 + nc; d[0] = v[i].x; d[1] = v[i].y; d[2] = v[i].z; d[3] = v[i].w; }
    LDS_WAIT(); asm volatile("" ::: "memory");
    const int c = lane & 7;
#pragma unroll
    for (int j = 0; j < 8; ++j) { const int n = (lane >> 3) + 8 * j; const LAS float* s = scr + (8 * c) * 65 + n;
        u32x4 o; o.x = pk_bf16(s[0 * 65], s[1 * 65]); o.y = pk_bf16(s[2 * 65], s[3 * 65]); o.z = pk_bf16(s[4 * 65], s[5 * 65]); o.w = pk_bf16(s[6 * 65], s[7 * 65]);
        const int nn = n0 + n; const int row = MAP == 0 ? nn : ((nn >> 7) * 256 + (nn & 127) + (MAP == 2 ? 128 : 0));
        __builtin_nontemporal_store(o, (u32x4*)(WT + (size_t)row * K + k0 + 8 * c)); }
    LDS_WAIT(); asm volatile("" ::: "memory");
}
template <int MAP>
__device__ __forceinline__ void transpose_item_f8(const float* W, int K, int N, unsigned char* WT, LAS float* scr, int item, int lane, int pitch = 0) {
    const int nblk = N / 64, kb = item / nblk, nb = item % nblk, k0 = 64 * kb, n0 = 64 * nb;
    const int kr = lane >> 4, nc = (lane & 15) * 4;
    const float* src = W + (size_t)(k0 + kr) * N + n0 + nc;
    f32x4 v[16];
#pragma unroll
    for (int i = 0; i < 16; ++i) v[i] = __builtin_nontemporal_load((const f32x4*)(src + (size_t)(4 * i) * N));
#pragma unroll
    for (int i = 0; i < 16; ++i) { LAS float* d = scr + (4 * i + kr) * 65 + nc; d[0] = v[i].x * W8_SCALE; d[1] = v[i].y * W8_SCALE; d[2] = v[i].z * W8_SCALE; d[3] = v[i].w * W8_SCALE; }
    LDS_WAIT(); asm volatile("" ::: "memory");
    const int c = lane & 3;
#pragma unroll
    for (int j = 0; j < 4; ++j) { const int n = (lane >> 2) + 16 * j; const LAS float* s = scr + (16 * c) * 65 + n;
        u32x4 o; o.x = pk4_fp8(s[0 * 65], s[1 * 65], s[2 * 65], s[3 * 65]); o.y = pk4_fp8(s[4 * 65], s[5 * 65], s[6 * 65], s[7 * 65]);
        o.z = pk4_fp8(s[8 * 65], s[9 * 65], s[10 * 65], s[11 * 65]); o.w = pk4_fp8(s[12 * 65], s[13 * 65], s[14 * 65], s[15 * 65]);
        const int nn = n0 + n; const int row = MAP == 0 ? nn : ((nn >> 7) * 256 + (nn & 127) + (MAP == 2 ? 128 : 0));
        __builtin_nontemporal_store(o, (u32x4*)(WT + (size_t)row * (pitch ? pitch : K) + k0 + 16 * c)); }
    LDS_WAIT(); asm volatile("" ::: "memory");
}
__device__ __forceinline__ void ph0(LAS unsigned char* lds, int tid, int lane, int wave, int G, int bid) {
    unsigned char* ws = AWS;
    {
        LAS float* sv = (LAS float*)(lds + 81920);
        LAS f32x4* comb = (LAS f32x4*)(lds + 81920 + 4096);
        float* modpart = (float*)(ws + WS_MODPART);
        for (int task = bid; task < 256; task += G) {
            const int cb = task & 15, kr = task >> 4;
            __syncthreads();
            for (int i = tid; i < 5 * 128; i += 512) { const int r = i >> 7, k = kr * 128 + (i & 127); const float v = (r < 4) ? AIN(IC)[r * D + k] : AIN(ICCTX)[k]; sv[i] = v / (1.0f + expf(-v)); }
            __syncthreads();
            f32x4 acc[5];
#pragma unroll
            for (int r = 0; r < 5; ++r) acc[r] = (f32x4){0.f, 0.f, 0.f, 0.f};
            const int c4 = tid % 192, ks = tid / 192;
            if (tid < 384) {
                const float* wp = AIN(IWADA) + (size_t)(kr * 128 + ks * 64) * 12288 + cb * 768 + c4 * 4;
#pragma unroll 8
                for (int k = 0; k < 64; ++k) { const f32x4 w = __builtin_nontemporal_load((const f32x4*)(wp + (size_t)k * 12288));
#pragma unroll
                    for (int r = 0; r < 5; ++r) acc[r] += w * sv[r * 128 + ks * 64 + k]; }
                if (ks == 1) {
#pragma unroll
                    for (int r = 0; r < 5; ++r) comb[r * 192 + c4] = acc[r]; }
            }
            __syncthreads();
            if (tid < 192) {
#pragma unroll
                for (int r = 0; r < 5; ++r) { const f32x4 t = acc[r] + comb[r * 192 + tid]; *(f32x4*)(modpart + (size_t)(kr * 5 + r) * 12288 + cb * 768 + tid * 4) = t; } }
        }
        __syncthreads();
    }
    const int gt = bid * 512 + tid, NGT = G * 512;
    {
        f32x2* PW = (f32x2*)(ws + WS_PW); f32x2* BBAR = (f32x2*)(ws + WS_BBAR); f32x2* LAML = (f32x2*)(ws + WS_LAML); f32x2* LAMSEG = (f32x2*)(ws + WS_LAMSEG);
        const double TWO_PI = 6.283185307179586476925287;
        for (int idx = gt; idx < SG * 2 * SP * 34; idx += NGT) {
            const int i = idx / 34, j = idx - i * 34; const int g = i >> 7, dir = (i >> 6) & 1, p = i & 63; const int si = (dir * SG + g) * SP + p;
            const double lr = (double)AIN(ILAMRE)[si], li = (double)AIN(ILAMIM)[si], dt = exp((double)AIN(ILOGDT)[dir * SG + g]);
            const int jj = (j == 33) ? LC * 33 : j;
            const double mag = exp((double)jj * lr * dt); double ang = (double)jj * li * dt; ang -= TWO_PI * rint(ang / TWO_PI);
            const float fa = (float)ang; const double cr = mag * (double)cosf(fa), ci = mag * (double)sinf(fa);
            const f32x2 o = (f32x2){(float)cr, (float)ci};
            if (j <= 32) PW[(size_t)i * 33 + j] = o;
            if (j == 32) LAML[i] = o;
            if (j == 33) LAMSEG[i] = o;
        }
        for (int idx = gt; idx < SG * 2 * SP * SH; idx += NGT) {
            const int i = idx >> 4, h = idx & 15; const int g = i >> 7, dir = (i >> 6) & 1, p = i & 63; const int si = (dir * SG + g) * SP + p;
            const double lr = (double)AIN(ILAMRE)[si], li = (double)AIN(ILAMIM)[si], dt = exp((double)AIN(ILOGDT)[dir * SG + g]);
            const double mag = exp(lr * dt); double ang = li * dt; ang -= TWO_PI * rint(ang / TWO_PI);
            const float fa = (float)ang; const double l1r = mag * (double)cosf(fa), l1i = mag * (double)sinf(fa);
            const double nr = l1r - 1.0, ni = l1i, den = lr * lr + li * li; const double qr = (nr * lr + ni * li) / den, qi = (ni * lr - nr * li) / den;
            const double br = (double)AIN(IBRE)[(size_t)si * SH + h], bi = (double)AIN(IBIM)[(size_t)si * SH + h];
            BBAR[(size_t)i * SH + h] = (f32x2){(float)(qr * br - qi * bi), (float)(qr * bi + qi * br)};
        }
    }
    {
        bf16* FKT = (bf16*)(ws + WS_FKT); bf16* FCT = (bf16*)(ws + WS_FCT); bf16* FRT = (bf16*)(ws + WS_FRT); bf16* WHI = (bf16*)(ws + WS_WRTHI); bf16* WLO = (bf16*)(ws + WS_WRTLO);
        const float TWO_PI_F = 6.2831853071795864f;
        for (int i = gt; i < 512 * 256; i += NGT) { const int m = i >> 8, k = i & 255, kp = m & 255, reim = m >> 8; const float ang = TWO_PI_F * (float)((k * kp) & 255) * (1.0f / 256.0f);
            FKT[i] = f2bf((reim ? -sinf(ang) : cosf(ang)) * 0.0625f); }
        for (int i = gt; i < 256 * 128; i += NGT) { const int m = i >> 7, kk = i & 127; float v = 0.f;
            if (m < 128) { const int ro = m >> 6, cp = m & 63, ri = kk >> 6, c = kk & 63; const float ang = TWO_PI_F * (float)((c * cp) & 63) * (1.0f / 64.0f); const float co = cosf(ang), sn = sinf(ang);
                v = (ro == 0 ? (ri == 0 ? co : sn) : (ri == 0 ? -sn : co)) * 0.125f; }
            FCT[i] = f2bf(v); }
        for (int i = gt; i < 256 * 256; i += NGT) { const int m = i >> 8, kk = i & 255; float v = 0.f;
            if (m < 128) { const int ri = kk >> 7, r = kk & 127; const float ang = TWO_PI_F * (float)((r * m) & 127) * (1.0f / 128.0f); v = (ri ? sinf(ang) : cosf(ang)) * 0.08838834764831845f; }
            FRT[i] = f2bf(v); }
        for (int i = gt; i < 48 * D; i += NGT) { const int n = i >> 11, k = i & (D - 1); float w = 0.f;
            if (n < 4) w = AIN(IWGRP)[k * 4 + n]; else if (n < 36) w = AIN(IWEXP)[k * 32 + (n - 4)];
            const bf16 h = f2bf(w); WHI[i] = h; WLO[i] = f2bf(w - bf2f(h)); }
    }
    {
        LAS float* scr = (LAS float*)(lds + wave * 16640);
        const int gw = bid * NWAVES + wave, NGW = G * NWAVES;
        constexpr int I_IN = 32 * 88, I_IN2 = 32 * 8, I_F = 16 * 32, I_S = 8 * 32, I_O = 32 * 32, I_G = 8 * 8, I_E = 512;
        constexpr int NITEMS = I_IN + I_IN2 + I_F + I_S + I_O + I_G + 3 * NE * I_E;
        for (int it = gw; it < NITEMS; it += NGW) {
            int r = it;
            if (r < I_IN) { transpose_item_f8<0>(AIN(IWIN), D, INW, (unsigned char*)(ws + WS_WG8), scr, r, lane); continue; } r -= I_IN;
            if (r < I_IN2) { transpose_item<0>(AIN(IWIN), D, INW, (bf16*)(ws + WS_WINT), scr, (r >> 3) * 88 + 16 + (r & 7), lane); continue; } r -= I_IN2;
            if (r < I_F) { transpose_item_f8<0>(AIN(IWF), FW, D, (unsigned char*)(ws + WS_WFT) + SW, scr, r, lane, SW + FW); continue; } r -= I_F;
            if (r < I_S) { transpose_item_f8<0>(AIN(IWS), SW, D, (unsigned char*)(ws + WS_WFT), scr, r, lane, SW + FW); continue; } r -= I_S;
            if (r < I_O) { transpose_item_f8<0>(AIN(IWOUT), D, D, (unsigned char*)(ws + WS_WOT), scr, r, lane); continue; } r -= I_O;
            if (r < I_G) { transpose_item<0>(AIN(IWGLU), SW, SW, (bf16*)(ws + WS_WGLUT), scr, r, lane); continue; } r -= I_G;
            if (r < NE * I_E) { const int e = r >> 9; transpose_item_f8<1>(AIN(IW1) + (size_t)e * D * DE, D, DE, (unsigned char*)(ws + WS_W13T) + (size_t)e * 2048 * D, scr, r & 511, lane); continue; } r -= NE * I_E;
            if (r < NE * I_E) { const int e = r >> 9; transpose_item_f8<2>(AIN(IW3) + (size_t)e * D * DE, D, DE, (unsigned char*)(ws + WS_W13T) + (size_t)e * 2048 * D, scr, r & 511, lane); continue; } r -= NE * I_E;
            { const int e = r >> 9; transpose_item_f8<0>(AIN(IW2) + (size_t)e * DE * D, DE, D, (unsigned char*)(ws + WS_W2T) + (size_t)e * D * DE, scr, r & 511, lane); }
        }
    }
}

__device__ __forceinline__ void ph1(LAS unsigned char* lds, int tid, int G, int bid) {
    unsigned char* ws = AWS; const int gt = bid * 512 + tid, NGT = G * 512;
    const f32x2* PW = (const f32x2*)(ws + WS_PW); const f32x2* BBAR = (const f32x2*)(ws + WS_BBAR);
    { const float* modpart = (const float*)(ws + WS_MODPART); float* modv = (float*)(ws + WS_MODV);
      for (int i = gt; i < 5 * 12288; i += NGT) { float s = AIN(IBADA)[i % 12288];
#pragma unroll
          for (int kr = 0; kr < 16; ++kr) s += modpart[(size_t)kr * 5 * 12288 + i];
          modv[i] = s; } }
    { float* KLAG = (float*)(ws + WS_KLAG);
      for (int i = gt; i < SG * 2 * LC * 64; i += NGT) { const int hq = i & 3, ho = (i >> 2) & 15, k = (i >> 6) & 31, gd = i >> 11, g = gd >> 1, dir = gd & 1;
          const float* cre = AIN(ICRE) + ((size_t)(dir * SG + g) * SH + ho) * SP; const float* cim = AIN(ICIM) + ((size_t)(dir * SG + g) * SH + ho) * SP;
          f32x4 s = (f32x4){0.f, 0.f, 0.f, 0.f};
#pragma unroll 4
          for (int p = 0; p < SP; ++p) { const f32x2 pw = PW[((size_t)gd * SP + p) * 33 + k]; const f32x4* bq = (const f32x4*)(BBAR + ((size_t)gd * SP + p) * SH + 4 * hq); const f32x4 b01 = bq[0], b23 = bq[1]; const float cr = cre[p], ci = cim[p];
              const float tr = cr * pw.x - ci * pw.y, ti = cr * pw.y + ci * pw.x;
              s.x += tr * b01.x - ti * b01.y; s.y += tr * b01.z - ti * b01.w; s.z += tr * b23.x - ti * b23.y; s.w += tr * b23.z - ti * b23.w; }
          *(f32x4*)(KLAG + (((size_t)gd * LC + k) << 8) + ho * 16 + 4 * hq) = s; } }
    { bf16* WET = (bf16*)(ws + WS_WET);
      for (int i = gt; i < SG * 256 * LC; i += NGT) { const int jj = i & 31, n = (i >> 5) & 255, g = i >> 13; const int dir = n >> 7, reim = (n >> 6) & 1, p = n & 63;
          const int gd = g * 2 + dir; const f32x2 pw = PW[((size_t)gd * SP + p) * 33 + (dir == 0 ? (LC - 1 - jj) : jj)]; const f32x4* bb = (const f32x4*)(BBAR + ((size_t)gd * SP + p) * SH);
          unsigned o[8];
#pragma unroll
          for (int q = 0; q < 8; ++q) { const f32x4 b2 = bb[q];
              const float v0 = reim ? (pw.x * b2.y + pw.y * b2.x) : (pw.x * b2.x - pw.y * b2.y), v1 = reim ? (pw.x * b2.w + pw.y * b2.z) : (pw.x * b2.z - pw.y * b2.w); o[q] = pk_bf16(v0, v1); }
          u32x4* dst = (u32x4*)(WET + ((size_t)g * 256 + n) * 512 + jj * 16); dst[0] = (u32x4){o[0], o[1], o[2], o[3]}; dst[1] = (u32x4){o[4], o[5], o[6], o[7]}; } }
    { bf16* TV = (bf16*)(ws + WS_TV);
      for (int i = gt; i < SG * 512 * 32; i += NGT) { const int p8 = i & 7, reim = (i >> 3) & 1, dir = (i >> 4) & 1, n = (i >> 5) & 511, g = i >> 14; const int tt = n >> 4, ho = n & 15;
          const int gd = g * 2 + dir, pj = dir == 0 ? (tt + 1) : (LC - tt); const size_t ci = ((size_t)(dir * SG + g) * SH + ho) * SP + p8 * 8;
          const f32x4 cr0 = *(const f32x4*)(AIN(ICRE) + ci), cr1 = *(const f32x4*)(AIN(ICRE) + ci + 4), ci0 = *(const f32x4*)(AIN(ICIM) + ci), ci1 = *(const f32x4*)(AIN(ICIM) + ci + 4);
          float v[8];
#pragma unroll
          for (int q = 0; q < 8; ++q) { const f32x2 pw = PW[((size_t)gd * SP + p8 * 8 + q) * 33 + pj]; const float cr = q < 4 ? cr0[q & 3] : cr1[q & 3], cim = q < 4 ? ci0[q & 3] : ci1[q & 3];
              v[q] = reim ? -(cr * pw.y + cim * pw.x) : (cr * pw.x - cim * pw.y); }
          *(u32x4*)(TV + ((size_t)g * 512 + n) * A2LD + 512 + dir * 128 + reim * 64 + p8 * 8) = (u32x4){pk_bf16(v[0], v[1]), pk_bf16(v[2], v[3]), pk_bf16(v[4], v[5]), pk_bf16(v[6], v[7])}; } }
}

__device__ __forceinline__ void ph2(LAS unsigned char* lds, int tid, int lane, int wave, int G, int bid) {
    unsigned char* ws = AWS; const float* modv = (const float*)(ws + WS_MODV);
    { const int gt = bid * 512 + tid, NGT = G * 512; bf16* TV = (bf16*)(ws + WS_TV); const float* KLAG = (const float*)(ws + WS_KLAG); const float* dsk = AIN(IDSKIP);
      for (int i = gt; i < SG * 512 * LC; i += NGT) { const int jj = i & 31, n = (i >> 5) & 511, g = i >> 14; const int tt = n >> 4, ho = n & 15;
          const int dir = jj > tt ? 1 : 0, lag = jj > tt ? jj - tt : tt - jj;
          const f32x4* k0 = (const f32x4*)(KLAG + (((size_t)(g * 2 + dir) * LC + lag) << 8) + ho * 16);
          f32x4 a[4];
#pragma unroll
          for (int q = 0; q < 4; ++q) a[q] = k0[q];
          if (jj == tt) { const f32x4* k1 = (const f32x4*)(KLAG + (((size_t)(g * 2 + 1) * LC) << 8) + ho * 16);
#pragma unroll
              for (int q = 0; q < 4; ++q) a[q] += k1[q];
              const float dv = dsk[g * SH + ho];
#pragma unroll
              for (int q = 0; q < 4; ++q) { a[q].x += (ho == 4 * q + 0) ? dv : 0.f; a[q].y += (ho == 4 * q + 1) ? dv : 0.f; a[q].z += (ho == 4 * q + 2) ? dv : 0.f; a[q].w += (ho == 4 * q + 3) ? dv : 0.f; } }
          u32x4* dst = (u32x4*)(TV + ((size_t)g * 512 + n) * A2LD + jj * 16);
          dst[0] = (u32x4){pk_bf16(a[0].x, a[0].y), pk_bf16(a[0].z, a[0].w), pk_bf16(a[1].x, a[1].y), pk_bf16(a[1].z, a[1].w)};
          dst[1] = (u32x4){pk_bf16(a[2].x, a[2].y), pk_bf16(a[2].z, a[2].w), pk_bf16(a[3].x, a[3].y), pk_bf16(a[3].z, a[3].w)}; } }
    LAS f32x4* MV = (LAS f32x4*)lds;
    for (int i = tid; i < 5 * 2 * 512; i += NWAVES * 64) { const int b = i >> 10, which = (i >> 9) & 1, q = i & 511; f32x4 t = *((const f32x4*)(modv + (size_t)b * 12288 + which * D) + q); if (which) t = t + 1.0f; MV[i] = t; }
    __syncthreads();
    const int gw = bid * NWAVES + wave, NGW = G * NWAVES; const float* XP = AIN(IX); const float* CP = AIN(ICTX);
    f32x4 v[8];
    { const int m = gw; const f32x4* xq = (const f32x4*)(m < T ? XP + (size_t)m * D : CP + (size_t)(m - T) * D) + lane;
#pragma unroll
      for (int j = 0; j < 8; ++j) v[j] = __builtin_nontemporal_load(xq + 64 * j); }
    for (int m = gw; m < T + TC; m += NGW) {
        f32x4 vn[8]; const int mn = m + NGW;
        if (mn < T + TC) { const f32x4* xq = (const f32x4*)(mn < T ? XP + (size_t)mn * D : CP + (size_t)(mn - T) * D) + lane;
#pragma unroll
            for (int j = 0; j < 8; ++j) vn[j] = __builtin_nontemporal_load(xq + 64 * j); }
        else {
#pragma unroll
            for (int j = 0; j < 8; ++j) vn[j] = (f32x4){0.f, 0.f, 0.f, 0.f}; }
        bf16* orow; int bsel;
        if (m < T) { orow = (bf16*)(ws + WS_R3) + (size_t)m * D; bsel = m >> 13; }
        else { orow = (bf16*)(ws + WS_HC) + (size_t)(m - T) * D; bsel = 4; }
        float s = 0.f;
#pragma unroll
        for (int j = 0; j < 8; ++j) s += (v[j].x + v[j].y) + (v[j].z + v[j].w);
        const float mean = wave_sum(s) * (1.f / D); float s2 = 0.f;
#pragma unroll
        for (int j = 0; j < 8; ++j) { v[j] = v[j] - mean; s2 += (v[j].x * v[j].x + v[j].y * v[j].y) + (v[j].z * v[j].z + v[j].w * v[j].w); }
        const float rstd = 1.f / sqrtf(wave_sum(s2) * (1.f / D) + LN_EPS);
        const LAS f32x4* shq = MV + bsel * 1024 + lane; const LAS f32x4* scq = shq + 512; u32x2* o8 = (u32x2*)orow + lane;
        unsigned* o4 = (unsigned*)(ws + WS_RA + (size_t)(m < T ? m : 0) * D) + lane;
#pragma unroll
        for (int j = 0; j < 8; ++j) { const f32x4 sh = shq[64 * j], sc = scq[64 * j]; const f32x4 y = v[j] * rstd * sc + sh; if (m < T) o4[64 * j] = pk4_fp8(y.x, y.y, y.z, y.w); else o8[64 * j] = (u32x2){pk_bf16(y.x, y.y), pk_bf16(y.z, y.w)}; }
#pragma unroll
        for (int j = 0; j < 8; ++j) v[j] = vn[j];
    }
}

__device__ __forceinline__ void ctx_inproj(LAS unsigned char* lds, int lane, int wave, int G, int bid) {
    unsigned char* ws = AWS; const bf16* HC = (const bf16*)(ws + WS_HC); const bf16* WINT = (const bf16*)(ws + WS_WINT); bf16* A2 = (bf16*)(ws + WS_A2);
    const int fr = lane & 15, fq = lane >> 4;
    for (int wt = bid * NWAVES + wave; wt < 2048; wt += G * NWAVES) {
        const int rt = wt >> 5, ct = wt & 31;
        const bf16* ap = HC + (size_t)(16 * rt + fr) * D + 8 * fq; const bf16* bp = WINT + (size_t)(FW + 16 * ct + fr) * D + 8 * fq;
        f32x4 acc = (f32x4){0.f, 0.f, 0.f, 0.f};
#pragma unroll 8
        for (int ks = 0; ks < 64; ++ks) { const bf16x8 av = *(const bf16x8*)(ap + 32 * ks), bv = *(const bf16x8*)(bp + 32 * ks); acc = __builtin_amdgcn_mfma_f32_16x16x32_bf16(av, bv, acc, 0, 0, 0); }
#pragma unroll
        for (int j = 0; j < 4; ++j) { const int row = 16 * rt + 4 * fq + j, b = row >> 8, tp = row & 255;
            A2[((size_t)((ct * 4 + b) * NCH + (tp >> 5))) * A2LD + (tp & 31) * 16 + fr] = f2bf(acc[j]); }
    }
}
__device__ __forceinline__ void ctx_E(LAS unsigned char* lds, int lane, int wave, int G, int bid) {
    unsigned char* ws = AWS; const bf16* A2 = (const bf16*)(ws + WS_A2); const bf16* WET = (const bf16*)(ws + WS_WET); float* E = (float*)(ws + WS_E);
    const int fr = lane & 15, fq = lane >> 4;
    for (int task = (bid + G - (128 % G)) % G; task < 128; task += G) {
        const int g = task >> 2, b = task & 3;
        const bf16* ap = A2 + (size_t)((g * 4 + b) * NCH + fr) * A2LD + 8 * fq;
        const bf16* bp0 = WET + (size_t)(g * 256 + 32 * wave + fr) * 512 + 8 * fq; const bf16* bp1 = bp0 + 16 * 512;
        f32x4 acc0 = (f32x4){0.f, 0.f, 0.f, 0.f}, acc1 = acc0;
#pragma unroll 4
        for (int ks = 0; ks < 16; ++ks) { const bf16x8 av = *(const bf16x8*)(ap + 32 * ks), b0 = *(const bf16x8*)(bp0 + 32 * ks), b1 = *(const bf16x8*)(bp1 + 32 * ks);
            acc0 = __builtin_amdgcn_mfma_f32_16x16x32_bf16(av, b0, acc0, 0, 0, 0); acc1 = __builtin_amdgcn_mfma_f32_16x16x32_bf16(av, b1, acc1, 0, 0, 0); }
        if (fq < 2) {
#pragma unroll
            for (int j = 0; j < 4; ++j) { float* er = E + (size_t)((g * 4 + b) * NCH + 4 * fq + j) * 256 + 32 * wave + fr; er[0] = acc0[j]; er[16] = acc1[j]; } }
    }
}

__device__ __forceinline__ void chunk_scan(LAS unsigned char* lds, int lane, int wave, int G, int bid) {
    unsigned char* ws = AWS; const float* E = (const float*)(ws + WS_E); bf16* A2 = (bf16*)(ws + WS_A2);
    const f32x2* LAML = (const f32x2*)(ws + WS_LAML); const f32x2* LAMSEG = (const f32x2*)(ws + WS_LAMSEG);
    LAS f32x2* segEnd = (LAS f32x2*)lds;
    for (int task = bid; task < 256; task += G) {
        const int g = task >> 3, b = (task >> 1) & 3, dir = task & 1, p = lane;
        const f32x2 lamL = LAML[(g * 2 + dir) * SP + p], lamS = LAMSEG[(g * 2 + dir) * SP + p];
        const float* Eb = E + (size_t)((g * 4 + b) * NCH) * 256 + dir * 128 + p;
        const int v0 = 33 * wave;
        float sr = 0.f, si = 0.f;
#pragma unroll 11
        for (int i = 0; i < 33; ++i) { const int vi = v0 + i; const int cr = dir == 0 ? vi : (vi < NCTXCH ? NCTXCH - 1 - vi : (NCH - 1 + NCTXCH) - vi);
            const float er = Eb[(size_t)cr * 256], ei = Eb[(size_t)cr * 256 + 64];
            const float tr = lamL.x * sr - lamL.y * si + er, ti = lamL.x * si + lamL.y * sr + ei; sr = tr; si = ti; }
        __syncthreads();
        segEnd[wave * 64 + p] = (f32x2){sr, si};
        __syncthreads();
        sr = 0.f; si = 0.f;
        for (int w = 0; w < wave; ++w) { const f32x2 se = segEnd[w * 64 + p]; const float tr = lamS.x * sr - lamS.y * si + se.x, ti = lamS.x * si + lamS.y * sr + se.y; sr = tr; si = ti; }
        bf16* Ab = A2 + (size_t)((g * 4 + b) * NCH) * A2LD + 512 + dir * 128 + p;
#pragma unroll 11
        for (int i = 0; i < 33; ++i) { const int vi = v0 + i; const int cr = dir == 0 ? vi : (vi < NCTXCH ? NCTXCH - 1 - vi : (NCH - 1 + NCTXCH) - vi);
            const float er = Eb[(size_t)cr * 256], ei = Eb[(size_t)cr * 256 + 64];
            if (cr >= NCTXCH) { Ab[(size_t)cr * A2LD] = f2bf(sr); Ab[(size_t)cr * A2LD + 64] = f2bf(si); }
            const float tr = lamL.x * sr - lamL.y * si + er, ti = lamL.x * si + lamL.y * sr + ei; sr = tr; si = ti; }
    }
    __syncthreads();
}

__device__ __forceinline__ void ph10(LAS unsigned char* lds, int tid, int lane, int wave, int G, int bid) {
    unsigned char* ws = AWS; bf16* XM = (bf16*)(ws + WS_XMID); unsigned char* H2 = (unsigned char*)(ws + WS_RB); const float* modv = (const float*)(ws + WS_MODV);
    const bf16* WHI = (const bf16*)(ws + WS_WRTHI); const bf16* WLO = (const bf16*)(ws + WS_WRTLO);
    unsigned* ctl = (unsigned*)(ws + WS_CTL); int* rowlist = (int*)(ws + WS_ROWLIST); float* rw = (float*)(ws + WS_RW);
    constexpr int RS = 4112;
    LAS unsigned char* Hhi = lds; LAS unsigned char* Hlo = lds + 16 * RS;
    LAS float* Pp = (LAS float*)lds;
    LAS float* Lg = (LAS float*)(lds + 2 * 16 * RS);
    LAS int* tokE = (LAS int*)(lds + 2 * 16 * RS + 2304);
    LAS float* tokW = (LAS float*)(lds + 2 * 16 * RS + 3328);
    LAS int* tokLi = (LAS int*)(lds + 2 * 16 * RS + 4352);
    LAS int* lcnt = (LAS int*)(lds + 2 * 16 * RS + 5376);
    LAS int* lbase = (LAS int*)(lds + 2 * 16 * RS + 5504);
    const int fr = lane & 15, fq = lane >> 4;
    const float* XIN = AIN(IX); const bf16* MG = (const bf16*)(ws + WS_R3);
    const float* bgrp = AIN(IBGRP); const float* bexp = AIN(IBEXP); const float* ln1g = AIN(ILN1G); const float* ln1b = AIN(ILN1B);
    bf16x8 wf[8][3];
#pragma unroll
    for (int ks = 0; ks < 8; ++ks)
#pragma unroll
        for (int nt = 0; nt < 3; ++nt) wf[ks][nt] = *(const bf16x8*)(WHI + (size_t)(16 * nt + fr) * D + 256 * wave + 32 * ks + 8 * fq);
    LAS f32x4* VEC = (LAS f32x4*)(lds + 16 * RS);
    const f32x4* XIN4 = (const f32x4*)XIN + lane; const u32x2* MG2 = (const u32x2*)MG + lane;
    auto load_row = [&](size_t gtok, f32x4 (&xv)[8], u32x2 (&mv_)[8]) {
        const f32x4* xin = XIN4 + gtok * (D / 4); const u32x2* mgq = MG2 + gtok * (D / 4);
#pragma unroll
        for (int j = 0; j < 8; ++j) { mv_[j] = __builtin_nontemporal_load(mgq + 64 * j); xv[j] = __builtin_nontemporal_load(xin + 64 * j); } };
    auto do_row = [&](f32x4 (&v)[8], const u32x2 (&mg)[8], size_t gtok, int row) {
        u32x2* xq = (u32x2*)(XM + gtok * D) + lane; float s = 0.f;
#pragma unroll
        for (int j = 0; j < 8; ++j) { v[j] = v[j] * DN_ALPHA + (f32x4){bf_lo(mg[j].x), bf_hi(mg[j].x), bf_lo(mg[j].y), bf_hi(mg[j].y)}; s += (v[j].x + v[j].y) + (v[j].z + v[j].w); }
        float mean = wave_sum(s) * (1.f / D), s2 = 0.f;
#pragma unroll
        for (int j = 0; j < 8; ++j) { v[j] = v[j] - mean; s2 += (v[j].x * v[j].x + v[j].y * v[j].y) + (v[j].z * v[j].z + v[j].w * v[j].w); }
        float rstd = 1.f / sqrtf(wave_sum(s2) * (1.f / D) + LN_EPS);
        const LAS f32x4* gq = VEC + lane; const LAS f32x4* bq = VEC + 512 + lane; s = 0.f;
#pragma unroll
        for (int j = 0; j < 8; ++j) { v[j] = v[j] * rstd * gq[64 * j] + bq[64 * j]; xq[64 * j] = (u32x2){pk_bf16(v[j].x, v[j].y), pk_bf16(v[j].z, v[j].w)}; s += (v[j].x + v[j].y) + (v[j].z + v[j].w); }
        mean = wave_sum(s) * (1.f / D); s2 = 0.f;
#pragma unroll
        for (int j = 0; j < 8; ++j) { v[j] = v[j] - mean; s2 += (v[j].x * v[j].x + v[j].y * v[j].y) + (v[j].z * v[j].z + v[j].w * v[j].w); }
        rstd = 1.f / sqrtf(wave_sum(s2) * (1.f / D) + LN_EPS);
        const LAS f32x4* scq = VEC + 1024 + lane; const LAS f32x4* shq = VEC + 1536 + lane; unsigned* o8 = (unsigned*)(H2 + gtok * D) + lane;
#pragma unroll
        for (int j = 0; j < 8; ++j) { const f32x4 y = v[j] * rstd * scq[64 * j] + shq[64 * j];
            const u32x2 hi = (u32x2){pk_bf16(y.x, y.y), pk_bf16(y.z, y.w)};
            o8[64 * j] = pk4_fp8(y.x, y.y, y.z, y.w);
            *(LAS u32x2*)(Hhi + row * RS + (256 * j + 4 * lane) * 2) = hi; } };
    for (int batch = bid; batch < 256; batch += G) {
        if (tid < 32) lcnt[tid] = 0;
        { const float* mv = modv + (size_t)((batch * 128) >> 13) * 12288;
          for (int i = tid; i < 4 * 512; i += NWAVES * 64) { const int r = i >> 9, q = i & 511;
              f32x4 t = *((const f32x4*)(r == 0 ? ln1g : r == 1 ? ln1b : r == 2 ? mv + 4 * D : mv + 3 * D) + q); if (r == 2) t = t + 1.0f; VEC[i] = t; } }
        __syncthreads();
        const size_t tokB = (size_t)batch * 128 + 2 * wave;
        f32x4 xa[8], xb[8]; u32x2 ma[8], mb[8];
        load_row(tokB, xa, ma);
        for (int grp = 0; grp < 8; ++grp) {
            const size_t g0 = tokB + grp * 16;
            load_row(g0 + 1, xb, mb);
            do_row(xa, ma, g0, 2 * wave);
            if (grp < 7) load_row(g0 + 16, xa, ma);
            do_row(xb, mb, g0 + 1, 2 * wave + 1);
            __syncthreads();
            f32x4 acc[3];
#pragma unroll
            for (int nt = 0; nt < 3; ++nt) acc[nt] = (f32x4){0.f, 0.f, 0.f, 0.f};
#pragma unroll
            for (int ks = 0; ks < 8; ++ks) { const int k = 256 * wave + 32 * ks + 8 * fq;
                const bf16x8 ahi = *(const LAS bf16x8*)(Hhi + fr * RS + k * 2);
#pragma unroll
                for (int nt = 0; nt < 3; ++nt) acc[nt] = __builtin_amdgcn_mfma_f32_16x16x32_bf16(ahi, wf[ks][nt], acc[nt], 0, 0, 0); }
            __syncthreads();
#pragma unroll
            for (int nt = 0; nt < 3; ++nt)
#pragma unroll
                for (int j = 0; j < 4; ++j) Pp[(wave * 16 + 4 * fq + j) * 48 + 16 * nt + fr] = acc[nt][j];
            __syncthreads();
            for (int i = tid; i < 16 * 36; i += 512) { const int tk = i / 36, n = i % 36; float s = 0.f;
#pragma unroll
                for (int w = 0; w < 8; ++w) s += Pp[(w * 16 + tk) * 48 + n];
                Lg[i] = s; }
            __syncthreads();
            if (tid < 16) {
                const LAS float* L = Lg + tid * 36;
                float lg[4]; int gi = 0; float gm;
#pragma unroll
                for (int i = 0; i < 4; ++i) lg[i] = L[i] + bgrp[i];
                gm = lg[0];
#pragma unroll
                for (int i = 1; i < 4; ++i) if (lg[i] > gm) { gm = lg[i]; gi = i; }
                float gz = 0.f;
#pragma unroll
                for (int i = 0; i < 4; ++i) gz += expf(lg[i] - gm);
                const float gtop = 1.0f / gz;
                float le[8]; int j0 = 0; float m0;
#pragma unroll
                for (int j = 0; j < 8; ++j) le[j] = L[4 + gi * 8 + j] + bexp[gi * 8 + j];
                m0 = le[0];
#pragma unroll
                for (int j = 1; j < 8; ++j) if (le[j] > m0) { m0 = le[j]; j0 = j; }
                int j1 = (j0 == 0) ? 1 : 0; float m1 = -3.0e38f;
#pragma unroll
                for (int j = 0; j < 8; ++j) if (j != j0 && le[j] > m1) { m1 = le[j]; j1 = j; }
                const float e1 = expf(m1 - m0), w0 = gtop / (1.0f + e1), w1 = gtop * e1 / (1.0f + e1);
                const int ex0 = gi * 8 + j0, ex1 = gi * 8 + j1; const int sl = (grp * 16 + tid) * 2;
                tokE[sl] = ex0; tokE[sl + 1] = ex1; tokW[sl] = w0; tokW[sl + 1] = w1;
                tokLi[sl] = __hip_atomic_fetch_add(lcnt + ex0, 1, __ATOMIC_RELAXED, __HIP_MEMORY_SCOPE_WORKGROUP);
                tokLi[sl + 1] = __hip_atomic_fetch_add(lcnt + ex1, 1, __ATOMIC_RELAXED, __HIP_MEMORY_SCOPE_WORKGROUP);
            }
            __syncthreads();
        }
        if (tid < 32) { const int n = lcnt[tid]; lbase[tid] = n ? (int)__hip_atomic_fetch_add(ctl + CW_CNT + 64 * tid, (unsigned)n, RLX_AGENT) : 0; }
        __syncthreads();
        if (tid < 256) { const int e = tokE[tid], pos = lbase[e] + tokLi[tid], ent = (batch * 128 + (tid >> 1)) * 2 + (tid & 1); rowlist[(size_t)e * ECAP + pos] = ent; rw[ent] = tokW[tid]; }
        __syncthreads();
    }
}

__device__ __forceinline__ void ph13(LAS unsigned char* lds, int tid, int lane_, int wave, int G, int bid) {
    const int lane = (int)__builtin_amdgcn_mbcnt_hi(~0u, __builtin_amdgcn_mbcnt_lo(~0u, 0u));
    unsigned char* ws = AWS; float* X = AOUT; const bf16* XM = (const bf16*)(ws + WS_XMID); const unsigned char* Y = (const unsigned char*)(ws + WS_RB); const float* rw = (const float*)(ws + WS_RW); const float* modv = (const float*)(ws + WS_MODV);
    LAS f32x4* VG = (LAS f32x4*)lds;
    { const f32x4* g2 = (const f32x4*)AIN(ILN2G); const f32x4* b2 = (const f32x4*)AIN(ILN2B);
      for (int i = tid; i < 6 * 512; i += NWAVES * 64) { const int r = i >> 9, q = i & 511; VG[i] = r < 4 ? *((const f32x4*)(modv + (size_t)r * 12288 + 5 * D) + q) : (r == 4 ? g2[q] : b2[q]); } }
    __syncthreads();
    const int gw = bid * NWAVES + wave, NGW = G * NWAVES;
    unsigned p0[8], p1[8]; u32x2 xb[8]; float w0, w1;
    { const int m = gw; const u32x2* xm = (const u32x2*)(XM + (size_t)m * D) + lane; const unsigned* y0 = (const unsigned*)(Y + (size_t)(2 * m) * D) + lane; const unsigned* y1 = y0 + D / 4;
#pragma unroll
      for (int j = 0; j < 8; ++j) { p0[j] = __builtin_nontemporal_load(y0 + 64 * j); p1[j] = __builtin_nontemporal_load(y1 + 64 * j); xb[j] = __builtin_nontemporal_load(xm + 64 * j); }
      w0 = rw[2 * m]; w1 = rw[2 * m + 1]; }
    for (int m = gw; m < T; m += NGW) {
        unsigned q0[8], q1[8]; u32x2 xn[8]; float wn0 = 0.f, wn1 = 0.f; const int mn = m + NGW;
        if (mn < T) { const u32x2* xm = (const u32x2*)(XM + (size_t)mn * D) + lane; const unsigned* y0 = (const unsigned*)(Y + (size_t)(2 * mn) * D) + lane; const unsigned* y1 = y0 + D / 4;
#pragma unroll
            for (int j = 0; j < 8; ++j) { q0[j] = __builtin_nontemporal_load(y0 + 64 * j); q1[j] = __builtin_nontemporal_load(y1 + 64 * j); xn[j] = __builtin_nontemporal_load(xm + 64 * j); }
            wn0 = rw[2 * mn]; wn1 = rw[2 * mn + 1]; }
        else {
#pragma unroll
            for (int j = 0; j < 8; ++j) { q0[j] = 0u; q1[j] = 0u; xn[j] = (u32x2){0u, 0u}; } }
        f32x4* xq = (f32x4*)(X + (size_t)m * D) + lane; const LAS f32x4* gq = VG + (m >> 13) * 512 + lane;
        const float c0 = w0 * Y8_INV, c1 = w1 * Y8_INV;
        f32x4 v[8]; float s = 0.f;
#pragma unroll
        for (int j = 0; j < 8; ++j) {
            const f32x2 a0 = __builtin_amdgcn_cvt_pk_f32_fp8((int)p0[j], false), a1 = __builtin_amdgcn_cvt_pk_f32_fp8((int)p0[j], true), b0 = __builtin_amdgcn_cvt_pk_f32_fp8((int)p1[j], false), b1 = __builtin_amdgcn_cvt_pk_f32_fp8((int)p1[j], true);
            const f32x4 yy = (f32x4){a0.x, a0.y, a1.x, a1.y} * c0 + (f32x4){b0.x, b0.y, b1.x, b1.y} * c1;
            v[j] = (f32x4){bf_lo(xb[j].x), bf_hi(xb[j].x), bf_lo(xb[j].y), bf_hi(xb[j].y)} * DN_ALPHA + gq[64 * j] * yy; s += (v[j].x + v[j].y) + (v[j].z + v[j].w); }
        const float mean = wave_sum(s) * (1.f / D); float s2 = 0.f;
#pragma unroll
        for (int j = 0; j < 8; ++j) { v[j] = v[j] - mean; s2 += (v[j].x * v[j].x + v[j].y * v[j].y) + (v[j].z * v[j].z + v[j].w * v[j].w); }
        const float rstd = 1.f / sqrtf(wave_sum(s2) * (1.f / D) + LN_EPS);
        const LAS f32x4* g2 = VG + 4 * 512 + lane; const LAS f32x4* b2 = VG + 5 * 512 + lane;
#pragma unroll
        for (int j = 0; j < 8; ++j) __builtin_nontemporal_store(v[j] * rstd * g2[64 * j] + b2[64 * j], xq + 64 * j);
#pragma unroll
        for (int j = 0; j < 8; ++j) { p0[j] = q0[j]; p1[j] = q1[j]; xb[j] = xn[j]; }
        w0 = wn0; w1 = wn1;
    }
}

__global__ void __launch_bounds__(NWAVES * 64, 2) fwd_kernel(Args a) {
    extern __shared__ __attribute__((aligned(16))) unsigned char lds_raw[];
    LAS unsigned char* lds = (LAS unsigned char*)lds_raw;
    const int tid = threadIdx.x, lane = tid & 63, wave = __builtin_amdgcn_readfirstlane(tid >> 6), G = gridDim.x, bid = blockIdx.x;
    for (int u = tid; u < (LDS_BYTES - MISC_OFF) / 4; u += NWAVES * 64) ((LAS unsigned*)(lds + MISC_OFF))[u] = 0u;
    __syncthreads();
    if (tid < NIN + 2) { const unsigned long long* kp = (const unsigned long long*)&a; const unsigned long long v = kp[tid];
        volatile LAS unsigned* tab = (volatile LAS unsigned*)(lds + ARGS_OFF); tab[2 * tid] = (unsigned)v; tab[2 * tid + 1] = (unsigned)(v >> 32); }
    __syncthreads();
    unsigned char* ws = AWS;
    const int lo = a.ph_lo, hi = a.ph_hi;
    XcdBarrier bar; bar.bar = (unsigned*)(ws + WS_CTL) + CW_BAR; bar.x = 0; bar.st = nullptr;
    if (hi - lo > 1) bar = xcd_barrier_post((unsigned*)(ws + WS_CTL) + CW_BAR, (volatile LAS unsigned*)(lds + MISC_OFF));
#ifndef PHASE_MASK
#define PHASE_MASK 0x3fff
#endif
#define IN(k) (((PHASE_MASK >> (k)) & 1) && lo <= (k) && (k) < hi)
#define SEAM(k) do { if (IN(k) && IN((k) + 1)) xcd_barrier(bar); } while (0)
    LAS int* moe_pre = (LAS int*)(lds + MISC_OFF + 256);
    LAS int* moe_cnt = (LAS int*)(lds + MISC_OFF + 512);

    if (IN(0)) { ph0(lds, tid, lane, wave, G, bid); } SEAM(0);
    if (IN(1)) { ph1(lds, tid, G, bid); } SEAM(1);
    if (IN(2)) { ph2(lds, tid, lane, wave, G, bid); } SEAM(2);
    if (IN(3)) {
        ctx_inproj(lds, lane, wave, G, bid);
        { SchedRect S; S.o.init(T / 256, 6, G, bid); S.A = (const char*)(ws + WS_RA); S.B = (const char*)(ws + WS_WG8); S.lda = D / 2; S.ldb = D / 2; S.nt = D / 128;
          EpiInProjT<true> E{(bf16*)(ws + WS_UF), (bf16*)(ws + WS_A2), nullptr, nullptr};
          pg8::gemm_phase<EpiInProjT<true>, SchedRect, true, true>(lds, S, E); }
        { SchedRect S; S.o.init(T / 256, 16, G, bid); S.A = (const char*)(ws + WS_RA); S.B = (const char*)(ws + WS_WG8) + (size_t)1536 * D; S.lda = D / 2; S.ldb = D / 2; S.nt = D / 128;
          EpiGates8 E{(unsigned char*)AOUT, (unsigned char*)AOUT + (size_t)T * D};
          pg8::gemm_phase<EpiGates8, SchedRect, true, true>(lds, S, E); }
    } SEAM(3);
    if (IN(4)) {
#ifndef NO_P4A
        { SchedE S{G, bid, (const char*)(ws + WS_A2), (const char*)(ws + WS_WET)}; EpiE E{(float*)(ws + WS_E)}; pg8::gemm_phase<EpiE, SchedE>(lds, S, E); }
#endif
#ifndef NO_P4B
        ctx_E(lds, lane, wave, G, bid);
#endif
#ifndef NO_P4C
        { SchedF1 S{G, bid, (const char*)(ws + WS_FKT), (const char*)(ws + WS_UF)}; EpiF1 E{(bf16*)(ws + WS_R3)}; pg8::gemm_phase<EpiF1, SchedF1>(lds, S, E); }
#endif
    } SEAM(4);
    if (IN(5)) {
        chunk_scan(lds, lane, wave, G, bid);
        { SchedF2 S{G, bid, (const char*)(ws + WS_FCT), (const char*)(ws + WS_R3)}; EpiF2 E{(bf16*)(ws + WS_RA)}; pg8::gemm_phase<EpiF2, SchedF2>(lds, S, E); }
    } SEAM(5);
    if (IN(6)) {
#ifndef NO_P6A
        { SchedSSM S{G, bid, (const char*)(ws + WS_A2), (const char*)(ws + WS_TV)}; EpiSSM E{(bf16*)(ws + WS_YS)}; pg8::gemm_phase<EpiSSM, SchedSSM>(lds, S, E); }
#endif
#ifndef NO_P6B
        { SchedF3 S{G, bid, (const char*)(ws + WS_FRT), (const char*)(ws + WS_RA)}; EpiF3 E{(unsigned char*)(ws + WS_R3)}; pg8::gemm_phase<EpiF3, SchedF3>(lds, S, E); }
#endif
    } SEAM(6);
    if (IN(7)) {
        SchedRect S; S.o.init(T / 256, SW / 256, G, bid); S.A = (const char*)(ws + WS_YS); S.B = (const char*)(ws + WS_WGLUT); S.lda = SW; S.ldb = SW; S.nt = SW / 64;
        EpiGate<2> E{nullptr, (const void*)(ws + WS_YS), AIN(IBGLU), SW, (unsigned char*)(ws + WS_R3), SW + FW};
        pg8::gemm_phase<EpiGate<2>, SchedRect>(lds, S, E);
    } SEAM(7);
    if (IN(8)) {
        SchedMerge S; S.o.init(T / 256, D / 256, G, bid); S.A = (const char*)(ws + WS_R3); S.B = (const char*)(ws + WS_WFT);
        EpiMerge E{(unsigned char*)(ws + WS_RA), (const unsigned char*)AOUT, (const unsigned char*)AOUT + (size_t)T * D};
        pg8::gemm_phase<EpiMerge, SchedMerge, true, true>(lds, S, E);
    } SEAM(8);
    if (IN(9)) {
        SchedRect S; S.o.init(T / 256, D / 256, G, bid); S.A = (const char*)(ws + WS_RA); S.B = (const char*)(ws + WS_WOT); S.lda = D / 2; S.ldb = D / 2; S.nt = D / 128;
        EpiOut E{(const float*)(ws + WS_MODV), (bf16*)(ws + WS_R3)};
        pg8::gemm_phase<EpiOut, SchedRect, true, true>(lds, S, E);
    } SEAM(9);
    if (IN(10)) { ph10(lds, tid, lane, wave, G, bid); } SEAM(10);
    if (IN(11) || IN(12)) {
        if (tid < 64) { const int cnt = tid < NE ? (int)__hip_atomic_load((unsigned*)(ws + WS_CTL) + CW_CNT + 64 * tid, RLX_AGENT) : 0; const int tiles = (cnt + 255) >> 8; int incl = tiles;
#pragma unroll
            for (int o = 1; o < 32; o <<= 1) { const int t = __shfl_up(incl, o); if (lane >= o) incl += t; }
            if (tid < NE) { moe_pre[tid] = incl - tiles; moe_cnt[tid] = cnt; } if (tid == NE - 1) moe_pre[NE] = incl; }
        __syncthreads();
    }
    if (IN(11)) {
        SchedMoe<1, D, D, D / 128> S{G, bid, (const char*)(ws + WS_RB), (const char*)(ws + WS_W13T), (const int*)(ws + WS_ROWLIST), moe_pre, moe_cnt};
        EpiMoe1 E{(unsigned char*)(ws + WS_RA), (const int*)(ws + WS_ROWLIST)};
        pg8::gemm_phase<EpiMoe1, SchedMoe<1, D, D, D / 128>, true, true>(lds, S, E);
    } SEAM(11);
    if (IN(12)) {
        SchedMoe<0, DE, DE, DE / 128> S{G, bid, (const char*)(ws + WS_RA), (const char*)(ws + WS_W2T), (const int*)(ws + WS_ROWLIST), moe_pre, moe_cnt};
        EpiMoe2 E{(unsigned char*)(ws + WS_RB), (const int*)(ws + WS_ROWLIST)};
        pg8::gemm_phase<EpiMoe2, SchedMoe<0, DE, DE, DE / 128>, true, true>(lds, S, E);
    } SEAM(12);
    if (IN(13)) { ph13(lds, tid, lane, wave, G, bid); }
#undef IN
#undef SEAM
}

extern "C" void kernel_launch(void* const* d_in, const int* in_sizes, int n_in, void* d_out, int out_size, void* d_ws, size_t ws_size, hipStream_t stream) {
    static int grid = 0;
    if (grid == 0) {
        if (n_in != NIN || out_size != T * D || ws_size < WS_END) { fprintf(stderr, "kernel_launch: unexpected problem (n_in %d, out %d, ws %zu); nothing launched\n", n_in, out_size, ws_size); grid = -1; return; }
        int dev = 0, cus = 0, per_cu = 0;
        if (hipGetDevice(&dev) != hipSuccess || hipDeviceGetAttribute(&cus, hipDeviceAttributeMultiprocessorCount, dev) != hipSuccess) { grid = -1; return; }
        if (hipFuncSetAttribute((const void*)fwd_kernel, hipFuncAttributeMaxDynamicSharedMemorySize, LDS_BYTES) != hipSuccess) { fprintf(stderr, "kernel_launch: hipFuncSetAttribute failed\n"); grid = -1; return; }
        if (hipOccupancyMaxActiveBlocksPerMultiprocessor(&per_cu, (const void*)fwd_kernel, NWAVES * 64, LDS_BYTES) != hipSuccess || per_cu < 1) { fprintf(stderr, "kernel_launch: occupancy query says %d\n", per_cu); (void)hipGetLastError(); }
        grid = cus > 256 ? 256 : cus;
    }
    if (grid < 0) return;
    (void)hipMemsetAsync((char*)d_ws + WS_CTL, 0, CTL_ZERO_BYTES, stream);
    Args a{};
    for (int i = 0; i < NIN; ++i) a.in[i] = (const float*)d_in[i];
    a.out = (float*)d_out; a.ws = (unsigned char*)d_ws;
#if MK_ONE_LAUNCH
    a.ph_lo = 0; a.ph_hi = NPHASE;
    hipLaunchKernelGGL(fwd_kernel, dim3(grid), dim3(NWAVES * 64), LDS_BYTES, stream, a);
#else
#ifndef RUN_PHASES
#define RUN_PHASES NPHASE
#endif
    for (int p = 0; p < RUN_PHASES; ++p) { a.ph_lo = p; a.ph_hi = p + 1; hipLaunchKernelGGL(fwd_kernel, dim3(grid), dim3(NWAVES * 64), LDS_BYTES, stream, a); }
#endif
}
```

```cpp
#include <hip/hip_runtime.h>
#include <cstdio>
#include <cstdint>

#ifndef MK_ONE_LAUNCH
#define MK_ONE_LAUNCH 1
#endif

#define GAS __attribute__((address_space(1)))
#define LAS __attribute__((address_space(3)))
typedef unsigned short bf16;
typedef float f32x4 __attribute__((ext_vector_type(4)));
typedef float f32x2 __attribute__((ext_vector_type(2)));
typedef short bf16x8 __attribute__((ext_vector_type(8)));
typedef unsigned u32x4 __attribute__((ext_vector_type(4)));
typedef unsigned u32x2 __attribute__((ext_vector_type(2)));
typedef int i32x4 __attribute__((ext_vector_type(4)));
typedef int i32x8 __attribute__((ext_vector_type(8)));
typedef GAS unsigned gu32;
#define RLX_AGENT __ATOMIC_RELAXED, __HIP_MEMORY_SCOPE_AGENT

constexpr int D = 2048, NB = 4, SEQ = 8192, T = NB * SEQ, CTXL = 256, TC = NB * CTXL;
constexpr int FW = 1024, SW = 512, INW = 5632;
constexpr int SG = 32, SH = 16, SP = 64, LC = 32, NCH = 264, NCTXCH = 8, A2LD = 768;
constexpr int NE = 32, DE = 1024, ECAP = 32768;
constexpr float LN_EPS = 1e-5f;
constexpr float DN_ALPHA = 1.189207115002721f;
constexpr int NPHASE = 14;

constexpr size_t MiB = 1u << 20;
constexpr size_t WS_CTL = 0, CTL_ZERO_BYTES = 64 * 1024;
constexpr size_t WS_MODPART = 1 * MiB;
constexpr size_t WS_MODV = 5 * MiB;
constexpr size_t WS_PW = 6 * MiB;
constexpr size_t WS_BBAR = 8 * MiB;
constexpr size_t WS_LAML = 9 * MiB;
constexpr size_t WS_LAMSEG = 9 * MiB + 512 * 1024;
constexpr size_t WS_KLAG = 10 * MiB;
constexpr size_t WS_RW = 12 * MiB;
constexpr size_t WS_ROWLIST = 13 * MiB;
constexpr size_t WS_FKT = 17 * MiB;
constexpr size_t WS_FCT = 17 * MiB + 256 * 1024;
constexpr size_t WS_FRT = 17 * MiB + 512 * 1024;
constexpr size_t WS_WRTHI = 17 * MiB + 768 * 1024;
constexpr size_t WS_WRTLO = 18 * MiB;
constexpr size_t WS_HC = 19 * MiB;
constexpr size_t WS_WINT = 24 * MiB;
constexpr size_t WS_WG8 = 32 * MiB;
constexpr size_t WS_WFT = 46 * MiB;
constexpr size_t WS_WST = 50 * MiB;
constexpr size_t WS_WOT = 52 * MiB;
constexpr size_t WS_WGLUT = 60 * MiB;
constexpr size_t WS_WET = 61 * MiB;
constexpr size_t WS_TV = 69 * MiB;
constexpr size_t WS_W13T = 96 * MiB;
constexpr size_t WS_XMID = 224 * MiB;
constexpr size_t WS_W2T = 352 * MiB;
constexpr size_t WS_R3 = 480 * MiB;
constexpr size_t WS_RA = 608 * MiB;
constexpr size_t WS_RB = 736 * MiB;
constexpr size_t WS_UF = WS_RB;
constexpr size_t WS_A2 = WS_RB + 64 * MiB;
constexpr size_t WS_E = WS_RB + 114 * MiB;
constexpr size_t WS_YS = WS_RB + 148 * MiB;
constexpr size_t WS_SOUT = WS_RB + 180 * MiB;
constexpr size_t WS_END = 992 * MiB;
constexpr int CW_TMO = 0, CW_BAR = 4096, CW_CNT = 8192;

constexpr int RING_BYTES = 131072;
constexpr int MISC_OFF = 147456;
constexpr int LDS_BYTES = 155648;
constexpr int NWAVES = 8;

typedef __bf16 bf16x2_t __attribute__((ext_vector_type(2)));
__device__ __forceinline__ unsigned pk_bf16(float lo, float hi) { const bf16x2_t r = __builtin_convertvector((f32x2){lo, hi}, bf16x2_t); return __builtin_bit_cast(unsigned, r); }
__device__ __forceinline__ float bf_lo(unsigned u) { return __uint_as_float(u << 16); }
__device__ __forceinline__ float bf_hi(unsigned u) { return __uint_as_float(u & 0xffff0000u); }
__device__ __forceinline__ bf16 f2bf(float f) { unsigned u = __float_as_uint(f); return (bf16)((u + 0x7fffu + ((u >> 16) & 1u)) >> 16); }
__device__ __forceinline__ float bf2f(bf16 b) { return __uint_as_float(((unsigned)b) << 16); }
__device__ __forceinline__ float fsigmoid(float x) { return __builtin_amdgcn_rcpf(1.0f + __builtin_amdgcn_exp2f(-1.44269504f * x)); }
__device__ __forceinline__ void st16_bf16(bf16* dst, f32x4 a, f32x4 b, f32x4 c, f32x4 d) {
    u32x4 w0, w1; w0.x = pk_bf16(a[0], a[1]); w0.y = pk_bf16(a[2], a[3]); w0.z = pk_bf16(b[0], b[1]); w0.w = pk_bf16(b[2], b[3]);
    w1.x = pk_bf16(c[0], c[1]); w1.y = pk_bf16(c[2], c[3]); w1.z = pk_bf16(d[0], d[1]); w1.w = pk_bf16(d[2], d[3]);
    *(u32x4*)dst = w0; *(u32x4*)(dst + 8) = w1; }
__device__ __forceinline__ unsigned pk4_u8(float a, float b, float c, float d) {
    const unsigned ya = __builtin_bit_cast(unsigned, a * 255.0f + 8388608.0f), yb = __builtin_bit_cast(unsigned, b * 255.0f + 8388608.0f), yc = __builtin_bit_cast(unsigned, c * 255.0f + 8388608.0f), yd = __builtin_bit_cast(unsigned, d * 255.0f + 8388608.0f);
    const unsigned w01 = __builtin_amdgcn_perm(yb, ya, 0x0c0c0400u), w23 = __builtin_amdgcn_perm(yd, yc, 0x0c0c0400u);
    return __builtin_amdgcn_perm(w23, w01, 0x05040100u); }
__device__ __forceinline__ f32x4 u8x4_f32(unsigned w) { return (f32x4){(float)(w & 0xffu), (float)((w >> 8) & 0xffu), (float)((w >> 16) & 0xffu), (float)(w >> 24)}; }
__device__ __forceinline__ float gelu_tanh(float x) { return x * fsigmoid(1.5957691216f * (x + 0.044715f * x * x * x)); }
__device__ __forceinline__ float wave_sum(float v) {
#pragma unroll
    for (int o = 1; o < 64; o <<= 1) v += __shfl_xor(v, o);
    return v;
}
constexpr float W8_SCALE = 64.0f, W8_INV = 1.0f / 64.0f;
__device__ __forceinline__ float clamp8(float x) { return __builtin_amdgcn_fmed3f(x, -448.0f, 448.0f); }
__device__ __forceinline__ unsigned pk4_fp8(float a, float b, float c, float d) { int w = 0; w = __builtin_amdgcn_cvt_pk_fp8_f32(clamp8(a), clamp8(b), w, false); w = __builtin_amdgcn_cvt_pk_fp8_f32(clamp8(c), clamp8(d), w, true); return (unsigned)w; }
#define LDS_WAIT() asm volatile("s_waitcnt lgkmcnt(0)" ::: "memory")
#define VM_WAIT() asm volatile("s_waitcnt vmcnt(0)" ::: "memory")

#define XB_TMO      128
#define XB_XCNT(j)  (256  + 64 * (j))
#define XB_XSUB(j)  (1280 + 64 * (j))
#define XB_XGEN(j)  (2304 + 64 * (j))
#define XB_TOP      3328
#define XB_TOPGEN   3392
#define XCD_BAR_WORDS 3456
#define XB_SPIN_CAP (1u << 18)
__device__ __forceinline__ unsigned xb_ld(unsigned* p)              { return __hip_atomic_load(p, __ATOMIC_RELAXED, __HIP_MEMORY_SCOPE_AGENT); }
__device__ __forceinline__ unsigned xb_add(unsigned* p, unsigned v) { return __hip_atomic_fetch_add(p, v, __ATOMIC_RELAXED, __HIP_MEMORY_SCOPE_AGENT); }
__device__ __forceinline__ unsigned xb_xcc_id() { return (unsigned)__builtin_amdgcn_s_getreg((3 << 11) | 20) & 0xFu; }
#define XB_SPIN(cond, bar) do { unsigned _sp = 0; while (cond) { __builtin_amdgcn_s_sleep(1); \
    if ((++_sp & 255u) == 0u) { if (xb_ld(&(bar)[XB_TMO])) break; if (_sp > XB_SPIN_CAP) { atomicAdd(&(bar)[XB_TMO], 1u); break; } } } } while (0)
struct XcdBarrier { unsigned* bar; unsigned x; volatile LAS unsigned* st; };
__device__ __forceinline__ XcdBarrier xcd_barrier_post(unsigned* bar, volatile LAS unsigned* st) {
    XcdBarrier b; b.bar = bar; b.x = xb_xcc_id(); b.st = st;
    if (threadIdx.x == 0) (void)xb_add(&bar[XB_XCNT(b.x)], 1u);
    return b;
}
__device__ __forceinline__ void xcd_barrier_complete(unsigned* bar, unsigned x, unsigned& nloc, unsigned& nx) {
    const unsigned G = gridDim.x * gridDim.y * gridDim.z;
    unsigned sum, cnt, mine, sp = 0u;
    for (;;) {
        sum = 0u; cnt = 0u; mine = 0u;
#pragma unroll
        for (unsigned j = 0; j < 16; ++j) { const unsigned c = xb_ld(&bar[XB_XCNT(j)]); sum += c; cnt += (c > 0u) ? 1u : 0u; mine = (j == x) ? c : mine; }
        if (sum == G) break;
        __builtin_amdgcn_s_sleep(1);
        if ((++sp & 255u) == 0u) { if (xb_ld(&bar[XB_TMO])) break; if (sp > XB_SPIN_CAP) { atomicAdd(&bar[XB_TMO], 1u); break; } }
    }
    nloc = mine > 0u ? mine : 1u; nx = cnt > 0u ? cnt : 1u;
}
__device__ __forceinline__ void xcd_barrier(const XcdBarrier& b) {
    asm volatile("s_waitcnt vmcnt(0)" ::: "memory");
    __syncthreads();
    if (threadIdx.x == 0) {
        unsigned* bar = b.bar;
        __builtin_amdgcn_s_waitcnt(0);
        unsigned nloc = b.st[0], nx = b.st[1];
        if (nloc == 0u) { xcd_barrier_complete(bar, b.x, nloc, nx); b.st[0] = nloc; b.st[1] = nx; }
        const unsigned old = xb_add(&bar[XB_XSUB(b.x)], 1u);
        const unsigned gen = old / nloc;
        if (old + 1u == (gen + 1u) * nloc) {
            __builtin_amdgcn_fence(__ATOMIC_RELEASE, "agent");
            asm volatile("s_waitcnt vmcnt(0)" ::: "memory");
            const unsigned og = xb_add(&bar[XB_TOP], 1u);
            const unsigned tg = og / nx;
            if (og + 1u == (tg + 1u) * nx) xb_add(&bar[XB_TOPGEN], 1u);
            else XB_SPIN(xb_ld(&bar[XB_TOPGEN]) == tg, bar);
            __builtin_amdgcn_fence(__ATOMIC_ACQUIRE, "agent");
            xb_add(&bar[XB_XGEN(b.x)], 1u);
            asm volatile("s_waitcnt vmcnt(0)" ::: "memory");
        } else {
            XB_SPIN(xb_ld(&bar[XB_XGEN(b.x)]) == gen, bar);
            __builtin_amdgcn_fence(__ATOMIC_ACQUIRE, "agent");
            asm volatile("s_waitcnt vmcnt(0)" ::: "memory");
        }
    }
    __syncthreads();
}

namespace pg8 {
#define PG8_LAS __attribute__((address_space(3)))
constexpr int BM = 256, BK = 64, HALF = 128, HTB = HALF * BK * 2, STAGE_BYTES = 8 * HTB, NXCD = 8, WGM = 8;
__host__ __device__ __forceinline__ int lds_byte(int r, int c) { const int st = (r >> 4) * 2 + (c >> 5), rr = r & 15, cc = c & 31, ob = rr * 64 + cc * 2; return st * 1024 + (ob ^ (((ob >> 9) & 1) << 5)); }
__host__ __device__ __forceinline__ void stage_rc(int b, int& R, int& C) { const int st = b / 1024, sb = b % 1024, swz = sb ^ (((sb >> 9) & 1) << 5); R = (st >> 1) * 16 + swz / 64; C = (st & 1) * 32 + (swz % 64) / 2; }
__host__ __device__ __forceinline__ int perm32(int rho) { const int n = rho >> 4, i = rho & 15; return 8 * (i >> 2) + 4 * n + (i & 3); }

struct GUnit { const char* A; const char* B; int nt, x0, x1, x2, x3; };
template <class E, class = void> struct HasSeg { static constexpr bool v = false; };
template <class E> struct HasSeg<E, decltype((void)E::SEG2)> { static constexpr bool v = E::SEG2; };
template <class S, class = void> struct SchedKstep { static constexpr int v = 128; };
template <class S> struct SchedKstep<S, decltype((void)S::KSTEP)> { static constexpr int v = S::KSTEP; };
template <class E, class = void> struct HasP16 { static constexpr bool v = false; };
template <class E> struct HasP16<E, decltype((void)E::PERM16)> { static constexpr bool v = E::PERM16; };

struct RectOrder {
    int nM, nN, nwg, G, c;
    __device__ __forceinline__ void init(int nM_, int nN_, int G_, int c_) { nM = nM_; nN = nN_; nwg = nM * nN; G = G_; c = c_; }
    __device__ __forceinline__ bool get(int i, int& pm, int& pn) const {
        const long L = (long)i * G + c; if (L >= nwg) return false;
        int wgid = (int)L; { const int q = nwg / NXCD, r = nwg % NXCD, xcd = wgid % NXCD, off = wgid / NXCD; wgid = (xcd < r ? xcd * (q + 1) : r * (q + 1) + (xcd - r) * q) + off; }
        const int nig = WGM * nN, gid = wgid / nig, fm = gid * WGM, gsz = (nM - fm) < WGM ? (nM - fm) : WGM;
        pm = fm + ((wgid % nig) % gsz); pn = (wgid % nig) / gsz; return true;
    }
};

template <class Epi, class Sched, bool ALIGN_EPI = true, bool F8 = false>
__device__ __forceinline__ void gemm_phase(PG8_LAS unsigned char* lds, const Sched& S, const Epi& E) {
    const int tid = threadIdx.x, wid = __builtin_amdgcn_readfirstlane(tid >> 6), lane = tid & 63, wr = wid >> 2, wc = wid & 3, fr = lane & 15, fq = lane >> 4;
    int Rs[2], Cs[2];
#pragma unroll
    for (int i = 0; i < 2; ++i) stage_rc(tid * 16 + i * 8192, Rs[i], Cs[i]);
    unsigned voffB[2][2], voffA[2][2], voffAn[2][2];
#pragma unroll
    for (int h = 0; h < 2; ++h)
#pragma unroll
        for (int i = 0; i < 2; ++i) {
            if constexpr (HasP16<Epi>::v) { const int r = Rs[i]; voffB[h][i] = S.b_off(64 * (r >> 5) + 16 * ((r & 15) >> 2) + 8 * h + 4 * ((r >> 4) & 1) + (r & 3), Cs[i]); }
            else { const int Rb = Epi::PERM ? ((Rs[i] & ~31) + perm32(Rs[i] & 31)) : Rs[i]; voffB[h][i] = S.b_off(h * HALF + Rb, Cs[i]); } }
    const size_t kstep = (size_t)SchedKstep<Sched>::v;
    const unsigned ldsw = (unsigned)wid * 1024u;
    const int aoff = lds_byte(wr * 64 + fr, fq * 8), boff = lds_byte(wc * 32 + fr, fq * 8);
#define PG8_SA(b, h) (((b) * 2 + (h)) * HTB)
#define PG8_SB(b, h) ((4 + (b) * 2 + (h)) * HTB)
#define PG8_STAGE(bufoff, gbase, voff) do { _Pragma("unroll") for (int _i = 0; _i < 2; ++_i) \
        __builtin_amdgcn_global_load_lds((const unsigned*)((const char*)(gbase) + (voff)[_i]), (PG8_LAS unsigned*)(lds + (bufoff) + ldsw + _i * 8192), 16, 0, 0); } while (0)
#define PG8_LDA(dst, b, h) do { if constexpr (F8) { _Pragma("unroll") for (int m = 0; m < 4; ++m) dst##8[m] = __builtin_shufflevector(*(const PG8_LAS i32x4*)(lds + PG8_SA(b, h) + aoff + m * 2048), *(const PG8_LAS i32x4*)(lds + PG8_SA(b, h) + aoff + m * 2048 + 1024), 0, 1, 2, 3, 4, 5, 6, 7); } \
        else { _Pragma("unroll") for (int m = 0; m < 4; ++m) _Pragma("unroll") for (int k = 0; k < 2; ++k) dst[m][k] = *(const PG8_LAS bf16x8*)(lds + PG8_SA(b, h) + aoff + m * 2048 + k * 1024); } } while (0)
#define PG8_LDB(dst, b, h) do { if constexpr (F8) { _Pragma("unroll") for (int n = 0; n < 2; ++n) dst##8[n] = __builtin_shufflevector(*(const PG8_LAS i32x4*)(lds + PG8_SB(b, h) + boff + n * 2048), *(const PG8_LAS i32x4*)(lds + PG8_SB(b, h) + boff + n * 2048 + 1024), 0, 1, 2, 3, 4, 5, 6, 7); } \
        else { _Pragma("unroll") for (int n = 0; n < 2; ++n) _Pragma("unroll") for (int k = 0; k < 2; ++k) dst[n][k] = *(const PG8_LAS bf16x8*)(lds + PG8_SB(b, h) + boff + n * 2048 + k * 1024); } } while (0)
#define PG8_MMA(ai, bj, At, Bt) do { __builtin_amdgcn_s_setprio(1); _Pragma("unroll") for (int m = 0; m < 4; ++m) _Pragma("unroll") for (int n = 0; n < 2; ++n) { \
        if constexpr (F8) { asm volatile("v_mfma_scale_f32_16x16x128_f8f6f4 %0, %1, %2, %0, %3, %3 op_sel_hi:[0,0,0]" : "+v"(acc[ai][bj][m][n]) : "v"(Bt##8[n]), "v"(At##8[m]), "v"(f8scale)); } \
        else { _Pragma("unroll") for (int k = 0; k < 2; ++k) acc[ai][bj][m][n] = __builtin_amdgcn_mfma_f32_16x16x32_bf16(Bt[n][k], At[m][k], acc[ai][bj][m][n], 0, 0, 0); } } \
        if constexpr (F8) asm volatile("s_nop 3" ::: "memory");     \
        __builtin_amdgcn_s_setprio(0); } while (0)
#define PG8_WAIT_V(n) asm volatile("s_waitcnt vmcnt(" #n ")" ::: "memory")
#define PG8_WAIT_L(n) asm volatile("s_waitcnt lgkmcnt(" #n ")" ::: "memory")
#define PG8_BAR __builtin_amdgcn_s_barrier()
#define PG8_SCHED __builtin_amdgcn_sched_barrier(0)
    GUnit cur, nxt; int ui = 0;
    if (!S.next(0, cur)) return;
    S.a_off(cur, Rs, Cs, voffA);
#pragma unroll
    for (int h = 0; h < 2; ++h)
#pragma unroll
        for (int i = 0; i < 2; ++i) voffAn[h][i] = voffA[h][i];
    f32x4 acc[2][2][4][2];
#pragma unroll
    for (int a = 0; a < 2; ++a)
#pragma unroll
        for (int b = 0; b < 2; ++b)
#pragma unroll
            for (int m = 0; m < 4; ++m)
#pragma unroll
                for (int n = 0; n < 2; ++n) acc[a][b][m][n] = (f32x4){0.f, 0.f, 0.f, 0.f};
    bf16x8 At[4][2], B0[2][2], B1[2][2]; i32x8 At8[4], B08[2], B18[2];
    const int f8scale = 0x7F7F7F7F;
    const char* cA = cur.A; const char* cB = cur.B;
    PG8_STAGE(PG8_SB(0, 0), cB, voffB[0]); PG8_STAGE(PG8_SB(0, 1), cB, voffB[1]); PG8_STAGE(PG8_SA(0, 0), cA, voffA[0]); PG8_STAGE(PG8_SA(0, 1), cA, voffA[1]);
    if (wr == 1) PG8_BAR;
    PG8_WAIT_V(2); PG8_BAR;
    PG8_STAGE(PG8_SB(1, 0), cB + kstep, voffB[0]); PG8_STAGE(PG8_SA(1, 0), cA + kstep, voffA[0]); PG8_STAGE(PG8_SB(1, 1), cB + kstep, voffB[1]);
    PG8_WAIT_V(6); PG8_BAR;
    for (;;) {
        const bool has_next = S.next(ui + 1, nxt);
        const char* nA = has_next ? nxt.A : cA; const char* nB = has_next ? nxt.B : cB;
        const int nt = cur.nt;
#pragma unroll 1
        for (int t = 0; t < nt; t += 2) {
            const bool last = (t == nt - 2);
            if constexpr (Sched::GATHER) { if (last && has_next) S.a_off(nxt, Rs, Cs, voffAn); }
            const char* a1 = cA + (size_t)(t + 1) * kstep;
            const char* a2 = last ? nA : cA + (size_t)(t + 2) * kstep; const char* b2 = last ? nB : cB + (size_t)(t + 2) * kstep;
            const char* a3 = a2 + kstep; const char* b3 = b2 + kstep;
            unsigned vA2[2][2];
#pragma unroll
            for (int h = 0; h < 2; ++h)
#pragma unroll
                for (int i = 0; i < 2; ++i) { if constexpr (Sched::GATHER) vA2[h][i] = (last && has_next) ? voffAn[h][i] : voffA[h][i]; else vA2[h][i] = voffA[h][i]; }
            PG8_LDB(B0, 0, 0); PG8_LDB(B1, 0, 1); PG8_SCHED; PG8_LDA(At, 0, 0); PG8_STAGE(PG8_SA(1, 1), a1, voffA[1]);
            PG8_WAIT_V(8); PG8_WAIT_L(0); PG8_BAR; PG8_MMA(0, 0, At, B0); PG8_MMA(0, 1, At, B1); PG8_BAR; PG8_SCHED;
            PG8_LDA(At, 0, 1); PG8_STAGE(PG8_SB(0, 0), b2, voffB[0]); PG8_STAGE(PG8_SB(0, 1), b2, voffB[1]); PG8_STAGE(PG8_SA(0, 0), a2, vA2[0]);
            PG8_WAIT_V(8); PG8_WAIT_L(0); PG8_BAR; PG8_MMA(1, 0, At, B0); PG8_MMA(1, 1, At, B1); PG8_BAR; PG8_SCHED;
            PG8_LDB(B0, 1, 0); PG8_LDB(B1, 1, 1); PG8_SCHED; PG8_LDA(At, 1, 0); PG8_STAGE(PG8_SA(0, 1), a2, vA2[1]);
            PG8_WAIT_V(8); PG8_WAIT_L(0); PG8_BAR; PG8_MMA(0, 0, At, B0); PG8_MMA(0, 1, At, B1); PG8_BAR; PG8_SCHED;
            PG8_LDA(At, 1, 1); PG8_STAGE(PG8_SB(1, 0), b3, voffB[0]); PG8_STAGE(PG8_SB(1, 1), b3, voffB[1]); PG8_STAGE(PG8_SA(1, 0), a3, vA2[0]);
            PG8_WAIT_V(8); PG8_WAIT_L(0); PG8_BAR; PG8_MMA(1, 0, At, B0); PG8_MMA(1, 1, At, B1); PG8_BAR; PG8_SCHED;
        }
        if constexpr (ALIGN_EPI) { if (wr == 0) PG8_BAR; }
        if constexpr (F8) {
#pragma unroll
            for (int a = 0; a < 2; ++a)
#pragma unroll
                for (int b = 0; b < 2; ++b)
                    asm volatile("s_nop 15\n\ts_nop 7" : "+v"(acc[a][b][0][0]), "+v"(acc[a][b][0][1]), "+v"(acc[a][b][1][0]), "+v"(acc[a][b][1][1]), "+v"(acc[a][b][2][0]), "+v"(acc[a][b][2][1]), "+v"(acc[a][b][3][0]), "+v"(acc[a][b][3][1]));
        }
        E(acc, cur, wr, wc, fr, fq);
        if (!has_next) break;
        if (!(HasSeg<Epi>::v && cur.x2 == 0)) {
#pragma unroll
        for (int a = 0; a < 2; ++a)
#pragma unroll
            for (int b = 0; b < 2; ++b)
#pragma unroll
                for (int m = 0; m < 4; ++m)
#pragma unroll
                    for (int n = 0; n < 2; ++n) acc[a][b][m][n] = (f32x4){0.f, 0.f, 0.f, 0.f};
        }
        cur = nxt; cA = nA; cB = nB; ++ui;
#pragma unroll
        for (int h = 0; h < 2; ++h)
#pragma unroll
            for (int i = 0; i < 2; ++i) voffA[h][i] = voffAn[h][i];
        if constexpr (ALIGN_EPI) { if (wr == 1) PG8_BAR; }
    }
    PG8_WAIT_V(0);
    if constexpr (!ALIGN_EPI) { if (wr == 0) PG8_BAR; }
    PG8_BAR;
#undef PG8_SA
#undef PG8_SB
#undef PG8_STAGE
#undef PG8_LDA
#undef PG8_LDB
#undef PG8_MMA
#undef PG8_WAIT_V
#undef PG8_WAIT_L
#undef PG8_BAR
#undef PG8_SCHED
}
}
using pg8::GUnit;
typedef const f32x4 (&AccRef)[2][2][4][2];


struct SchedRect {
    static constexpr bool GATHER = false;
    pg8::RectOrder o; const char* A; const char* B; int lda, ldb, nt;
    __device__ __forceinline__ bool next(int i, GUnit& u) const { int pm, pn; if (!o.get(i, pm, pn)) return false;
        u.A = A + (size_t)pm * 256 * lda * 2; u.B = B + (size_t)pn * 256 * ldb * 2; u.nt = nt; u.x0 = pm; u.x1 = pn; u.x2 = 0; u.x3 = 0; return true; }
    __device__ __forceinline__ unsigned b_off(int R, int C) const { return (unsigned)(R * ldb + C) * 2u; }
    __device__ __forceinline__ void a_off(const GUnit&, const int (&R)[2], const int (&C)[2], unsigned (&v)[2][2]) const {
#pragma unroll
        for (int h = 0; h < 2; ++h)
#pragma unroll
            for (int i = 0; i < 2; ++i) v[h][i] = (unsigned)((h * 128 + R[i]) * lda + C[i]) * 2u; }
};
__host__ __device__ __forceinline__ size_t tiled_off(size_t r, int kb, int ktiles) { return (((r >> 8) * ktiles + (kb >> 7)) << 15) + ((r & 255) << 7) + (kb & 127); }
struct SchedTiled {
    static constexpr bool GATHER = false; static constexpr int KSTEP = 32768;
    pg8::RectOrder o; const char* A; const char* B; int nt;
    __device__ __forceinline__ bool next(int i, GUnit& u) const { int pm, pn; if (!o.get(i, pm, pn)) return false;
        u.A = A + ((size_t)pm * nt << 15); u.B = B + ((size_t)pn * nt << 15); u.nt = nt; u.x0 = pm; u.x1 = pn; u.x2 = 0; u.x3 = 0; return true; }
    __device__ __forceinline__ unsigned b_off(int R, int C) const { return (unsigned)(R * 128 + C * 2); }
    __device__ __forceinline__ void a_off(const GUnit&, const int (&R)[2], const int (&C)[2], unsigned (&v)[2][2]) const {
#pragma unroll
        for (int h = 0; h < 2; ++h)
#pragma unroll
            for (int i = 0; i < 2; ++i) v[h][i] = (unsigned)((h * 128 + R[i]) * 128 + C[i] * 2); }
};
struct SchedRectOff {
    static constexpr bool GATHER = false;
    pg8::RectOrder o; const char* A; const char* B; int lda, ldb, nt, pn0;
    __device__ __forceinline__ bool next(int i, GUnit& u) const { int pm, pn; if (!o.get(i, pm, pn)) return false;
        u.A = A + (size_t)pm * 256 * lda * 2; u.B = B + (size_t)pn * 256 * ldb * 2; u.nt = nt; u.x0 = pm; u.x1 = pn + pn0; u.x2 = 0; u.x3 = 0; return true; }
    __device__ __forceinline__ unsigned b_off(int R, int C) const { return (unsigned)(R * ldb + C) * 2u; }
    __device__ __forceinline__ void a_off(const GUnit&, const int (&R)[2], const int (&C)[2], unsigned (&v)[2][2]) const {
#pragma unroll
        for (int h = 0; h < 2; ++h)
#pragma unroll
            for (int i = 0; i < 2; ++i) v[h][i] = (unsigned)((h * 128 + R[i]) * lda + C[i]) * 2u; }
};
struct SchedMerge {
    static constexpr bool GATHER = false; static constexpr int PITCH = SW + FW;
    pg8::RectOrder o; const char* A; const char* B;
    __device__ __forceinline__ bool next(int i, GUnit& u) const { int pm, pn; if (!o.get(i >> 1, pm, pn)) return false; const int seg = i & 1;
        u.A = A + (size_t)pm * 256 * PITCH + seg * SW; u.B = B + (size_t)pn * 256 * PITCH + seg * SW; u.nt = seg ? FW / 128 : SW / 128; u.x0 = pm; u.x1 = pn; u.x2 = seg; u.x3 = 0; return true; }
    __device__ __forceinline__ unsigned b_off(int R, int C) const { return (unsigned)(R * PITCH + C * 2); }
    __device__ __forceinline__ void a_off(const GUnit&, const int (&R)[2], const int (&C)[2], unsigned (&v)[2][2]) const {
#pragma unroll
        for (int h = 0; h < 2; ++h)
#pragma unroll
            for (int i = 0; i < 2; ++i) v[h][i] = (unsigned)((h * 128 + R[i]) * PITCH + C[i] * 2); }
};
struct SchedE {
    static constexpr bool GATHER = false;
    int G, c; const char* A2; const char* WeT;
    __device__ __forceinline__ bool next(int i, GUnit& u) const { const int L = i * G + c; if (L >= 128) return false; const int g = L >> 2, b = L & 3;
        u.A = A2 + ((size_t)((g * 4 + b) * NCH + NCTXCH) * A2LD) * 2; u.B = WeT + (size_t)g * 256 * 512 * 2; u.nt = 8; u.x0 = g; u.x1 = b; u.x2 = 0; u.x3 = 0; return true; }
    __device__ __forceinline__ unsigned b_off(int R, int C) const { return (unsigned)(R * 512 + C) * 2u; }
    __device__ __forceinline__ void a_off(const GUnit&, const int (&R)[2], const int (&C)[2], unsigned (&v)[2][2]) const {
#pragma unroll
        for (int h = 0; h < 2; ++h)
#pragma unroll
            for (int i = 0; i < 2; ++i) v[h][i] = (unsigned)((h * 128 + R[i]) * A2LD + C[i]) * 2u; }
};
struct SchedSSM {
    static constexpr bool GATHER = false;
    int G, c; const char* A2; const char* TV;
    __device__ __forceinline__ bool next(int i, GUnit& u) const { const int L = i * G + c; if (L >= 256) return false; const int g = L >> 3, b = (L >> 1) & 3, pn = L & 1;
        u.A = A2 + ((size_t)((g * 4 + b) * NCH + NCTXCH) * A2LD) * 2; u.B = TV + ((size_t)(g * 512 + pn * 256) * A2LD) * 2; u.nt = 12; u.x0 = g; u.x1 = b; u.x2 = pn; u.x3 = 0; return true; }
    __device__ __forceinline__ unsigned b_off(int R, int C) const { return (unsigned)(R * A2LD + C) * 2u; }
    __device__ __forceinline__ void a_off(const GUnit&, const int (&R)[2], const int (&C)[2], unsigned (&v)[2][2]) const {
#pragma unroll
        for (int h = 0; h < 2; ++h)
#pragma unroll
            for (int i = 0; i < 2; ++i) v[h][i] = (unsigned)((h * 128 + R[i]) * A2LD + C[i]) * 2u; }
};
struct SchedF1 {
    static constexpr bool GATHER = false;
    int G, c; const char* FkT; const char* UF;
    __device__ __forceinline__ bool next(int i, GUnit& u) const { const int L = i * G + c; if (L >= 1024) return false; const int pn = L >> 1, pm = L & 1;
        u.A = FkT + (size_t)pm * 256 * 256 * 2; u.B = UF + (size_t)pn * 64 * FW * 2; u.nt = 4; u.x0 = pm; u.x1 = pn; u.x2 = 0; u.x3 = 0; return true; }
    __device__ __forceinline__ unsigned b_off(int R, int C) const { const int g = R >> 6, cc = R & 63; return (unsigned)(cc * FW + g * 256 + C) * 2u; }
    __device__ __forceinline__ void a_off(const GUnit&, const int (&R)[2], const int (&C)[2], unsigned (&v)[2][2]) const {
#pragma unroll
        for (int h = 0; h < 2; ++h)
#pragma unroll
            for (int i = 0; i < 2; ++i) v[h][i] = (unsigned)((h * 128 + R[i]) * 256 + C[i]) * 2u; }
};
struct SchedF2 {
    static constexpr bool GATHER = false;
    int G, c; const char* FcT; const char* Z1T;
    __device__ __forceinline__ bool next(int i, GUnit& u) const { const int L = i * G + c; if (L >= 2048) return false; const int b = L >> 9, g = (L >> 7) & 3, kp = L & 127;
        u.A = FcT; u.B = Z1T + ((size_t)((b * 128) * 4 + g) * 256 + 2 * kp) * 128 * 2; u.nt = 2; u.x0 = b; u.x1 = g; u.x2 = 2 * kp; u.x3 = 0; return true; }
    __device__ __forceinline__ unsigned b_off(int R, int C) const { const int dk = R >> 7, r = R & 127; return (unsigned)(r * (4 * 256 * 128) + dk * 128 + C) * 2u; }
    __device__ __forceinline__ void a_off(const GUnit&, const int (&R)[2], const int (&C)[2], unsigned (&v)[2][2]) const {
#pragma unroll
        for (int h = 0; h < 2; ++h)
#pragma unroll
            for (int i = 0; i < 2; ++i) v[h][i] = (unsigned)((h * 128 + R[i]) * 128 + C[i]) * 2u; }
};
struct SchedF3 {
    static constexpr bool GATHER = false;
    int G, c; const char* FrT; const char* Z2T;
    __device__ __forceinline__ bool next(int i, GUnit& u) const { const int L = i * G + c; if (L >= 1024) return false; const int b = L >> 8, cp = (L >> 2) & 63, g = L & 3;
        u.A = FrT; u.B = Z2T + ((size_t)((b * 4 + g) * 256) * 64 + cp) * 256 * 2; u.nt = 4; u.x0 = b; u.x1 = cp; u.x2 = g; u.x3 = 0; return true; }
    __device__ __forceinline__ unsigned b_off(int R, int C) const { return (unsigned)(R * (64 * 256) + C) * 2u; }
    __device__ __forceinline__ void a_off(const GUnit&, const int (&R)[2], const int (&C)[2], unsigned (&v)[2][2]) const {
#pragma unroll
        for (int h = 0; h < 2; ++h)
#pragma unroll
            for (int i = 0; i < 2; ++i) v[h][i] = (unsigned)((h * 128 + R[i]) * 256 + C[i]) * 2u; }
};
template <int SHIFT, int PA, int PB, int NT> struct SchedMoe {
    static constexpr bool GATHER = true;
    int G, c; const char* Abase; const char* Bbase; const int* rowlist; const LAS int* pre; const LAS int* cnt;
    __device__ __forceinline__ bool next(int i, GUnit& u) const { const int L = i * G + c; const int ti = L >> 3, ct = L & 7; if (ti >= __builtin_amdgcn_readfirstlane(pre[NE])) return false;
        int e = 0;
#pragma unroll 1
        for (int s = 16; s >= 1; s >>= 1) if (pre[e + s] <= ti) e += s;
        e = __builtin_amdgcn_readfirstlane(e);
        u.A = Abase; u.B = Bbase + (size_t)(e * 2048 + ct * 256) * PB; u.nt = NT; u.x0 = e; u.x1 = ti - __builtin_amdgcn_readfirstlane(pre[e]); u.x2 = ct; u.x3 = __builtin_amdgcn_readfirstlane(cnt[e]); return true; }
    __device__ __forceinline__ unsigned b_off(int R, int C) const { return (unsigned)(R * PB + C * 2); }
    __device__ __forceinline__ void a_off(const GUnit& u, const int (&R)[2], const int (&C)[2], unsigned (&v)[2][2]) const {
        const int* rl = rowlist + (size_t)u.x0 * ECAP; const int base = u.x1 * 256, cm = u.x3 - 1;
#pragma unroll
        for (int h = 0; h < 2; ++h)
#pragma unroll
            for (int i = 0; i < 2; ++i) { int p = base + h * 128 + R[i]; p = p < cm ? p : cm; const unsigned ent = (unsigned)rl[p]; v[h][i] = (ent >> SHIFT) * (unsigned)PA + (unsigned)C[i] * 2u; } }
};

template <bool S8> struct EpiInProjT {
    static constexpr bool PERM = true, PERM16 = true;
    bf16* UF; bf16* A2; bf16* GZF; bf16* GZS;
    __device__ __forceinline__ void operator()(AccRef acc, const GUnit& u, int wr, int wc, int fr, int fq) const {
        const int pm = u.x0, pn = u.x1; const int col = pn * 256 + wc * 64 + 16 * fq;
#pragma unroll
        for (int ai = 0; ai < 2; ++ai)
#pragma unroll
            for (int m = 0; m < 4; ++m) { const int row = pm * 256 + ai * 128 + wr * 64 + m * 16 + fr; bf16* dst;
                if (pn < 4) dst = UF + (size_t)row * FW + col;
                else { const int g = (col - FW) >> 4, b = row >> 13, t = row & (SEQ - 1); dst = A2 + ((size_t)((g * 4 + b) * NCH + NCTXCH + (t >> 5)) * A2LD + (t & 31) * 16); }
                constexpr float SC = S8 ? W8_INV : 1.0f; st16_bf16(dst, acc[ai][0][m][0] * SC, acc[ai][0][m][1] * SC, acc[ai][1][m][0] * SC, acc[ai][1][m][1] * SC); }
    }
};
typedef EpiInProjT<false> EpiInProj;
struct EpiGates8 {
    static constexpr bool PERM = true, PERM16 = true;
    unsigned char* GZF; unsigned char* GZS;
    __device__ __forceinline__ void operator()(AccRef acc, const GUnit& u, int wr, int wc, int fr, int fq) const {
        const int pm = u.x0, pn = u.x1; unsigned char* base = (pn < 8 ? GZF : GZS) + (size_t)(pm * 256 + wr * 64 + fr) * D + (pn & 7) * 256 + wc * 64 + 16 * fq;
#pragma unroll
        for (int ai = 0; ai < 2; ++ai)
#pragma unroll
            for (int m = 0; m < 4; ++m) { u32x4 w;
#pragma unroll
                for (int bj = 0; bj < 2; ++bj)
#pragma unroll
                    for (int n = 0; n < 2; ++n) { const f32x4 v = acc[ai][bj][m][n]; w[bj * 2 + n] = pk4_u8(fsigmoid(v[0] * W8_INV), fsigmoid(v[1] * W8_INV), fsigmoid(v[2] * W8_INV), fsigmoid(v[3] * W8_INV)); }
                *(u32x4*)(base + (size_t)(ai * 128 + m * 16) * D) = w; }
    }
};
struct EpiE {
    static constexpr bool PERM = false;
    float* E;
    __device__ __forceinline__ void operator()(AccRef acc, const GUnit& u, int wr, int wc, int fr, int fq) const {
        float* base = E + (size_t)((u.x0 * 4 + u.x1) * NCH + NCTXCH) * 256;
#pragma unroll
        for (int ai = 0; ai < 2; ++ai)
#pragma unroll
            for (int m = 0; m < 4; ++m) { float* rowp = base + (size_t)(ai * 128 + wr * 64 + m * 16 + fr) * 256 + wc * 32 + 4 * fq;
#pragma unroll
                for (int bj = 0; bj < 2; ++bj)
#pragma unroll
                    for (int n = 0; n < 2; ++n) *(f32x4*)(rowp + bj * 128 + n * 16) = acc[ai][bj][m][n]; }
    }
};
struct EpiSSM {
    static constexpr bool PERM = true, PERM16 = true;
    bf16* YS;
    __device__ __forceinline__ void operator()(AccRef acc, const GUnit& u, int wr, int wc, int fr, int fq) const {
        const int g = u.x0, b = u.x1, pn = u.x2; const int tt = (pn * 256 + wc * 64 + 16 * fq) >> 4;
#pragma unroll
        for (int ai = 0; ai < 2; ++ai)
#pragma unroll
            for (int m = 0; m < 4; ++m) { const int ch = ai * 128 + wr * 64 + m * 16 + fr; const size_t tok = (size_t)b * SEQ + ch * LC + tt;
                f32x4 v0 = acc[ai][0][m][0], v1 = acc[ai][0][m][1], v2 = acc[ai][1][m][0], v3 = acc[ai][1][m][1];
#pragma unroll
                for (int j = 0; j < 4; ++j) { v0[j] = gelu_tanh(v0[j]); v1[j] = gelu_tanh(v1[j]); v2[j] = gelu_tanh(v2[j]); v3[j] = gelu_tanh(v3[j]); }
                st16_bf16(YS + tok * SW + g * 16, v0, v1, v2, v3); }
    }
};
constexpr float S8_SCALE = 16.0f, S8_INV = 1.0f / 16.0f;
template <int MODE> struct EpiGate {
    static constexpr bool PERM = true, PERM16 = true; static constexpr float ASC = MODE == 0 ? W8_INV / 255.0f : (MODE == 1 ? W8_INV * S8_INV / 255.0f : 1.0f);
    bf16* O; const void* G0; const float* bias; int ld; unsigned char* O8; int ldo;
    __device__ __forceinline__ void operator()(AccRef acc, const GUnit& u, int wr, int wc, int fr, int fq) const {
        const int pm = u.x0, pn = u.x1;
        const size_t off0 = (size_t)(pm * 256 + wr * 64 + fr) * ld + pn * 256 + wc * 64 + 16 * fq;
        f32x4 bv[2][2];
        if (MODE == 2) {
#pragma unroll
            for (int q = 0; q < 4; ++q) bv[q >> 1][q & 1] = *(const f32x4*)(bias + pn * 256 + wc * 64 + 16 * fq + 4 * q); }
#pragma unroll
        for (int ai = 0; ai < 2; ++ai) {
            u32x4 gq[4], yq[4][2], oq[4][2];
#pragma unroll
            for (int m = 0; m < 4; ++m) { const size_t off = off0 + (size_t)(ai * 128 + m * 16) * ld;
                if (MODE == 2) { yq[m][0] = *(const u32x4*)((const bf16*)G0 + off); yq[m][1] = *(const u32x4*)((const bf16*)G0 + off + 8); }
                else gq[m] = __builtin_nontemporal_load((const u32x4*)((const unsigned char*)G0 + off));
                if (MODE == 1) { oq[m][0] = *(const u32x4*)(O + off); oq[m][1] = *(const u32x4*)(O + off + 8); } }
#pragma unroll
            for (int m = 0; m < 4; ++m) { const size_t off = off0 + (size_t)(ai * 128 + m * 16) * ld;
                f32x4 v[2][2];
#pragma unroll
                for (int bj = 0; bj < 2; ++bj)
#pragma unroll
                    for (int n = 0; n < 2; ++n) { const int q = bj * 2 + n; const f32x4 a = acc[ai][bj][m][n];
                        if (MODE == 2) { const unsigned lo = yq[m][bj][2 * n], hi = yq[m][bj][2 * n + 1]; const f32x4 y = (f32x4){bf_lo(lo), bf_hi(lo), bf_lo(hi), bf_hi(hi)};
#pragma unroll
                            for (int j = 0; j < 4; ++j) v[bj][n][j] = y[j] * fsigmoid(a[j] + bv[bj][n][j]) * S8_SCALE; }
                        else { const f32x4 g = u8x4_f32(gq[m][q]);
                            if (MODE == 0) v[bj][n] = a * g * ASC;
                            else { const unsigned lo = oq[m][bj][2 * n], hi = oq[m][bj][2 * n + 1]; v[bj][n] = (f32x4){bf_lo(lo), bf_hi(lo), bf_lo(hi), bf_hi(hi)} + a * g * ASC; } } }
                if (MODE == 0) {
#pragma unroll
                    for (int bj = 0; bj < 2; ++bj) { u32x4 w; w.x = pk_bf16(v[bj][0][0], v[bj][0][1]); w.y = pk_bf16(v[bj][0][2], v[bj][0][3]); w.z = pk_bf16(v[bj][1][0], v[bj][1][1]); w.w = pk_bf16(v[bj][1][2], v[bj][1][3]); *(u32x4*)(O + off + 8 * bj) = w; } }
                else { u32x4 w;
#pragma unroll
                    for (int q = 0; q < 4; ++q) w[q] = pk4_fp8(v[q >> 1][q & 1][0], v[q >> 1][q & 1][1], v[q >> 1][q & 1][2], v[q >> 1][q & 1][3]);
                    const size_t offo = MODE == 2 ? (size_t)(pm * 256 + wr * 64 + fr + ai * 128 + m * 16) * ldo + pn * 256 + wc * 64 + 16 * fq : off;
                    *(u32x4*)(O8 + offo) = w; } }
            asm volatile("" ::: "memory");
        }
    }
};
struct EpiMerge {
    static constexpr bool PERM = true, PERM16 = true, SEG2 = true;
    unsigned char* M8; const unsigned char* GZF; const unsigned char* GZS;
    __device__ __forceinline__ void operator()(f32x4 (&acc)[2][2][4][2], const GUnit& u, int wr, int wc, int fr, int fq) const {
        const size_t off0 = (size_t)(u.x0 * 256 + wr * 64 + fr) * D + u.x1 * 256 + wc * 64 + 16 * fq;
        if (u.x2 == 0) {
#pragma unroll
            for (int ai = 0; ai < 2; ++ai) {
                u32x4 qs[4], qf[4];
#pragma unroll
                for (int m = 0; m < 4; ++m) { const size_t off = off0 + (size_t)(ai * 128 + m * 16) * D; qs[m] = __builtin_nontemporal_load((const u32x4*)(GZS + off)); qf[m] = *(const u32x4*)(GZF + off); }
#pragma unroll
                for (int m = 0; m < 4; ++m)
#pragma unroll
                    for (int q = 0; q < 4; ++q) { const f32x4 s = u8x4_f32(qs[m][q]), f = u8x4_f32(qf[m][q]); f32x4 r;
#pragma unroll
                        for (int j = 0; j < 4; ++j) r[j] = s[j] * S8_INV * __builtin_amdgcn_rcpf(fmaxf(f[j], 0.5f));
                        acc[ai][q >> 1][m][q & 1] *= r; }
                asm volatile("" ::: "memory");
            }
            return;
        }
#pragma unroll
        for (int ai = 0; ai < 2; ++ai) {
            u32x4 qf[4];
#pragma unroll
            for (int m = 0; m < 4; ++m) qf[m] = __builtin_nontemporal_load((const u32x4*)(GZF + off0 + (size_t)(ai * 128 + m * 16) * D));
#pragma unroll
            for (int m = 0; m < 4; ++m) { u32x4 w;
#pragma unroll
                for (int q = 0; q < 4; ++q) { const f32x4 f = u8x4_f32(qf[m][q]); const f32x4 a = acc[ai][q >> 1][m][q & 1]; f32x4 v;
#pragma unroll
                    for (int j = 0; j < 4; ++j) v[j] = a[j] * (fmaxf(f[j], 0.5f) * (W8_INV / 255.0f));
                    w[q] = pk4_fp8(v[0], v[1], v[2], v[3]); }
                *(u32x4*)(M8 + off0 + (size_t)(ai * 128 + m * 16) * D) = w; }
            asm volatile("" ::: "memory");
        }
    }
};
struct EpiOut {
    static constexpr bool PERM = true, PERM16 = true;
    const float* modv; bf16* MG;
    __device__ __forceinline__ void operator()(AccRef acc, const GUnit& u, int wr, int wc, int fr, int fq) const {
        const int pm = u.x0, pn = u.x1; const float* gate = modv + (size_t)(pm >> 5) * 12288 + 2 * D;
        const int col0 = pn * 256 + wc * 64 + 16 * fq;
        const f32x4 gv0 = *(const f32x4*)(gate + col0) * W8_INV, gv1 = *(const f32x4*)(gate + col0 + 4) * W8_INV, gv2 = *(const f32x4*)(gate + col0 + 8) * W8_INV, gv3 = *(const f32x4*)(gate + col0 + 12) * W8_INV;
#pragma unroll
        for (int ai = 0; ai < 2; ++ai)
#pragma unroll
            for (int m = 0; m < 4; ++m) { bf16* rowp = MG + (size_t)(pm * 256 + ai * 128 + wr * 64 + m * 16 + fr) * D + col0;
                st16_bf16(rowp, acc[ai][0][m][0] * gv0, acc[ai][0][m][1] * gv1, acc[ai][1][m][0] * gv2, acc[ai][1][m][1] * gv3); }
    }
};
struct EpiF1 {
    static constexpr bool PERM = true, PERM16 = true;
    bf16* Z1T;
    __device__ __forceinline__ void operator()(AccRef acc, const GUnit& u, int wr, int wc, int fr, int fq) const {
        const int reim = u.x0, br = u.x1;
#pragma unroll
        for (int ai = 0; ai < 2; ++ai)
#pragma unroll
            for (int m = 0; m < 4; ++m) { const int kp = ai * 128 + wr * 64 + m * 16 + fr;
                st16_bf16(Z1T + ((((size_t)br * 4 + wc) * 256 + kp) * 2 + reim) * 64 + 16 * fq, acc[ai][0][m][0], acc[ai][0][m][1], acc[ai][1][m][0], acc[ai][1][m][1]); }
    }
};
struct EpiF2 {
    static constexpr bool PERM = true, PERM16 = true;
    bf16* Z2T;
    __device__ __forceinline__ void operator()(AccRef acc, const GUnit& u, int wr, int wc, int fr, int fq) const {
        const int b = u.x0, g = u.x1, k0 = u.x2; const int kp = k0 + (wc >> 1), r0 = (wc & 1) * 64 + 16 * fq;
#pragma unroll
        for (int m = 0; m < 4; ++m) { const int mm = wr * 64 + m * 16 + fr, reim = mm >> 6, cp = mm & 63;
            st16_bf16(Z2T + (((((size_t)b * 4 + g) * 256 + kp) * 64 + cp) * 2 + reim) * 128 + r0, acc[0][0][m][0], acc[0][0][m][1], acc[0][1][m][0], acc[0][1][m][1]); }
    }
};
struct EpiF3 {
    static constexpr bool PERM = true, PERM16 = true;
    unsigned char* FO;
    __device__ __forceinline__ void operator()(AccRef acc, const GUnit& u, int wr, int wc, int fr, int fq) const {
        const int b = u.x0, cp = u.x1, g = u.x2;
#pragma unroll
        for (int m = 0; m < 4; ++m) { const int rr = wr * 64 + m * 16 + fr; const size_t tok = (size_t)b * SEQ + rr * 64 + cp; u32x4 w;
#pragma unroll
            for (int q = 0; q < 4; ++q) { const f32x4 v = acc[0][q >> 1][m][q & 1]; w[q] = pk4_fp8(v[0], v[1], v[2], v[3]); }
            *(u32x4*)(FO + tok * (SW + FW) + SW + g * 256 + wc * 64 + 16 * fq) = w; }
    }
};
struct EpiMoe1 {
    static constexpr bool PERM = true;
    unsigned char* HID; const int* rowlist;
    __device__ __forceinline__ void operator()(AccRef acc, const GUnit& u, int wr, int wc, int fr, int fq) const {
        const int e = u.x0, rt = u.x1, ct = u.x2, cnt = u.x3; const int* rl = rowlist + (size_t)e * ECAP; const int p0 = rt * 256 + wr * 64 + fr;
        const int odd = fq & 1;
        unsigned ent[2][2];
#pragma unroll
        for (int ai = 0; ai < 2; ++ai)
#pragma unroll
            for (int h = 0; h < 2; ++h) { int p = p0 + ai * 128 + (2 * h + odd) * 16; p = p < cnt ? p : cnt - 1; ent[ai][h] = (unsigned)rl[p]; }
#pragma unroll
        for (int ai = 0; ai < 2; ++ai)
#pragma unroll
            for (int mp = 0; mp < 4; mp += 2) {
                f32x4 v0, v1, w0, w1;
#pragma unroll
                for (int j = 0; j < 4; ++j) { const float a0 = acc[ai][0][mp][0][j] * W8_INV, a1 = acc[ai][0][mp][1][j] * W8_INV; v0[j] = a0 * fsigmoid(a0) * (acc[ai][1][mp][0][j] * W8_INV); v1[j] = a1 * fsigmoid(a1) * (acc[ai][1][mp][1][j] * W8_INV); }
#pragma unroll
                for (int j = 0; j < 4; ++j) { const float a0 = acc[ai][0][mp + 1][0][j] * W8_INV, a1 = acc[ai][0][mp + 1][1][j] * W8_INV; w0[j] = a0 * fsigmoid(a0) * (acc[ai][1][mp + 1][0][j] * W8_INV); w1[j] = a1 * fsigmoid(a1) * (acc[ai][1][mp + 1][1][j] * W8_INV); }
                const unsigned lo0 = pk4_fp8(v0[0], v0[1], v0[2], v0[3]), hi0 = pk4_fp8(v1[0], v1[1], v1[2], v1[3]), lo1 = pk4_fp8(w0[0], w0[1], w0[2], w0[3]), hi1 = pk4_fp8(w1[0], w1[1], w1[2], w1[3]);
                const auto sl = __builtin_amdgcn_permlane16_swap(lo0, lo1, false, false), sh = __builtin_amdgcn_permlane16_swap(hi0, hi1, false, false);
                const int p = p0 + ai * 128 + (mp + odd) * 16; const unsigned en = ent[ai][mp >> 1];
                if (p < cnt) *(u32x4*)(HID + (size_t)en * DE + ct * 128 + wc * 32 + 16 * (fq >> 1)) = (u32x4){sl[0], sh[0], sl[1], sh[1]}; }
    }
};
constexpr float Y8_SCALE = 16.0f, Y8_INV = 1.0f / 16.0f;
struct EpiMoe2 {
    static constexpr bool PERM = true, PERM16 = true;
    unsigned char* Y; const int* rowlist;
    __device__ __forceinline__ void operator()(AccRef acc, const GUnit& u, int wr, int wc, int fr, int fq) const {
        const int e = u.x0, rt = u.x1, ct = u.x2, cnt = u.x3; const int* rl = rowlist + (size_t)e * ECAP; const int p0 = rt * 256 + wr * 64 + fr;
        unsigned ent[2][4];
#pragma unroll
        for (int ai = 0; ai < 2; ++ai)
#pragma unroll
            for (int m = 0; m < 4; ++m) { int p = p0 + ai * 128 + m * 16; p = p < cnt ? p : cnt - 1; ent[ai][m] = (unsigned)rl[p]; }
#pragma unroll
        for (int ai = 0; ai < 2; ++ai)
#pragma unroll
            for (int m = 0; m < 4; ++m) { const int p = p0 + ai * 128 + m * 16;
                if (p < cnt) { u32x4 w;
#pragma unroll
                    for (int q = 0; q < 4; ++q) { const f32x4 v = acc[ai][q >> 1][m][q & 1] * (W8_INV * Y8_SCALE); w[q] = pk4_fp8(v[0], v[1], v[2], v[3]); }
                    *(u32x4*)(Y + (size_t)ent[ai][m] * D + ct * 256 + wc * 64 + 16 * fq) = w; } }
    }
};

enum { IX = 0, IC, ICTX, ICCTX, IWADA, IBADA, IWIN, IWF, ILAMRE, ILAMIM, ILOGDT, IBRE, IBIM, ICRE, ICIM, IDSKIP, IWGLU, IBGLU, IWS, IWOUT, ILN1G, ILN1B, IWGRP, IBGRP, IWEXP, IBEXP, IW1, IW3, IW2, ILN2G, ILN2B, NIN };
struct Args { const float* in[NIN]; float* out; unsigned char* ws; int ph_lo, ph_hi; };
constexpr int ARGS_OFF = MISC_OFF + 1024;
__device__ __forceinline__ unsigned long long ldp(LAS unsigned char* lds, int i) {
    const volatile LAS unsigned* p = (const volatile LAS unsigned*)(lds + ARGS_OFF) + 2 * i;
    const unsigned lo = __builtin_amdgcn_readfirstlane(p[0]), hi = __builtin_amdgcn_readfirstlane(p[1]);
    return ((unsigned long long)hi << 32) | lo;
}
#define AIN(i) ((const float*)ldp(lds, (i)))
#define AOUT ((float*)ldp(lds, NIN))
#define AWS ((unsigned char*)ldp(lds, NIN + 1))

template <int MAP>
__device__ __forceinline__ void transpose_item(const float* W, int K, int N, bf16* WT, LAS float* scr, int item, int lane) {
    const int nblk = N / 64, kb = item / nblk, nb = item % nblk, k0 = 64 * kb, n0 = 64 * nb;
    const int kr = lane >> 4, nc = (lane & 15) * 4;
    const float* src = W + (size_t)(k0 + kr) * N + n0 + nc;
    f32x4 v[16];
#pragma unroll
    for (int i = 0; i < 16; ++i) v[i] = __builtin_nontemporal_load((const f32x4*)(src + (size_t)(4 * i) * N));
#pragma unroll
    for (int i = 0; i < 16; ++i) { LAS float* d = scr + (4 * i + kr) * 65 + nc; d[0] = v[i].x; d[1] = v[i].y; d[2] = v[i].z; d[3] = v[i].w; }
    LDS_WAIT(); asm volatile("" ::: "memory");
    const int c = lane & 7;
#pragma unroll
    for (int j = 0; j < 8; ++j) { const int n = (lane >> 3) + 8 * j; const LAS float* s = scr + (8 * c) * 65 + n;
        u32x4 o; o.x = pk_bf16(s[0 * 65], s[1 * 65]); o.y = pk_bf16(s[2 * 65], s[3 * 65]); o.z = pk_bf16(s[4 * 65], s[5 * 65]); o.w = pk_bf16(s[6 * 65], s[7 * 65]);
        const int nn = n0 + n; const int row = MAP == 0 ? nn : ((nn >> 7) * 256 + (nn & 127) + (MAP == 2 ? 128 : 0));
        __builtin_nontemporal_store(o, (u32x4*)(WT + (size_t)row * K + k0 + 8 * c)); }
    LDS_WAIT(); asm volatile("" ::: "memory");
}
template <int MAP>
__device__ __forceinline__ void transpose_item_f8(const float* W, int K, int N, unsigned char* WT, LAS float* scr, int item, int lane, int pitch = 0) {
    const int nblk = N / 64, kb = item / nblk, nb = item % nblk, k0 = 64 * kb, n0 = 64 * nb;
    const int kr = lane >> 4, nc = (lane & 15) * 4;
    const float* src = W + (size_t)(k0 + kr) * N + n0 + nc;
    f32x4 v[16];
#pragma unroll
    for (int i = 0; i < 16; ++i) v[i] = __builtin_nontemporal_load((const f32x4*)(src + (size_t)(4 * i) * N));
#pragma unroll
    for (int i = 0; i < 16; ++i) { LAS float* d = scr + (4 * i + kr) * 65 + nc; d[0] = v[i].x * W8_SCALE; d[1] = v[i].y * W8_SCALE; d[2] = v[i].z * W8_SCALE; d[3] = v[i].w * W8_SCALE; }
    LDS_WAIT(); asm volatile("" ::: "memory");
    const int c = lane & 3;
#pragma unroll
    for (int j = 0; j < 4; ++j) { const int n = (lane >> 2) + 16 * j; const LAS float* s = scr + (16 * c) * 65 + n;
        u32x4 o; o.x = pk4_fp8(s[0 * 65], s[1 * 65], s[2 * 65], s[3 * 65]); o.y = pk4_fp8(s[4 * 65], s[5 * 65], s[6 * 65], s[7 * 65]);
        o.z = pk4_fp8(s[8 * 65], s[9 * 65], s[10 * 65], s[11 * 65]); o.w = pk4_fp8(s[12 * 65], s[13 * 65], s[14 * 65], s[15 * 65]);
        const int nn = n0 + n; const int row = MAP == 0 ? nn : ((nn >> 7) * 256 + (nn & 127) + (MAP == 2 ? 128 : 0));
        __builtin_nontemporal_store(o, (u32x4*)(WT + (pitch < 0 ? tiled_off((size_t)row, k0 + 16 * c, K >> 7) : (size_t)row * (pitch ? pitch : K) + k0 + 16 * c))); }
    LDS_WAIT(); asm volatile("" ::: "memory");
}
__device__ __forceinline__ void ph0(LAS unsigned char* lds, int tid, int lane, int wave, int G, int bid) {
    unsigned char* ws = AWS;
    {
        LAS float* sv = (LAS float*)(lds + 81920);
        LAS f32x4* comb = (LAS f32x4*)(lds + 81920 + 4096);
        float* modpart = (float*)(ws + WS_MODPART);
        for (int task = bid; task < 256; task += G) {
            const int cb = task & 15, kr = task >> 4;
            __syncthreads();
            for (int i = tid; i < 5 * 128; i += 512) { const int r = i >> 7, k = kr * 128 + (i & 127); const float v = (r < 4) ? AIN(IC)[r * D + k] : AIN(ICCTX)[k]; sv[i] = v / (1.0f + expf(-v)); }
            __syncthreads();
            f32x4 acc[5];
#pragma unroll
            for (int r = 0; r < 5; ++r) acc[r] = (f32x4){0.f, 0.f, 0.f, 0.f};
            const int c4 = tid % 192, ks = tid / 192;
            if (tid < 384) {
                const float* wp = AIN(IWADA) + (size_t)(kr * 128 + ks * 64) * 12288 + cb * 768 + c4 * 4;
#pragma unroll 8
                for (int k = 0; k < 64; ++k) { const f32x4 w = __builtin_nontemporal_load((const f32x4*)(wp + (size_t)k * 12288));
#pragma unroll
                    for (int r = 0; r < 5; ++r) acc[r] += w * sv[r * 128 + ks * 64 + k]; }
                if (ks == 1) {
#pragma unroll
                    for (int r = 0; r < 5; ++r) comb[r * 192 + c4] = acc[r]; }
            }
            __syncthreads();
            if (tid < 192) {
#pragma unroll
                for (int r = 0; r < 5; ++r) { const f32x4 t = acc[r] + comb[r * 192 + tid]; *(f32x4*)(modpart + (size_t)(kr * 5 + r) * 12288 + cb * 768 + tid * 4) = t; } }
        }
        __syncthreads();
    }
    const int gt = bid * 512 + tid, NGT = G * 512;
    {
        f32x2* PW = (f32x2*)(ws + WS_PW); f32x2* BBAR = (f32x2*)(ws + WS_BBAR); f32x2* LAML = (f32x2*)(ws + WS_LAML); f32x2* LAMSEG = (f32x2*)(ws + WS_LAMSEG);
        const double TWO_PI = 6.283185307179586476925287;
        for (int idx = gt; idx < SG * 2 * SP * 34; idx += NGT) {
            const int i = idx / 34, j = idx - i * 34; const int g = i >> 7, dir = (i >> 6) & 1, p = i & 63; const int si = (dir * SG + g) * SP + p;
            const double lr = (double)AIN(ILAMRE)[si], li = (double)AIN(ILAMIM)[si], dt = exp((double)AIN(ILOGDT)[dir * SG + g]);
            const int jj = (j == 33) ? LC * 33 : j;
            const double mag = exp((double)jj * lr * dt); double ang = (double)jj * li * dt; ang -= TWO_PI * rint(ang / TWO_PI);
            const float fa = (float)ang; const double cr = mag * (double)cosf(fa), ci = mag * (double)sinf(fa);
            const f32x2 o = (f32x2){(float)cr, (float)ci};
            if (j <= 32) PW[(size_t)i * 33 + j] = o;
            if (j == 32) LAML[i] = o;
            if (j == 33) LAMSEG[i] = o;
        }
        for (int idx = gt; idx < SG * 2 * SP * SH; idx += NGT) {
            const int i = idx >> 4, h = idx & 15; const int g = i >> 7, dir = (i >> 6) & 1, p = i & 63; const int si = (dir * SG + g) * SP + p;
            const double lr = (double)AIN(ILAMRE)[si], li = (double)AIN(ILAMIM)[si], dt = exp((double)AIN(ILOGDT)[dir * SG + g]);
            const double mag = exp(lr * dt); double ang = li * dt; ang -= TWO_PI * rint(ang / TWO_PI);
            const float fa = (float)ang; const double l1r = mag * (double)cosf(fa), l1i = mag * (double)sinf(fa);
            const double nr = l1r - 1.0, ni = l1i, den = lr * lr + li * li; const double qr = (nr * lr + ni * li) / den, qi = (ni * lr - nr * li) / den;
            const double br = (double)AIN(IBRE)[(size_t)si * SH + h], bi = (double)AIN(IBIM)[(size_t)si * SH + h];
            BBAR[(size_t)i * SH + h] = (f32x2){(float)(qr * br - qi * bi), (float)(qr * bi + qi * br)};
        }
    }
    {
        bf16* FKT = (bf16*)(ws + WS_FKT); bf16* FCT = (bf16*)(ws + WS_FCT); bf16* FRT = (bf16*)(ws + WS_FRT); bf16* WHI = (bf16*)(ws + WS_WRTHI); bf16* WLO = (bf16*)(ws + WS_WRTLO);
        const float TWO_PI_F = 6.2831853071795864f;
        for (int i = gt; i < 512 * 256; i += NGT) { const int m = i >> 8, k = i & 255, kp = m & 255, reim = m >> 8; const float ang = TWO_PI_F * (float)((k * kp) & 255) * (1.0f / 256.0f);
            FKT[i] = f2bf((reim ? -sinf(ang) : cosf(ang)) * 0.0625f); }
        for (int i = gt; i < 256 * 128; i += NGT) { const int m = i >> 7, kk = i & 127; float v = 0.f;
            if (m < 128) { const int ro = m >> 6, cp = m & 63, ri = kk >> 6, c = kk & 63; const float ang = TWO_PI_F * (float)((c * cp) & 63) * (1.0f / 64.0f); const float co = cosf(ang), sn = sinf(ang);
                v = (ro == 0 ? (ri == 0 ? co : sn) : (ri == 0 ? -sn : co)) * 0.125f; }
            FCT[i] = f2bf(v); }
        for (int i = gt; i < 256 * 256; i += NGT) { const int m = i >> 8, kk = i & 255; float v = 0.f;
            if (m < 128) { const int ri = kk >> 7, r = kk & 127; const float ang = TWO_PI_F * (float)((r * m) & 127) * (1.0f / 128.0f); v = (ri ? sinf(ang) : cosf(ang)) * 0.08838834764831845f; }
            FRT[i] = f2bf(v); }
        for (int i = gt; i < 48 * D; i += NGT) { const int n = i >> 11, k = i & (D - 1); float w = 0.f;
            if (n < 4) w = AIN(IWGRP)[k * 4 + n]; else if (n < 36) w = AIN(IWEXP)[k * 32 + (n - 4)];
            const bf16 h = f2bf(w); WHI[i] = h; WLO[i] = f2bf(w - bf2f(h)); }
    }
    {
        LAS float* scr = (LAS float*)(lds + wave * 16640);
        const int gw = bid * NWAVES + wave, NGW = G * NWAVES;
        constexpr int I_IN = 32 * 88, I_IN2 = 32 * 8, I_F = 16 * 32, I_S = 8 * 32, I_O = 32 * 32, I_G = 8 * 8, I_E = 512;
        constexpr int NITEMS = I_IN + I_IN2 + I_F + I_S + I_O + I_G + 3 * NE * I_E;
        for (int it = gw; it < NITEMS; it += NGW) {
            int r = it;
            if (r < I_IN) { transpose_item_f8<0>(AIN(IWIN), D, INW, (unsigned char*)(ws + WS_WG8), scr, r, lane, -1); continue; } r -= I_IN;
            if (r < I_IN2) { transpose_item<0>(AIN(IWIN), D, INW, (bf16*)(ws + WS_WINT), scr, (r >> 3) * 88 + 16 + (r & 7), lane); continue; } r -= I_IN2;
            if (r < I_F) { transpose_item_f8<0>(AIN(IWF), FW, D, (unsigned char*)(ws + WS_WFT) + SW, scr, r, lane, SW + FW); continue; } r -= I_F;
            if (r < I_S) { transpose_item_f8<0>(AIN(IWS), SW, D, (unsigned char*)(ws + WS_WFT), scr, r, lane, SW + FW); continue; } r -= I_S;
            if (r < I_O) { transpose_item_f8<0>(AIN(IWOUT), D, D, (unsigned char*)(ws + WS_WOT), scr, r, lane); continue; } r -= I_O;
            if (r < I_G) { transpose_item<0>(AIN(IWGLU), SW, SW, (bf16*)(ws + WS_WGLUT), scr, r, lane); continue; } r -= I_G;
            if (r < NE * I_E) { const int e = r >> 9; transpose_item_f8<1>(AIN(IW1) + (size_t)e * D * DE, D, DE, (unsigned char*)(ws + WS_W13T) + (size_t)e * 2048 * D, scr, r & 511, lane); continue; } r -= NE * I_E;
            if (r < NE * I_E) { const int e = r >> 9; transpose_item_f8<2>(AIN(IW3) + (size_t)e * D * DE, D, DE, (unsigned char*)(ws + WS_W13T) + (size_t)e * 2048 * D, scr, r & 511, lane); continue; } r -= NE * I_E;
            { const int e = r >> 9; transpose_item_f8<0>(AIN(IW2) + (size_t)e * DE * D, DE, D, (unsigned char*)(ws + WS_W2T) + (size_t)e * D * DE, scr, r & 511, lane); }
        }
    }
}

__device__ __forceinline__ void ph1(LAS unsigned char* lds, int tid, int G, int bid) {
    unsigned char* ws = AWS; const int gt = bid * 512 + tid, NGT = G * 512;
    const f32x2* PW = (const f32x2*)(ws + WS_PW); const f32x2* BBAR = (const f32x2*)(ws + WS_BBAR);
    { const float* modpart = (const float*)(ws + WS_MODPART); float* modv = (float*)(ws + WS_MODV);
      for (int i = gt; i < 5 * 12288; i += NGT) { float s = AIN(IBADA)[i % 12288];
#pragma unroll
          for (int kr = 0; kr < 16; ++kr) s += modpart[(size_t)kr * 5 * 12288 + i];
          modv[i] = s; } }
    { float* KLAG = (float*)(ws + WS_KLAG);
      for (int i = gt; i < SG * 2 * LC * 64; i += NGT) { const int hq = i & 3, ho = (i >> 2) & 15, k = (i >> 6) & 31, gd = i >> 11, g = gd >> 1, dir = gd & 1;
          const float* cre = AIN(ICRE) + ((size_t)(dir * SG + g) * SH + ho) * SP; const float* cim = AIN(ICIM) + ((size_t)(dir * SG + g) * SH + ho) * SP;
          f32x4 s = (f32x4){0.f, 0.f, 0.f, 0.f};
#pragma unroll 4
          for (int p = 0; p < SP; ++p) { const f32x2 pw = PW[((size_t)gd * SP + p) * 33 + k]; const f32x4* bq = (const f32x4*)(BBAR + ((size_t)gd * SP + p) * SH + 4 * hq); const f32x4 b01 = bq[0], b23 = bq[1]; const float cr = cre[p], ci = cim[p];
              const float tr = cr * pw.x - ci * pw.y, ti = cr * pw.y + ci * pw.x;
              s.x += tr * b01.x - ti * b01.y; s.y += tr * b01.z - ti * b01.w; s.z += tr * b23.x - ti * b23.y; s.w += tr * b23.z - ti * b23.w; }
          *(f32x4*)(KLAG + (((size_t)gd * LC + k) << 8) + ho * 16 + 4 * hq) = s; } }
    { bf16* WET = (bf16*)(ws + WS_WET);
      for (int i = gt; i < SG * 256 * LC; i += NGT) { const int jj = i & 31, n = (i >> 5) & 255, g = i >> 13; const int dir = n >> 7, reim = (n >> 6) & 1, p = n & 63;
          const int gd = g * 2 + dir; const f32x2 pw = PW[((size_t)gd * SP + p) * 33 + (dir == 0 ? (LC - 1 - jj) : jj)]; const f32x4* bb = (const f32x4*)(BBAR + ((size_t)gd * SP + p) * SH);
          unsigned o[8];
#pragma unroll
          for (int q = 0; q < 8; ++q) { const f32x4 b2 = bb[q];
              const float v0 = reim ? (pw.x * b2.y + pw.y * b2.x) : (pw.x * b2.x - pw.y * b2.y), v1 = reim ? (pw.x * b2.w + pw.y * b2.z) : (pw.x * b2.z - pw.y * b2.w); o[q] = pk_bf16(v0, v1); }
          u32x4* dst = (u32x4*)(WET + ((size_t)g * 256 + n) * 512 + jj * 16); dst[0] = (u32x4){o[0], o[1], o[2], o[3]}; dst[1] = (u32x4){o[4], o[5], o[6], o[7]}; } }
    { bf16* TV = (bf16*)(ws + WS_TV);
      for (int i = gt; i < SG * 512 * 32; i += NGT) { const int p8 = i & 7, reim = (i >> 3) & 1, dir = (i >> 4) & 1, n = (i >> 5) & 511, g = i >> 14; const int tt = n >> 4, ho = n & 15;
          const int gd = g * 2 + dir, pj = dir == 0 ? (tt + 1) : (LC - tt); const size_t ci = ((size_t)(dir * SG + g) * SH + ho) * SP + p8 * 8;
          const f32x4 cr0 = *(const f32x4*)(AIN(ICRE) + ci), cr1 = *(const f32x4*)(AIN(ICRE) + ci + 4), ci0 = *(const f32x4*)(AIN(ICIM) + ci), ci1 = *(const f32x4*)(AIN(ICIM) + ci + 4);
          float v[8];
#pragma unroll
          for (int q = 0; q < 8; ++q) { const f32x2 pw = PW[((size_t)gd * SP + p8 * 8 + q) * 33 + pj]; const float cr = q < 4 ? cr0[q & 3] : cr1[q & 3], cim = q < 4 ? ci0[q & 3] : ci1[q & 3];
              v[q] = reim ? -(cr * pw.y + cim * pw.x) : (cr * pw.x - cim * pw.y); }
          *(u32x4*)(TV + ((size_t)g * 512 + n) * A2LD + 512 + dir * 128 + reim * 64 + p8 * 8) = (u32x4){pk_bf16(v[0], v[1]), pk_bf16(v[2], v[3]), pk_bf16(v[4], v[5]), pk_bf16(v[6], v[7])}; } }
}

__device__ __forceinline__ void ph2(LAS unsigned char* lds, int tid, int lane, int wave, int G, int bid) {
    unsigned char* ws = AWS; const float* modv = (const float*)(ws + WS_MODV);
    { const int gt = bid * 512 + tid, NGT = G * 512; bf16* TV = (bf16*)(ws + WS_TV); const float* KLAG = (const float*)(ws + WS_KLAG); const float* dsk = AIN(IDSKIP);
      for (int i = gt; i < SG * 512 * LC; i += NGT) { const int jj = i & 31, n = (i >> 5) & 511, g = i >> 14; const int tt = n >> 4, ho = n & 15;
          const int dir = jj > tt ? 1 : 0, lag = jj > tt ? jj - tt : tt - jj;
          const f32x4* k0 = (const f32x4*)(KLAG + (((size_t)(g * 2 + dir) * LC + lag) << 8) + ho * 16);
          f32x4 a[4];
#pragma unroll
          for (int q = 0; q < 4; ++q) a[q] = k0[q];
          if (jj == tt) { const f32x4* k1 = (const f32x4*)(KLAG + (((size_t)(g * 2 + 1) * LC) << 8) + ho * 16);
#pragma unroll
              for (int q = 0; q < 4; ++q) a[q] += k1[q];
              const float dv = dsk[g * SH + ho];
#pragma unroll
              for (int q = 0; q < 4; ++q) { a[q].x += (ho == 4 * q + 0) ? dv : 0.f; a[q].y += (ho == 4 * q + 1) ? dv : 0.f; a[q].z += (ho == 4 * q + 2) ? dv : 0.f; a[q].w += (ho == 4 * q + 3) ? dv : 0.f; } }
          u32x4* dst = (u32x4*)(TV + ((size_t)g * 512 + n) * A2LD + jj * 16);
          dst[0] = (u32x4){pk_bf16(a[0].x, a[0].y), pk_bf16(a[0].z, a[0].w), pk_bf16(a[1].x, a[1].y), pk_bf16(a[1].z, a[1].w)};
          dst[1] = (u32x4){pk_bf16(a[2].x, a[2].y), pk_bf16(a[2].z, a[2].w), pk_bf16(a[3].x, a[3].y), pk_bf16(a[3].z, a[3].w)}; } }
    LAS f32x4* MV = (LAS f32x4*)lds;
    for (int i = tid; i < 5 * 2 * 512; i += NWAVES * 64) { const int b = i >> 10, which = (i >> 9) & 1, q = i & 511; f32x4 t = *((const f32x4*)(modv + (size_t)b * 12288 + which * D) + q); if (which) t = t + 1.0f; MV[i] = t; }
    __syncthreads();
    const int gw = bid * NWAVES + wave, NGW = G * NWAVES; const float* XP = AIN(IX); const float* CP = AIN(ICTX);
    f32x4 v[8];
    { const int m = gw; const f32x4* xq = (const f32x4*)(m < T ? XP + (size_t)m * D : CP + (size_t)(m - T) * D) + lane;
#pragma unroll
      for (int j = 0; j < 8; ++j) v[j] = __builtin_nontemporal_load(xq + 64 * j); }
    for (int m = gw; m < T + TC; m += NGW) {
        f32x4 vn[8]; const int mn = m + NGW;
        if (mn < T + TC) { const f32x4* xq = (const f32x4*)(mn < T ? XP + (size_t)mn * D : CP + (size_t)(mn - T) * D) + lane;
#pragma unroll
            for (int j = 0; j < 8; ++j) vn[j] = __builtin_nontemporal_load(xq + 64 * j); }
        else {
#pragma unroll
            for (int j = 0; j < 8; ++j) vn[j] = (f32x4){0.f, 0.f, 0.f, 0.f}; }
        bf16* orow; int bsel;
        if (m < T) { orow = (bf16*)(ws + WS_R3) + (size_t)m * D; bsel = m >> 13; }
        else { orow = (bf16*)(ws + WS_HC) + (size_t)(m - T) * D; bsel = 4; }
        float s = 0.f;
#pragma unroll
        for (int j = 0; j < 8; ++j) s += (v[j].x + v[j].y) + (v[j].z + v[j].w);
        const float mean = wave_sum(s) * (1.f / D); float s2 = 0.f;
#pragma unroll
        for (int j = 0; j < 8; ++j) { v[j] = v[j] - mean; s2 += (v[j].x * v[j].x + v[j].y * v[j].y) + (v[j].z * v[j].z + v[j].w * v[j].w); }
        const float rstd = 1.f / sqrtf(wave_sum(s2) * (1.f / D) + LN_EPS);
        const LAS f32x4* shq = MV + bsel * 1024 + lane; const LAS f32x4* scq = shq + 512; u32x2* o8 = (u32x2*)orow + lane;
        unsigned char* o4 = ws + WS_RA + ((size_t)((m < T ? m : 0) >> 8) * 16 << 15) + ((size_t)(m & 255) << 7) + ((lane >> 5) << 15) + 4 * (lane & 31);
#pragma unroll
        for (int j = 0; j < 8; ++j) { const f32x4 sh = shq[64 * j], sc = scq[64 * j]; const f32x4 y = v[j] * rstd * sc + sh; if (m < T) *(unsigned*)(o4 + ((size_t)(2 * j) << 15)) = pk4_fp8(y.x, y.y, y.z, y.w); else o8[64 * j] = (u32x2){pk_bf16(y.x, y.y), pk_bf16(y.z, y.w)}; }
#pragma unroll
        for (int j = 0; j < 8; ++j) v[j] = vn[j];
    }
}

__device__ __forceinline__ void ctx_inproj(LAS unsigned char* lds, int lane, int wave, int G, int bid) {
    unsigned char* ws = AWS; const bf16* HC = (const bf16*)(ws + WS_HC); const bf16* WINT = (const bf16*)(ws + WS_WINT); bf16* A2 = (bf16*)(ws + WS_A2);
    const int fr = lane & 15, fq = lane >> 4;
    for (int wt = bid * NWAVES + wave; wt < 2048; wt += G * NWAVES) {
        const int rt = wt >> 5, ct = wt & 31;
        const bf16* ap = HC + (size_t)(16 * rt + fr) * D + 8 * fq; const bf16* bp = WINT + (size_t)(FW + 16 * ct + fr) * D + 8 * fq;
        f32x4 acc = (f32x4){0.f, 0.f, 0.f, 0.f};
#pragma unroll 8
        for (int ks = 0; ks < 64; ++ks) { const bf16x8 av = *(const bf16x8*)(ap + 32 * ks), bv = *(const bf16x8*)(bp + 32 * ks); acc = __builtin_amdgcn_mfma_f32_16x16x32_bf16(av, bv, acc, 0, 0, 0); }
#pragma unroll
        for (int j = 0; j < 4; ++j) { const int row = 16 * rt + 4 * fq + j, b = row >> 8, tp = row & 255;
            A2[((size_t)((ct * 4 + b) * NCH + (tp >> 5))) * A2LD + (tp & 31) * 16 + fr] = f2bf(acc[j]); }
    }
}
__device__ __forceinline__ void ctx_E(LAS unsigned char* lds, int lane, int wave, int G, int bid) {
    unsigned char* ws = AWS; const bf16* A2 = (const bf16*)(ws + WS_A2); const bf16* WET = (const bf16*)(ws + WS_WET); float* E = (float*)(ws + WS_E);
    const int fr = lane & 15, fq = lane >> 4;
    for (int task = (bid + G - (128 % G)) % G; task < 128; task += G) {
        const int g = task >> 2, b = task & 3;
        const bf16* ap = A2 + (size_t)((g * 4 + b) * NCH + fr) * A2LD + 8 * fq;
        const bf16* bp0 = WET + (size_t)(g * 256 + 32 * wave + fr) * 512 + 8 * fq; const bf16* bp1 = bp0 + 16 * 512;
        f32x4 acc0 = (f32x4){0.f, 0.f, 0.f, 0.f}, acc1 = acc0;
#pragma unroll 4
        for (int ks = 0; ks < 16; ++ks) { const bf16x8 av = *(const bf16x8*)(ap + 32 * ks), b0 = *(const bf16x8*)(bp0 + 32 * ks), b1 = *(const bf16x8*)(bp1 + 32 * ks);
            acc0 = __builtin_amdgcn_mfma_f32_16x16x32_bf16(av, b0, acc0, 0, 0, 0); acc1 = __builtin_amdgcn_mfma_f32_16x16x32_bf16(av, b1, acc1, 0, 0, 0); }
        if (fq < 2) {
#pragma unroll
            for (int j = 0; j < 4; ++j) { float* er = E + (size_t)((g * 4 + b) * NCH + 4 * fq + j) * 256 + 32 * wave + fr; er[0] = acc0[j]; er[16] = acc1[j]; } }
    }
}

__device__ __forceinline__ void chunk_scan(LAS unsigned char* lds, int lane, int wave, int G, int bid) {
    unsigned char* ws = AWS; const float* E = (const float*)(ws + WS_E); bf16* A2 = (bf16*)(ws + WS_A2);
    const f32x2* LAML = (const f32x2*)(ws + WS_LAML); const f32x2* LAMSEG = (const f32x2*)(ws + WS_LAMSEG);
    LAS f32x2* segEnd = (LAS f32x2*)lds;
    for (int task = bid; task < 256; task += G) {
        const int g = task >> 3, b = (task >> 1) & 3, dir = task & 1, p = lane;
        const f32x2 lamL = LAML[(g * 2 + dir) * SP + p], lamS = LAMSEG[(g * 2 + dir) * SP + p];
        const float* Eb = E + (size_t)((g * 4 + b) * NCH) * 256 + dir * 128 + p;
        const int v0 = 33 * wave;
        float sr = 0.f, si = 0.f;
#pragma unroll 11
        for (int i = 0; i < 33; ++i) { const int vi = v0 + i; const int cr = dir == 0 ? vi : (vi < NCTXCH ? NCTXCH - 1 - vi : (NCH - 1 + NCTXCH) - vi);
            const float er = Eb[(size_t)cr * 256], ei = Eb[(size_t)cr * 256 + 64];
            const float tr = lamL.x * sr - lamL.y * si + er, ti = lamL.x * si + lamL.y * sr + ei; sr = tr; si = ti; }
        __syncthreads();
        segEnd[wave * 64 + p] = (f32x2){sr, si};
        __syncthreads();
        sr = 0.f; si = 0.f;
        for (int w = 0; w < wave; ++w) { const f32x2 se = segEnd[w * 64 + p]; const float tr = lamS.x * sr - lamS.y * si + se.x, ti = lamS.x * si + lamS.y * sr + se.y; sr = tr; si = ti; }
        bf16* Ab = A2 + (size_t)((g * 4 + b) * NCH) * A2LD + 512 + dir * 128 + p;
#pragma unroll 11
        for (int i = 0; i < 33; ++i) { const int vi = v0 + i; const int cr = dir == 0 ? vi : (vi < NCTXCH ? NCTXCH - 1 - vi : (NCH - 1 + NCTXCH) - vi);
            const float er = Eb[(size_t)cr * 256], ei = Eb[(size_t)cr * 256 + 64];
            if (cr >= NCTXCH) { Ab[(size_t)cr * A2LD] = f2bf(sr); Ab[(size_t)cr * A2LD + 64] = f2bf(si); }
            const float tr = lamL.x * sr - lamL.y * si + er, ti = lamL.x * si + lamL.y * sr + ei; sr = tr; si = ti; }
    }
    __syncthreads();
}

__device__ __forceinline__ void ph10(LAS unsigned char* lds, int tid, int lane, int wave, int G, int bid) {
    unsigned char* ws = AWS; bf16* XM = (bf16*)(ws + WS_XMID); unsigned char* H2 = (unsigned char*)(ws + WS_RB); const float* modv = (const float*)(ws + WS_MODV);
    const bf16* WHI = (const bf16*)(ws + WS_WRTHI); const bf16* WLO = (const bf16*)(ws + WS_WRTLO);
    unsigned* ctl = (unsigned*)(ws + WS_CTL); int* rowlist = (int*)(ws + WS_ROWLIST); float* rw = (float*)(ws + WS_RW);
    constexpr int RS = 4112;
    LAS unsigned char* Hhi = lds; LAS unsigned char* Hlo = lds + 16 * RS;
    LAS float* Pp = (LAS float*)lds;
    LAS float* Lg = (LAS float*)(lds + 2 * 16 * RS);
    LAS int* tokE = (LAS int*)(lds + 2 * 16 * RS + 2304);
    LAS float* tokW = (LAS float*)(lds + 2 * 16 * RS + 3328);
    LAS int* tokLi = (LAS int*)(lds + 2 * 16 * RS + 4352);
    LAS int* lcnt = (LAS int*)(lds + 2 * 16 * RS + 5376);
    LAS int* lbase = (LAS int*)(lds + 2 * 16 * RS + 5504);
    const int fr = lane & 15, fq = lane >> 4;
    const float* XIN = AIN(IX); const bf16* MG = (const bf16*)(ws + WS_R3);
    const float* bgrp = AIN(IBGRP); const float* bexp = AIN(IBEXP); const float* ln1g = AIN(ILN1G); const float* ln1b = AIN(ILN1B);
    bf16x8 wf[8][3];
#pragma unroll
    for (int ks = 0; ks < 8; ++ks)
#pragma unroll
        for (int nt = 0; nt < 3; ++nt) wf[ks][nt] = *(const bf16x8*)(WHI + (size_t)(16 * nt + fr) * D + 256 * wave + 32 * ks + 8 * fq);
    LAS f32x4* VEC = (LAS f32x4*)(lds + 16 * RS);
    const f32x4* XIN4 = (const f32x4*)XIN + lane; const u32x2* MG2 = (const u32x2*)MG + lane;
    auto load_row = [&](size_t gtok, f32x4 (&xv)[8], u32x2 (&mv_)[8]) {
        const f32x4* xin = XIN4 + gtok * (D / 4); const u32x2* mgq = MG2 + gtok * (D / 4);
#pragma unroll
        for (int j = 0; j < 8; ++j) { mv_[j] = __builtin_nontemporal_load(mgq + 64 * j); xv[j] = __builtin_nontemporal_load(xin + 64 * j); } };
    auto do_row = [&](f32x4 (&v)[8], const u32x2 (&mg)[8], size_t gtok, int row) {
        u32x2* xq = (u32x2*)(XM + gtok * D) + lane; float s = 0.f;
#pragma unroll
        for (int j = 0; j < 8; ++j) { v[j] = v[j] * DN_ALPHA + (f32x4){bf_lo(mg[j].x), bf_hi(mg[j].x), bf_lo(mg[j].y), bf_hi(mg[j].y)}; s += (v[j].x + v[j].y) + (v[j].z + v[j].w); }
        float mean = wave_sum(s) * (1.f / D), s2 = 0.f;
#pragma unroll
        for (int j = 0; j < 8; ++j) { v[j] = v[j] - mean; s2 += (v[j].x * v[j].x + v[j].y * v[j].y) + (v[j].z * v[j].z + v[j].w * v[j].w); }
        float rstd = 1.f / sqrtf(wave_sum(s2) * (1.f / D) + LN_EPS);
        const LAS f32x4* gq = VEC + lane; const LAS f32x4* bq = VEC + 512 + lane; s = 0.f;
#pragma unroll
        for (int j = 0; j < 8; ++j) { v[j] = v[j] * rstd * gq[64 * j] + bq[64 * j]; xq[64 * j] = (u32x2){pk_bf16(v[j].x, v[j].y), pk_bf16(v[j].z, v[j].w)}; s += (v[j].x + v[j].y) + (v[j].z + v[j].w); }
        mean = wave_sum(s) * (1.f / D); s2 = 0.f;
#pragma unroll
        for (int j = 0; j < 8; ++j) { v[j] = v[j] - mean; s2 += (v[j].x * v[j].x + v[j].y * v[j].y) + (v[j].z * v[j].z + v[j].w * v[j].w); }
        rstd = 1.f / sqrtf(wave_sum(s2) * (1.f / D) + LN_EPS);
        const LAS f32x4* scq = VEC + 1024 + lane; const LAS f32x4* shq = VEC + 1536 + lane; unsigned* o8 = (unsigned*)(H2 + gtok * D) + lane;
#pragma unroll
        for (int j = 0; j < 8; ++j) { const f32x4 y = v[j] * rstd * scq[64 * j] + shq[64 * j];
            const u32x2 hi = (u32x2){pk_bf16(y.x, y.y), pk_bf16(y.z, y.w)};
            o8[64 * j] = pk4_fp8(y.x, y.y, y.z, y.w);
            *(LAS u32x2*)(Hhi + row * RS + (256 * j + 4 * lane) * 2) = hi; } };
    for (int batch = bid; batch < 256; batch += G) {
        if (tid < 32) lcnt[tid] = 0;
        { const float* mv = modv + (size_t)((batch * 128) >> 13) * 12288;
          for (int i = tid; i < 4 * 512; i += NWAVES * 64) { const int r = i >> 9, q = i & 511;
              f32x4 t = *((const f32x4*)(r == 0 ? ln1g : r == 1 ? ln1b : r == 2 ? mv + 4 * D : mv + 3 * D) + q); if (r == 2) t = t + 1.0f; VEC[i] = t; } }
        __syncthreads();
        const size_t tokB = (size_t)batch * 128 + 2 * wave;
        f32x4 xa[8], xb[8]; u32x2 ma[8], mb[8];
        load_row(tokB, xa, ma);
        for (int grp = 0; grp < 8; ++grp) {
            const size_t g0 = tokB + grp * 16;
            load_row(g0 + 1, xb, mb);
            do_row(xa, ma, g0, 2 * wave);
            if (grp < 7) load_row(g0 + 16, xa, ma);
            do_row(xb, mb, g0 + 1, 2 * wave + 1);
            __syncthreads();
            f32x4 acc[3];
#pragma unroll
            for (int nt = 0; nt < 3; ++nt) acc[nt] = (f32x4){0.f, 0.f, 0.f, 0.f};
#pragma unroll
            for (int ks = 0; ks < 8; ++ks) { const int k = 256 * wave + 32 * ks + 8 * fq;
                const bf16x8 ahi = *(const LAS bf16x8*)(Hhi + fr * RS + k * 2);
#pragma unroll
                for (int nt = 0; nt < 3; ++nt) acc[nt] = __builtin_amdgcn_mfma_f32_16x16x32_bf16(ahi, wf[ks][nt], acc[nt], 0, 0, 0); }
            __syncthreads();
#pragma unroll
            for (int nt = 0; nt < 3; ++nt)
#pragma unroll
                for (int j = 0; j < 4; ++j) Pp[(wave * 16 + 4 * fq + j) * 48 + 16 * nt + fr] = acc[nt][j];
            __syncthreads();
            for (int i = tid; i < 16 * 36; i += 512) { const int tk = i / 36, n = i % 36; float s = 0.f;
#pragma unroll
                for (int w = 0; w < 8; ++w) s += Pp[(w * 16 + tk) * 48 + n];
                Lg[i] = s; }
            __syncthreads();
            if (tid < 16) {
                const LAS float* L = Lg + tid * 36;
                float lg[4]; int gi = 0; float gm;
#pragma unroll
                for (int i = 0; i < 4; ++i) lg[i] = L[i] + bgrp[i];
                gm = lg[0];
#pragma unroll
                for (int i = 1; i < 4; ++i) if (lg[i] > gm) { gm = lg[i]; gi = i; }
                float gz = 0.f;
#pragma unroll
                for (int i = 0; i < 4; ++i) gz += expf(lg[i] - gm);
                const float gtop = 1.0f / gz;
                float le[8]; int j0 = 0; float m0;
#pragma unroll
                for (int j = 0; j < 8; ++j) le[j] = L[4 + gi * 8 + j] + bexp[gi * 8 + j];
                m0 = le[0];
#pragma unroll
                for (int j = 1; j < 8; ++j) if (le[j] > m0) { m0 = le[j]; j0 = j; }
                int j1 = (j0 == 0) ? 1 : 0; float m1 = -3.0e38f;
#pragma unroll
                for (int j = 0; j < 8; ++j) if (j != j0 && le[j] > m1) { m1 = le[j]; j1 = j; }
                const float e1 = expf(m1 - m0), w0 = gtop / (1.0f + e1), w1 = gtop * e1 / (1.0f + e1);
                const int ex0 = gi * 8 + j0, ex1 = gi * 8 + j1; const int sl = (grp * 16 + tid) * 2;
                tokE[sl] = ex0; tokE[sl + 1] = ex1; tokW[sl] = w0; tokW[sl + 1] = w1;
                tokLi[sl] = __hip_atomic_fetch_add(lcnt + ex0, 1, __ATOMIC_RELAXED, __HIP_MEMORY_SCOPE_WORKGROUP);
                tokLi[sl + 1] = __hip_atomic_fetch_add(lcnt + ex1, 1, __ATOMIC_RELAXED, __HIP_MEMORY_SCOPE_WORKGROUP);
            }
            __syncthreads();
        }
        if (tid < 32) { const int n = lcnt[tid]; lbase[tid] = n ? (int)__hip_atomic_fetch_add(ctl + CW_CNT + 64 * tid, (unsigned)n, RLX_AGENT) : 0; }
        __syncthreads();
        if (tid < 256) { const int e = tokE[tid], pos = lbase[e] + tokLi[tid], ent = (batch * 128 + (tid >> 1)) * 2 + (tid & 1); rowlist[(size_t)e * ECAP + pos] = ent; rw[ent] = tokW[tid]; }
        __syncthreads();
    }
}

__device__ __forceinline__ void ph13(LAS unsigned char* lds, int tid, int lane_, int wave, int G, int bid) {
    const int lane = (int)__builtin_amdgcn_mbcnt_hi(~0u, __builtin_amdgcn_mbcnt_lo(~0u, 0u));
    unsigned char* ws = AWS; float* X = AOUT; const bf16* XM = (const bf16*)(ws + WS_XMID); const unsigned char* Y = (const unsigned char*)(ws + WS_RB); const float* rw = (const float*)(ws + WS_RW); const float* modv = (const float*)(ws + WS_MODV);
    LAS f32x4* VG = (LAS f32x4*)lds;
    { const f32x4* g2 = (const f32x4*)AIN(ILN2G); const f32x4* b2 = (const f32x4*)AIN(ILN2B);
      for (int i = tid; i < 6 * 512; i += NWAVES * 64) { const int r = i >> 9, q = i & 511; VG[i] = r < 4 ? *((const f32x4*)(modv + (size_t)r * 12288 + 5 * D) + q) : (r == 4 ? g2[q] : b2[q]); } }
    __syncthreads();
    const int gw = bid * NWAVES + wave, NGW = G * NWAVES;
    unsigned p0[8], p1[8]; u32x2 xb[8]; float w0, w1;
    { const int m = gw; const u32x2* xm = (const u32x2*)(XM + (size_t)m * D) + lane; const unsigned* y0 = (const unsigned*)(Y + (size_t)(2 * m) * D) + lane; const unsigned* y1 = y0 + D / 4;
#pragma unroll
      for (int j = 0; j < 8; ++j) { p0[j] = __builtin_nontemporal_load(y0 + 64 * j); p1[j] = __builtin_nontemporal_load(y1 + 64 * j); xb[j] = __builtin_nontemporal_load(xm + 64 * j); }
      w0 = rw[2 * m]; w1 = rw[2 * m + 1]; }
    for (int m = gw; m < T; m += NGW) {
        unsigned q0[8], q1[8]; u32x2 xn[8]; float wn0 = 0.f, wn1 = 0.f; const int mn = m + NGW;
        if (mn < T) { const u32x2* xm = (const u32x2*)(XM + (size_t)mn * D) + lane; const unsigned* y0 = (const unsigned*)(Y + (size_t)(2 * mn) * D) + lane; const unsigned* y1 = y0 + D / 4;
#pragma unroll
            for (int j = 0; j < 8; ++j) { q0[j] = __builtin_nontemporal_load(y0 + 64 * j); q1[j] = __builtin_nontemporal_load(y1 + 64 * j); xn[j] = __builtin_nontemporal_load(xm + 64 * j); }
            wn0 = rw[2 * mn]; wn1 = rw[2 * mn + 1]; }
        else {
#pragma unroll
            for (int j = 0; j < 8; ++j) { q0[j] = 0u; q1[j] = 0u; xn[j] = (u32x2){0u, 0u}; } }
        f32x4* xq = (f32x4*)(X + (size_t)m * D) + lane; const LAS f32x4* gq = VG + (m >> 13) * 512 + lane;
        const float c0 = w0 * Y8_INV, c1 = w1 * Y8_INV;
        f32x4 v[8]; float s = 0.f;
#pragma unroll
        for (int j = 0; j < 8; ++j) {
            const f32x2 a0 = __builtin_amdgcn_cvt_pk_f32_fp8((int)p0[j], false), a1 = __builtin_amdgcn_cvt_pk_f32_fp8((int)p0[j], true), b0 = __builtin_amdgcn_cvt_pk_f32_fp8((int)p1[j], false), b1 = __builtin_amdgcn_cvt_pk_f32_fp8((int)p1[j], true);
            const f32x4 yy = (f32x4){a0.x, a0.y, a1.x, a1.y} * c0 + (f32x4){b0.x, b0.y, b1.x, b1.y} * c1;
            v[j] = (f32x4){bf_lo(xb[j].x), bf_hi(xb[j].x), bf_lo(xb[j].y), bf_hi(xb[j].y)} * DN_ALPHA + gq[64 * j] * yy; s += (v[j].x + v[j].y) + (v[j].z + v[j].w); }
        const float mean = wave_sum(s) * (1.f / D); float s2 = 0.f;
#pragma unroll
        for (int j = 0; j < 8; ++j) { v[j] = v[j] - mean; s2 += (v[j].x * v[j].x + v[j].y * v[j].y) + (v[j].z * v[j].z + v[j].w * v[j].w); }
        const float rstd = 1.f / sqrtf(wave_sum(s2) * (1.f / D) + LN_EPS);
        const LAS f32x4* g2 = VG + 4 * 512 + lane; const LAS f32x4* b2 = VG + 5 * 512 + lane;
#pragma unroll
        for (int j = 0; j < 8; ++j) __builtin_nontemporal_store(v[j] * rstd * g2[64 * j] + b2[64 * j], xq + 64 * j);
#pragma unroll
        for (int j = 0; j < 8; ++j) { p0[j] = q0[j]; p1[j] = q1[j]; xb[j] = xn[j]; }
        w0 = wn0; w1 = wn1;
    }
}

__global__ void __launch_bounds__(NWAVES * 64, 2) fwd_kernel(Args a) {
    extern __shared__ __attribute__((aligned(16))) unsigned char lds_raw[];
    LAS unsigned char* lds = (LAS unsigned char*)lds_raw;
    const int tid = threadIdx.x, lane = tid & 63, wave = __builtin_amdgcn_readfirstlane(tid >> 6), G = gridDim.x, bid = blockIdx.x;
    for (int u = tid; u < (LDS_BYTES - MISC_OFF) / 4; u += NWAVES * 64) ((LAS unsigned*)(lds + MISC_OFF))[u] = 0u;
    __syncthreads();
    if (tid < NIN + 2) { const unsigned long long* kp = (const unsigned long long*)&a; const unsigned long long v = kp[tid];
        volatile LAS unsigned* tab = (volatile LAS unsigned*)(lds + ARGS_OFF); tab[2 * tid] = (unsigned)v; tab[2 * tid + 1] = (unsigned)(v >> 32); }
    __syncthreads();
    unsigned char* ws = AWS;
    const int lo = a.ph_lo, hi = a.ph_hi;
    XcdBarrier bar; bar.bar = (unsigned*)(ws + WS_CTL) + CW_BAR; bar.x = 0; bar.st = nullptr;
    if (hi - lo > 1) bar = xcd_barrier_post((unsigned*)(ws + WS_CTL) + CW_BAR, (volatile LAS unsigned*)(lds + MISC_OFF));
#ifndef PHASE_MASK
#define PHASE_MASK 0x3fff
#endif
#define IN(k) (((PHASE_MASK >> (k)) & 1) && lo <= (k) && (k) < hi)
#define SEAM(k) do { if (IN(k) && IN((k) + 1)) xcd_barrier(bar); } while (0)
    LAS int* moe_pre = (LAS int*)(lds + MISC_OFF + 256);
    LAS int* moe_cnt = (LAS int*)(lds + MISC_OFF + 512);

    if (IN(0)) { ph0(lds, tid, lane, wave, G, bid); } SEAM(0);
    if (IN(1)) { ph1(lds, tid, G, bid); } SEAM(1);
    if (IN(2)) { ph2(lds, tid, lane, wave, G, bid); } SEAM(2);
    if (IN(3)) {
        ctx_inproj(lds, lane, wave, G, bid);
        { SchedTiled S; S.o.init(T / 256, 6, G, bid); S.A = (const char*)(ws + WS_RA); S.B = (const char*)(ws + WS_WG8); S.nt = D / 128;
          EpiInProjT<true> E{(bf16*)(ws + WS_UF), (bf16*)(ws + WS_A2), nullptr, nullptr};
          pg8::gemm_phase<EpiInProjT<true>, SchedTiled, true, true>(lds, S, E); }
        { SchedTiled S; S.o.init(T / 256, 16, G, bid); S.A = (const char*)(ws + WS_RA); S.B = (const char*)(ws + WS_WG8) + ((size_t)6 * (D / 128) << 15); S.nt = D / 128;
          EpiGates8 E{(unsigned char*)AOUT, (unsigned char*)AOUT + (size_t)T * D};
          pg8::gemm_phase<EpiGates8, SchedTiled, true, true>(lds, S, E); }
    } SEAM(3);
    if (IN(4)) {
#ifndef NO_P4A
        { SchedE S{G, bid, (const char*)(ws + WS_A2), (const char*)(ws + WS_WET)}; EpiE E{(float*)(ws + WS_E)}; pg8::gemm_phase<EpiE, SchedE>(lds, S, E); }
#endif
#ifndef NO_P4B
        ctx_E(lds, lane, wave, G, bid);
#endif
#ifndef NO_P4C
        { SchedF1 S{G, bid, (const char*)(ws + WS_FKT), (const char*)(ws + WS_UF)}; EpiF1 E{(bf16*)(ws + WS_R3)}; pg8::gemm_phase<EpiF1, SchedF1>(lds, S, E); }
#endif
    } SEAM(4);
    if (IN(5)) {
        chunk_scan(lds, lane, wave, G, bid);
        { SchedF2 S{G, bid, (const char*)(ws + WS_FCT), (const char*)(ws + WS_R3)}; EpiF2 E{(bf16*)(ws + WS_RA)}; pg8::gemm_phase<EpiF2, SchedF2>(lds, S, E); }
    } SEAM(5);
    if (IN(6)) {
#ifndef NO_P6A
        { SchedSSM S{G, bid, (const char*)(ws + WS_A2), (const char*)(ws + WS_TV)}; EpiSSM E{(bf16*)(ws + WS_YS)}; pg8::gemm_phase<EpiSSM, SchedSSM>(lds, S, E); }
#endif
#ifndef NO_P6B
        { SchedF3 S{G, bid, (const char*)(ws + WS_FRT), (const char*)(ws + WS_RA)}; EpiF3 E{(unsigned char*)(ws + WS_R3)}; pg8::gemm_phase<EpiF3, SchedF3>(lds, S, E); }
#endif
    } SEAM(6);
    if (IN(7)) {
        SchedRect S; S.o.init(T / 256, SW / 256, G, bid); S.A = (const char*)(ws + WS_YS); S.B = (const char*)(ws + WS_WGLUT); S.lda = SW; S.ldb = SW; S.nt = SW / 64;
        EpiGate<2> E{nullptr, (const void*)(ws + WS_YS), AIN(IBGLU), SW, (unsigned char*)(ws + WS_R3), SW + FW};
        pg8::gemm_phase<EpiGate<2>, SchedRect>(lds, S, E);
    } SEAM(7);
    if (IN(8)) {
        SchedMerge S; S.o.init(T / 256, D / 256, G, bid); S.A = (const char*)(ws + WS_R3); S.B = (const char*)(ws + WS_WFT);
        EpiMerge E{(unsigned char*)(ws + WS_RA), (const unsigned char*)AOUT, (const unsigned char*)AOUT + (size_t)T * D};
        pg8::gemm_phase<EpiMerge, SchedMerge, true, true>(lds, S, E);
    } SEAM(8);
    if (IN(9)) {
        SchedRect S; S.o.init(T / 256, D / 256, G, bid); S.A = (const char*)(ws + WS_RA); S.B = (const char*)(ws + WS_WOT); S.lda = D / 2; S.ldb = D / 2; S.nt = D / 128;
        EpiOut E{(const float*)(ws + WS_MODV), (bf16*)(ws + WS_R3)};
        pg8::gemm_phase<EpiOut, SchedRect, true, true>(lds, S, E);
    } SEAM(9);
    if (IN(10)) { ph10(lds, tid, lane, wave, G, bid); } SEAM(10);
    if (IN(11) || IN(12)) {
        if (tid < 64) { const int cnt = tid < NE ? (int)__hip_atomic_load((unsigned*)(ws + WS_CTL) + CW_CNT + 64 * tid, RLX_AGENT) : 0; const int tiles = (cnt + 255) >> 8; int incl = tiles;
#pragma unroll
            for (int o = 1; o < 32; o <<= 1) { const int t = __shfl_up(incl, o); if (lane >= o) incl += t; }
            if (tid < NE) { moe_pre[tid] = incl - tiles; moe_cnt[tid] = cnt; } if (tid == NE - 1) moe_pre[NE] = incl; }
        __syncthreads();
    }
    if (IN(11)) {
        SchedMoe<1, D, D, D / 128> S{G, bid, (const char*)(ws + WS_RB), (const char*)(ws + WS_W13T), (const int*)(ws + WS_ROWLIST), moe_pre, moe_cnt};
        EpiMoe1 E{(unsigned char*)(ws + WS_RA), (const int*)(ws + WS_ROWLIST)};
        pg8::gemm_phase<EpiMoe1, SchedMoe<1, D, D, D / 128>, true, true>(lds, S, E);
    } SEAM(11);
    if (IN(12)) {
        SchedMoe<0, DE, DE, DE / 128> S{G, bid, (const char*)(ws + WS_RA), (const char*)(ws + WS_W2T), (const int*)(ws + WS_ROWLIST), moe_pre, moe_cnt};
        EpiMoe2 E{(unsigned char*)(ws + WS_RB), (const int*)(ws + WS_ROWLIST)};
        pg8::gemm_phase<EpiMoe2, SchedMoe<0, DE, DE, DE / 128>, true, true>(lds, S, E);
    } SEAM(12);
    if (IN(13)) { ph13(lds, tid, lane, wave, G, bid); }
#undef IN
#undef SEAM
}

extern "C" void kernel_launch(void* const* d_in, const int* in_sizes, int n_in, void* d_out, int out_size, void* d_ws, size_t ws_size, hipStream_t stream) {
    static int grid = 0;
    if (grid == 0) {
        if (n_in != NIN || out_size != T * D || ws_size < WS_END) { fprintf(stderr, "kernel_launch: unexpected problem (n_in %d, out %d, ws %zu); nothing launched\n", n_in, out_size, ws_size); grid = -1; return; }
        int dev = 0, cus = 0, per_cu = 0;
        if (hipGetDevice(&dev) != hipSuccess || hipDeviceGetAttribute(&cus, hipDeviceAttributeMultiprocessorCount, dev) != hipSuccess) { grid = -1; return; }
        if (hipFuncSetAttribute((const void*)fwd_kernel, hipFuncAttributeMaxDynamicSharedMemorySize, LDS_BYTES) != hipSuccess) { fprintf(stderr, "kernel_launch: hipFuncSetAttribute failed\n"); grid = -1; return; }
        if (hipOccupancyMaxActiveBlocksPerMultiprocessor(&per_cu, (const void*)fwd_kernel, NWAVES * 64, LDS_BYTES) != hipSuccess || per_cu < 1) { fprintf(stderr, "kernel_launch: occupancy query says %d\n", per_cu); (void)hipGetLastError(); }
        grid = cus > 256 ? 256 : cus;
    }
    if (grid < 0) return;
    (void)hipMemsetAsync((char*)d_ws + WS_CTL, 0, CTL_ZERO_BYTES, stream);
    Args a{};
    for (int i = 0; i < NIN; ++i) a.in[i] = (const float*)d_in[i];
    a.out = (float*)d_out; a.ws = (unsigned char*)d_ws;
#if MK_ONE_LAUNCH
    a.ph_lo = 0; a.ph_hi = NPHASE;
    hipLaunchKernelGGL(fwd_kernel, dim3(grid), dim3(NWAVES * 64), LDS_BYTES, stream, a);
#else
#ifndef RUN_PHASES
#define RUN_PHASES NPHASE
#endif
    for (int p = 0; p < RUN_PHASES; ++p) { a.ph_lo = p; a.ph_hi = p + 1; hipLaunchKernelGGL(fwd_kernel, dim3(grid), dim3(NWAVES * 64), LDS_BYTES, stream, a); }
#endif
}
```

```cpp
#include <hip/hip_runtime.h>
#include <cstdio>
#include <cstdint>

#ifndef MK_ONE_LAUNCH
#define MK_ONE_LAUNCH 1
#endif

#define GAS __attribute__((address_space(1)))
#define LAS __attribute__((address_space(3)))
typedef unsigned short bf16;
typedef float f32x4 __attribute__((ext_vector_type(4)));
typedef float f32x2 __attribute__((ext_vector_type(2)));
typedef short bf16x8 __attribute__((ext_vector_type(8)));
typedef unsigned u32x4 __attribute__((ext_vector_type(4)));
typedef unsigned u32x2 __attribute__((ext_vector_type(2)));
typedef int i32x4 __attribute__((ext_vector_type(4)));
typedef int i32x8 __attribute__((ext_vector_type(8)));
typedef GAS unsigned gu32;
#define RLX_AGENT __ATOMIC_RELAXED, __HIP_MEMORY_SCOPE_AGENT

constexpr int D = 2048, NB = 4, SEQ = 8192, T = NB * SEQ, CTXL = 256, TC = NB * CTXL;
constexpr int FW = 1024, SW = 512, INW = 5632;
constexpr int SG = 32, SH = 16, SP = 64, LC = 32, NCH = 264, NCTXCH = 8, A2LD = 768;
constexpr int NE = 32, DE = 1024, ECAP = 32768;
constexpr float LN_EPS = 1e-5f;
constexpr float DN_ALPHA = 1.189207115002721f;
constexpr int NPHASE = 14;

constexpr size_t MiB = 1u << 20;
constexpr size_t WS_CTL = 0, CTL_ZERO_BYTES = 64 * 1024;
constexpr size_t WS_MODPART = 1 * MiB;
constexpr size_t WS_MODV = 5 * MiB;
constexpr size_t WS_PW = 6 * MiB;
constexpr size_t WS_BBAR = 8 * MiB;
constexpr size_t WS_LAML = 9 * MiB;
constexpr size_t WS_LAMSEG = 9 * MiB + 512 * 1024;
constexpr size_t WS_KLAG = 10 * MiB;
constexpr size_t WS_RW = 12 * MiB;
constexpr size_t WS_ROWLIST = 13 * MiB;
constexpr size_t WS_FKT = 17 * MiB;
constexpr size_t WS_FCT = 17 * MiB + 256 * 1024;
constexpr size_t WS_FRT = 17 * MiB + 512 * 1024;
constexpr size_t WS_WRTHI = 17 * MiB + 768 * 1024;
constexpr size_t WS_WRTLO = 18 * MiB;
constexpr size_t WS_HC = 19 * MiB;
constexpr size_t WS_WINT = 24 * MiB;
constexpr size_t WS_WG8 = 32 * MiB;
constexpr size_t WS_WFT = 46 * MiB;
constexpr size_t WS_WST = 50 * MiB;
constexpr size_t WS_WOT = 52 * MiB;
constexpr size_t WS_WGLUT = 60 * MiB;
constexpr size_t WS_WET = 61 * MiB;
constexpr size_t WS_TV = 69 * MiB;
constexpr size_t WS_W13T = 96 * MiB;
constexpr size_t WS_XMID = 224 * MiB;
constexpr size_t WS_W2T = 352 * MiB;
constexpr size_t WS_R3 = 480 * MiB;
constexpr size_t WS_RA = 608 * MiB;
constexpr size_t WS_RB = 736 * MiB;
constexpr size_t WS_UF = WS_RB;
constexpr size_t WS_A2 = WS_RB + 64 * MiB;
constexpr size_t WS_E = WS_RB + 114 * MiB;
constexpr size_t WS_YS = WS_RB + 148 * MiB;
constexpr size_t WS_SOUT = WS_RB + 180 * MiB;
constexpr size_t WS_END = 992 * MiB;
constexpr int CW_TMO = 0, CW_BAR = 4096, CW_CNT = 8192;

constexpr int RING_BYTES = 131072;
constexpr int MISC_OFF = 147456;
constexpr int LDS_BYTES = 155648;
constexpr int NWAVES = 8;

typedef __bf16 bf16x2_t __attribute__((ext_vector_type(2)));
__device__ __forceinline__ unsigned pk_bf16(float lo, float hi) { const bf16x2_t r = __builtin_convertvector((f32x2){lo, hi}, bf16x2_t); return __builtin_bit_cast(unsigned, r); }
__device__ __forceinline__ float bf_lo(unsigned u) { return __uint_as_float(u << 16); }
__device__ __forceinline__ float bf_hi(unsigned u) { return __uint_as_float(u & 0xffff0000u); }
__device__ __forceinline__ bf16 f2bf(float f) { unsigned u = __float_as_uint(f); return (bf16)((u + 0x7fffu + ((u >> 16) & 1u)) >> 16); }
__device__ __forceinline__ float bf2f(bf16 b) { return __uint_as_float(((unsigned)b) << 16); }
__device__ __forceinline__ float fsigmoid(float x) { return __builtin_amdgcn_rcpf(1.0f + __builtin_amdgcn_exp2f(-1.44269504f * x)); }
__device__ __forceinline__ void st16_bf16(bf16* dst, f32x4 a, f32x4 b, f32x4 c, f32x4 d) {
    u32x4 w0, w1; w0.x = pk_bf16(a[0], a[1]); w0.y = pk_bf16(a[2], a[3]); w0.z = pk_bf16(b[0], b[1]); w0.w = pk_bf16(b[2], b[3]);
    w1.x = pk_bf16(c[0], c[1]); w1.y = pk_bf16(c[2], c[3]); w1.z = pk_bf16(d[0], d[1]); w1.w = pk_bf16(d[2], d[3]);
    *(u32x4*)dst = w0; *(u32x4*)(dst + 8) = w1; }
__device__ __forceinline__ unsigned pk4_u8(float a, float b, float c, float d) {
    const unsigned ya = __builtin_bit_cast(unsigned, a * 255.0f + 8388608.0f), yb = __builtin_bit_cast(unsigned, b * 255.0f + 8388608.0f), yc = __builtin_bit_cast(unsigned, c * 255.0f + 8388608.0f), yd = __builtin_bit_cast(unsigned, d * 255.0f + 8388608.0f);
    const unsigned w01 = __builtin_amdgcn_perm(yb, ya, 0x0c0c0400u), w23 = __builtin_amdgcn_perm(yd, yc, 0x0c0c0400u);
    return __builtin_amdgcn_perm(w23, w01, 0x05040100u); }
__device__ __forceinline__ f32x4 u8x4_f32(unsigned w) { return (f32x4){(float)(w & 0xffu), (float)((w >> 8) & 0xffu), (float)((w >> 16) & 0xffu), (float)(w >> 24)}; }
__device__ __forceinline__ float gelu_tanh(float x) { return x * fsigmoid(1.5957691216f * (x + 0.044715f * x * x * x)); }
__device__ __forceinline__ float wave_sum(float v) {
#pragma unroll
    for (int o = 1; o < 64; o <<= 1) v += __shfl_xor(v, o);
    return v;
}
constexpr float W8_SCALE = 64.0f, W8_INV = 1.0f / 64.0f;
__device__ __forceinline__ float clamp8(float x) { return __builtin_amdgcn_fmed3f(x, -448.0f, 448.0f); }
__device__ __forceinline__ unsigned pk4_fp8(float a, float b, float c, float d) { int w = 0; w = __builtin_amdgcn_cvt_pk_fp8_f32(clamp8(a), clamp8(b), w, false); w = __builtin_amdgcn_cvt_pk_fp8_f32(clamp8(c), clamp8(d), w, true); return (unsigned)w; }
#define LDS_WAIT() asm volatile("s_waitcnt lgkmcnt(0)" ::: "memory")
#define VM_WAIT() asm volatile("s_waitcnt vmcnt(0)" ::: "memory")

#define XB_TMO      128
#define XB_XCNT(j)  (256  + 64 * (j))
#define XB_XSUB(j)  (1280 + 64 * (j))
#define XB_XGEN(j)  (2304 + 64 * (j))
#define XB_TOP      3328
#define XB_TOPGEN   3392
#define XCD_BAR_WORDS 3456
#define XB_SPIN_CAP (1u << 18)
__device__ __forceinline__ unsigned xb_ld(unsigned* p)              { return __hip_atomic_load(p, __ATOMIC_RELAXED, __HIP_MEMORY_SCOPE_AGENT); }
__device__ __forceinline__ unsigned xb_add(unsigned* p, unsigned v) { return __hip_atomic_fetch_add(p, v, __ATOMIC_RELAXED, __HIP_MEMORY_SCOPE_AGENT); }
__device__ __forceinline__ unsigned xb_xcc_id() { return (unsigned)__builtin_amdgcn_s_getreg((3 << 11) | 20) & 0xFu; }
#define XB_SPIN(cond, bar) do { unsigned _sp = 0; while (cond) { __builtin_amdgcn_s_sleep(1); \
    if ((++_sp & 255u) == 0u) { if (xb_ld(&(bar)[XB_TMO])) break; if (_sp > XB_SPIN_CAP) { atomicAdd(&(bar)[XB_TMO], 1u); break; } } } } while (0)
struct XcdBarrier { unsigned* bar; unsigned x; volatile LAS unsigned* st; };
__device__ __forceinline__ XcdBarrier xcd_barrier_post(unsigned* bar, volatile LAS unsigned* st) {
    XcdBarrier b; b.bar = bar; b.x = xb_xcc_id(); b.st = st;
    if (threadIdx.x == 0) (void)xb_add(&bar[XB_XCNT(b.x)], 1u);
    return b;
}
__device__ __forceinline__ void xcd_barrier_complete(unsigned* bar, unsigned x, unsigned& nloc, unsigned& nx) {
    const unsigned G = gridDim.x * gridDim.y * gridDim.z;
    unsigned sum, cnt, mine, sp = 0u;
    for (;;) {
        sum = 0u; cnt = 0u; mine = 0u;
#pragma unroll
        for (unsigned j = 0; j < 16; ++j) { const unsigned c = xb_ld(&bar[XB_XCNT(j)]); sum += c; cnt += (c > 0u) ? 1u : 0u; mine = (j == x) ? c : mine; }
        if (sum == G) break;
        __builtin_amdgcn_s_sleep(1);
        if ((++sp & 255u) == 0u) { if (xb_ld(&bar[XB_TMO])) break; if (sp > XB_SPIN_CAP) { atomicAdd(&bar[XB_TMO], 1u); break; } }
    }
    nloc = mine > 0u ? mine : 1u; nx = cnt > 0u ? cnt : 1u;
}
__device__ __forceinline__ void xcd_barrier(const XcdBarrier& b) {
    asm volatile("s_waitcnt vmcnt(0)" ::: "memory");
    __syncthreads();
    if (threadIdx.x == 0) {
        unsigned* bar = b.bar;
        __builtin_amdgcn_s_waitcnt(0);
        unsigned nloc = b.st[0], nx = b.st[1];
        if (nloc == 0u) { xcd_barrier_complete(bar, b.x, nloc, nx); b.st[0] = nloc; b.st[1] = nx; }
        const unsigned old = xb_add(&bar[XB_XSUB(b.x)], 1u);
        const unsigned gen = old / nloc;
        if (old + 1u == (gen + 1u) * nloc) {
            __builtin_amdgcn_fence(__ATOMIC_RELEASE, "agent");
            asm volatile("s_waitcnt vmcnt(0)" ::: "memory");
            const unsigned og = xb_add(&bar[XB_TOP], 1u);
            const unsigned tg = og / nx;
            if (og + 1u == (tg + 1u) * nx) xb_add(&bar[XB_TOPGEN], 1u);
            else XB_SPIN(xb_ld(&bar[XB_TOPGEN]) == tg, bar);
            __builtin_amdgcn_fence(__ATOMIC_ACQUIRE, "agent");
            xb_add(&bar[XB_XGEN(b.x)], 1u);
            asm volatile("s_waitcnt vmcnt(0)" ::: "memory");
        } else {
            XB_SPIN(xb_ld(&bar[XB_XGEN(b.x)]) == gen, bar);
            __builtin_amdgcn_fence(__ATOMIC_ACQUIRE, "agent");
            asm volatile("s_waitcnt vmcnt(0)" ::: "memory");
        }
    }
    __syncthreads();
}

namespace pg8 {
#define PG8_LAS __attribute__((address_space(3)))
constexpr int BM = 256, BK = 64, HALF = 128, HTB = HALF * BK * 2, STAGE_BYTES = 8 * HTB, NXCD = 8, WGM = 8;
__host__ __device__ __forceinline__ int lds_byte(int r, int c) { const int st = (r >> 4) * 2 + (c >> 5), rr = r & 15, cc = c & 31, ob = rr * 64 + cc * 2; return st * 1024 + (ob ^ (((ob >> 9) & 1) << 5)); }
__host__ __device__ __forceinline__ void stage_rc(int b, int& R, int& C) { const int st = b / 1024, sb = b % 1024, swz = sb ^ (((sb >> 9) & 1) << 5); R = (st >> 1) * 16 + swz / 64; C = (st & 1) * 32 + (swz % 64) / 2; }
__host__ __device__ __forceinline__ int perm32(int rho) { const int n = rho >> 4, i = rho & 15; return 8 * (i >> 2) + 4 * n + (i & 3); }

struct GUnit { const char* A; const char* B; int nt, x0, x1, x2, x3; };
template <class E, class = void> struct HasSeg { static constexpr bool v = false; };
template <class E> struct HasSeg<E, decltype((void)E::SEG2)> { static constexpr bool v = E::SEG2; };
template <class S, class = void> struct SchedKstep { static constexpr int v = 128; };
template <class S> struct SchedKstep<S, decltype((void)S::KSTEP)> { static constexpr int v = S::KSTEP; };
template <class S, class = void> struct SchedKstepB { static constexpr int v = SchedKstep<S>::v; };
template <class S> struct SchedKstepB<S, decltype((void)S::KSTEP_B)> { static constexpr int v = S::KSTEP_B; };
template <class E, class = void> struct HasP16 { static constexpr bool v = false; };
template <class E> struct HasP16<E, decltype((void)E::PERM16)> { static constexpr bool v = E::PERM16; };

struct RectOrder {
    int nM, nN, nwg, G, c;
    __device__ __forceinline__ void init(int nM_, int nN_, int G_, int c_) { nM = nM_; nN = nN_; nwg = nM * nN; G = G_; c = c_; }
    __device__ __forceinline__ bool get(int i, int& pm, int& pn) const {
        const long L = (long)i * G + c; if (L >= nwg) return false;
        int wgid = (int)L; { const int q = nwg / NXCD, r = nwg % NXCD, xcd = wgid % NXCD, off = wgid / NXCD; wgid = (xcd < r ? xcd * (q + 1) : r * (q + 1) + (xcd - r) * q) + off; }
        const int nig = WGM * nN, gid = wgid / nig, fm = gid * WGM, gsz = (nM - fm) < WGM ? (nM - fm) : WGM;
        pm = fm + ((wgid % nig) % gsz); pn = (wgid % nig) / gsz; return true;
    }
};

template <class Epi, class Sched, bool ALIGN_EPI = true, bool F8 = false>
__device__ __forceinline__ void gemm_phase(PG8_LAS unsigned char* lds, const Sched& S, const Epi& E) {
    const int tid = threadIdx.x, wid = __builtin_amdgcn_readfirstlane(tid >> 6), lane = tid & 63, wr = wid >> 2, wc = wid & 3, fr = lane & 15, fq = lane >> 4;
    int Rs[2], Cs[2];
#pragma unroll
    for (int i = 0; i < 2; ++i) stage_rc(tid * 16 + i * 8192, Rs[i], Cs[i]);
    unsigned voffB[2][2], voffA[2][2], voffAn[2][2];
#pragma unroll
    for (int h = 0; h < 2; ++h)
#pragma unroll
        for (int i = 0; i < 2; ++i) {
            if constexpr (HasP16<Epi>::v) { const int r = Rs[i]; voffB[h][i] = S.b_off(64 * (r >> 5) + 16 * ((r & 15) >> 2) + 8 * h + 4 * ((r >> 4) & 1) + (r & 3), Cs[i]); }
            else { const int Rb = Epi::PERM ? ((Rs[i] & ~31) + perm32(Rs[i] & 31)) : Rs[i]; voffB[h][i] = S.b_off(h * HALF + Rb, Cs[i]); } }
    const size_t kstep = (size_t)SchedKstep<Sched>::v, kstepB = (size_t)SchedKstepB<Sched>::v;
    const unsigned ldsw = (unsigned)wid * 1024u;
    const int aoff = lds_byte(wr * 64 + fr, fq * 8), boff = lds_byte(wc * 32 + fr, fq * 8);
#define PG8_SA(b, h) (((b) * 2 + (h)) * HTB)
#define PG8_SB(b, h) ((4 + (b) * 2 + (h)) * HTB)
#define PG8_STAGE(bufoff, gbase, voff) do { _Pragma("unroll") for (int _i = 0; _i < 2; ++_i) \
        __builtin_amdgcn_global_load_lds((const unsigned*)((const char*)(gbase) + (voff)[_i]), (PG8_LAS unsigned*)(lds + (bufoff) + ldsw + _i * 8192), 16, 0, 0); } while (0)
#define PG8_LDA(dst, b, h) do { if constexpr (F8) { _Pragma("unroll") for (int m = 0; m < 4; ++m) dst##8[m] = __builtin_shufflevector(*(const PG8_LAS i32x4*)(lds + PG8_SA(b, h) + aoff + m * 2048), *(const PG8_LAS i32x4*)(lds + PG8_SA(b, h) + aoff + m * 2048 + 1024), 0, 1, 2, 3, 4, 5, 6, 7); } \
        else { _Pragma("unroll") for (int m = 0; m < 4; ++m) _Pragma("unroll") for (int k = 0; k < 2; ++k) dst[m][k] = *(const PG8_LAS bf16x8*)(lds + PG8_SA(b, h) + aoff + m * 2048 + k * 1024); } } while (0)
#define PG8_LDB(dst, b, h) do { if constexpr (F8) { _Pragma("unroll") for (int n = 0; n < 2; ++n) dst##8[n] = __builtin_shufflevector(*(const PG8_LAS i32x4*)(lds + PG8_SB(b, h) + boff + n * 2048), *(const PG8_LAS i32x4*)(lds + PG8_SB(b, h) + boff + n * 2048 + 1024), 0, 1, 2, 3, 4, 5, 6, 7); } \
        else { _Pragma("unroll") for (int n = 0; n < 2; ++n) _Pragma("unroll") for (int k = 0; k < 2; ++k) dst[n][k] = *(const PG8_LAS bf16x8*)(lds + PG8_SB(b, h) + boff + n * 2048 + k * 1024); } } while (0)
#define PG8_MMA(ai, bj, At, Bt) do { __builtin_amdgcn_s_setprio(1); _Pragma("unroll") for (int m = 0; m < 4; ++m) _Pragma("unroll") for (int n = 0; n < 2; ++n) { \
        if constexpr (F8) { asm volatile("v_mfma_scale_f32_16x16x128_f8f6f4 %0, %1, %2, %0, %3, %3 op_sel_hi:[0,0,0]" : "+v"(acc[ai][bj][m][n]) : "v"(Bt##8[n]), "v"(At##8[m]), "v"(f8scale)); } \
        else { _Pragma("unroll") for (int k = 0; k < 2; ++k) acc[ai][bj][m][n] = __builtin_amdgcn_mfma_f32_16x16x32_bf16(Bt[n][k], At[m][k], acc[ai][bj][m][n], 0, 0, 0); } } \
        if constexpr (F8) asm volatile("s_nop 3" ::: "memory");     \
        __builtin_amdgcn_s_setprio(0); } while (0)
#define PG8_WAIT_V(n) asm volatile("s_waitcnt vmcnt(" #n ")" ::: "memory")
#define PG8_WAIT_L(n) asm volatile("s_waitcnt lgkmcnt(" #n ")" ::: "memory")
#define PG8_BAR __builtin_amdgcn_s_barrier()
#define PG8_SCHED __builtin_amdgcn_sched_barrier(0)
    GUnit cur, nxt; int ui = 0;
    if (!S.next(0, cur)) return;
    S.a_off(cur, Rs, Cs, voffA);
#pragma unroll
    for (int h = 0; h < 2; ++h)
#pragma unroll
        for (int i = 0; i < 2; ++i) voffAn[h][i] = voffA[h][i];
    f32x4 acc[2][2][4][2];
#pragma unroll
    for (int a = 0; a < 2; ++a)
#pragma unroll
        for (int b = 0; b < 2; ++b)
#pragma unroll
            for (int m = 0; m < 4; ++m)
#pragma unroll
                for (int n = 0; n < 2; ++n) acc[a][b][m][n] = (f32x4){0.f, 0.f, 0.f, 0.f};
    bf16x8 At[4][2], B0[2][2], B1[2][2]; i32x8 At8[4], B08[2], B18[2];
    const int f8scale = 0x7F7F7F7F;
    const char* cA = cur.A; const char* cB = cur.B;
    PG8_STAGE(PG8_SB(0, 0), cB, voffB[0]); PG8_STAGE(PG8_SB(0, 1), cB, voffB[1]); PG8_STAGE(PG8_SA(0, 0), cA, voffA[0]); PG8_STAGE(PG8_SA(0, 1), cA, voffA[1]);
    if (wr == 1) PG8_BAR;
    PG8_WAIT_V(2); PG8_BAR;
    PG8_STAGE(PG8_SB(1, 0), cB + kstepB, voffB[0]); PG8_STAGE(PG8_SA(1, 0), cA + kstep, voffA[0]); PG8_STAGE(PG8_SB(1, 1), cB + kstepB, voffB[1]);
    PG8_WAIT_V(6); PG8_BAR;
    for (;;) {
        const bool has_next = S.next(ui + 1, nxt);
        const char* nA = has_next ? nxt.A : cA; const char* nB = has_next ? nxt.B : cB;
        const int nt = cur.nt;
#pragma unroll 1
        for (int t = 0; t < nt; t += 2) {
            const bool last = (t == nt - 2);
            if constexpr (Sched::GATHER) { if (last && has_next) S.a_off(nxt, Rs, Cs, voffAn); }
            const char* a1 = cA + (size_t)(t + 1) * kstep;
            const char* a2 = last ? nA : cA + (size_t)(t + 2) * kstep; const char* b2 = last ? nB : cB + (size_t)(t + 2) * kstepB;
            const char* a3 = a2 + kstep; const char* b3 = b2 + kstepB;
            unsigned vA2[2][2];
#pragma unroll
            for (int h = 0; h < 2; ++h)
#pragma unroll
                for (int i = 0; i < 2; ++i) { if constexpr (Sched::GATHER) vA2[h][i] = (last && has_next) ? voffAn[h][i] : voffA[h][i]; else vA2[h][i] = voffA[h][i]; }
            PG8_LDB(B0, 0, 0); PG8_LDB(B1, 0, 1); PG8_SCHED; PG8_LDA(At, 0, 0); PG8_STAGE(PG8_SA(1, 1), a1, voffA[1]);
            PG8_WAIT_V(8); PG8_WAIT_L(0); PG8_BAR; PG8_MMA(0, 0, At, B0); PG8_MMA(0, 1, At, B1); PG8_BAR; PG8_SCHED;
            PG8_LDA(At, 0, 1); PG8_STAGE(PG8_SB(0, 0), b2, voffB[0]); PG8_STAGE(PG8_SB(0, 1), b2, voffB[1]); PG8_STAGE(PG8_SA(0, 0), a2, vA2[0]);
            PG8_WAIT_V(8); PG8_WAIT_L(0); PG8_BAR; PG8_MMA(1, 0, At, B0); PG8_MMA(1, 1, At, B1); PG8_BAR; PG8_SCHED;
            PG8_LDB(B0, 1, 0); PG8_LDB(B1, 1, 1); PG8_SCHED; PG8_LDA(At, 1, 0); PG8_STAGE(PG8_SA(0, 1), a2, vA2[1]);
            PG8_WAIT_V(8); PG8_WAIT_L(0); PG8_BAR; PG8_MMA(0, 0, At, B0); PG8_MMA(0, 1, At, B1); PG8_BAR; PG8_SCHED;
            PG8_LDA(At, 1, 1); PG8_STAGE(PG8_SB(1, 0), b3, voffB[0]); PG8_STAGE(PG8_SB(1, 1), b3, voffB[1]); PG8_STAGE(PG8_SA(1, 0), a3, vA2[0]);
            PG8_WAIT_V(8); PG8_WAIT_L(0); PG8_BAR; PG8_MMA(1, 0, At, B0); PG8_MMA(1, 1, At, B1); PG8_BAR; PG8_SCHED;
        }
        if constexpr (ALIGN_EPI) { if (wr == 0) PG8_BAR; }
        if constexpr (F8) {
#pragma unroll
            for (int a = 0; a < 2; ++a)
#pragma unroll
                for (int b = 0; b < 2; ++b)
                    asm volatile("s_nop 15\n\ts_nop 7" : "+v"(acc[a][b][0][0]), "+v"(acc[a][b][0][1]), "+v"(acc[a][b][1][0]), "+v"(acc[a][b][1][1]), "+v"(acc[a][b][2][0]), "+v"(acc[a][b][2][1]), "+v"(acc[a][b][3][0]), "+v"(acc[a][b][3][1]));
        }
        E(acc, cur, wr, wc, fr, fq);
        if (!has_next) break;
        if (!(HasSeg<Epi>::v && cur.x2 == 0)) {
#pragma unroll
        for (int a = 0; a < 2; ++a)
#pragma unroll
            for (int b = 0; b < 2; ++b)
#pragma unroll
                for (int m = 0; m < 4; ++m)
#pragma unroll
                    for (int n = 0; n < 2; ++n) acc[a][b][m][n] = (f32x4){0.f, 0.f, 0.f, 0.f};
        }
        cur = nxt; cA = nA; cB = nB; ++ui;
#pragma unroll
        for (int h = 0; h < 2; ++h)
#pragma unroll
            for (int i = 0; i < 2; ++i) voffA[h][i] = voffAn[h][i];
        if constexpr (ALIGN_EPI) { if (wr == 1) PG8_BAR; }
    }
    PG8_WAIT_V(0);
    if constexpr (!ALIGN_EPI) { if (wr == 0) PG8_BAR; }
    PG8_BAR;
#undef PG8_SA
#undef PG8_SB
#undef PG8_STAGE
#undef PG8_LDA
#undef PG8_LDB
#undef PG8_MMA
#undef PG8_WAIT_V
#undef PG8_WAIT_L
#undef PG8_BAR
#undef PG8_SCHED
}
}
using pg8::GUnit;
typedef const f32x4 (&AccRef)[2][2][4][2];


struct SchedRect {
    static constexpr bool GATHER = false;
    pg8::RectOrder o; const char* A; const char* B; int lda, ldb, nt;
    __device__ __forceinline__ bool next(int i, GUnit& u) const { int pm, pn; if (!o.get(i, pm, pn)) return false;
        u.A = A + (size_t)pm * 256 * lda * 2; u.B = B + (size_t)pn * 256 * ldb * 2; u.nt = nt; u.x0 = pm; u.x1 = pn; u.x2 = 0; u.x3 = 0; return true; }
    __device__ __forceinline__ unsigned b_off(int R, int C) const { return (unsigned)(R * ldb + C) * 2u; }
    __device__ __forceinline__ void a_off(const GUnit&, const int (&R)[2], const int (&C)[2], unsigned (&v)[2][2]) const {
#pragma unroll
        for (int h = 0; h < 2; ++h)
#pragma unroll
            for (int i = 0; i < 2; ++i) v[h][i] = (unsigned)((h * 128 + R[i]) * lda + C[i]) * 2u; }
};
__host__ __device__ __forceinline__ size_t tiled_off(size_t r, int kb, int ktiles) { return (((r >> 8) * ktiles + (kb >> 7)) << 15) + ((r & 255) << 7) + (kb & 127); }
struct SchedTiled {
    static constexpr bool GATHER = false; static constexpr int KSTEP = 32768;
    pg8::RectOrder o; const char* A; const char* B; int nt;
    __device__ __forceinline__ bool next(int i, GUnit& u) const { int pm, pn; if (!o.get(i, pm, pn)) return false;
        u.A = A + ((size_t)pm * nt << 15); u.B = B + ((size_t)pn * nt << 15); u.nt = nt; u.x0 = pm; u.x1 = pn; u.x2 = 0; u.x3 = 0; return true; }
    __device__ __forceinline__ unsigned b_off(int R, int C) const { return (unsigned)(R * 128 + C * 2); }
    __device__ __forceinline__ void a_off(const GUnit&, const int (&R)[2], const int (&C)[2], unsigned (&v)[2][2]) const {
#pragma unroll
        for (int h = 0; h < 2; ++h)
#pragma unroll
            for (int i = 0; i < 2; ++i) v[h][i] = (unsigned)((h * 128 + R[i]) * 128 + C[i] * 2); }
};
struct SchedRectOff {
    static constexpr bool GATHER = false;
    pg8::RectOrder o; const char* A; const char* B; int lda, ldb, nt, pn0;
    __device__ __forceinline__ bool next(int i, GUnit& u) const { int pm, pn; if (!o.get(i, pm, pn)) return false;
        u.A = A + (size_t)pm * 256 * lda * 2; u.B = B + (size_t)pn * 256 * ldb * 2; u.nt = nt; u.x0 = pm; u.x1 = pn + pn0; u.x2 = 0; u.x3 = 0; return true; }
    __device__ __forceinline__ unsigned b_off(int R, int C) const { return (unsigned)(R * ldb + C) * 2u; }
    __device__ __forceinline__ void a_off(const GUnit&, const int (&R)[2], const int (&C)[2], unsigned (&v)[2][2]) const {
#pragma unroll
        for (int h = 0; h < 2; ++h)
#pragma unroll
            for (int i = 0; i < 2; ++i) v[h][i] = (unsigned)((h * 128 + R[i]) * lda + C[i]) * 2u; }
};
struct SchedMerge {
    static constexpr bool GATHER = false; static constexpr int KT = (SW + FW) / 128, KSTEP = 32768;
    pg8::RectOrder o; const char* A; const char* B;
    __device__ __forceinline__ bool next(int i, GUnit& u) const { int pm, pn; if (!o.get(i >> 1, pm, pn)) return false; const int seg = i & 1;
        u.A = A + ((size_t)(pm * KT + seg * (SW / 128)) << 15); u.B = B + ((size_t)(pn * KT + seg * (SW / 128)) << 15); u.nt = seg ? FW / 128 : SW / 128; u.x0 = pm; u.x1 = pn; u.x2 = seg; u.x3 = 0; return true; }
    __device__ __forceinline__ unsigned b_off(int R, int C) const { return (unsigned)(R * 128 + C * 2); }
    __device__ __forceinline__ void a_off(const GUnit&, const int (&R)[2], const int (&C)[2], unsigned (&v)[2][2]) const {
#pragma unroll
        for (int h = 0; h < 2; ++h)
#pragma unroll
            for (int i = 0; i < 2; ++i) v[h][i] = (unsigned)((h * 128 + R[i]) * 128 + C[i] * 2); }
};
struct SchedE {
    static constexpr bool GATHER = false;
    int G, c; const char* A2; const char* WeT;
    __device__ __forceinline__ bool next(int i, GUnit& u) const { const int L = i * G + c; if (L >= 128) return false; const int g = L >> 2, b = L & 3;
        u.A = A2 + ((size_t)((g * 4 + b) * NCH + NCTXCH) * A2LD) * 2; u.B = WeT + (size_t)g * 256 * 512 * 2; u.nt = 8; u.x0 = g; u.x1 = b; u.x2 = 0; u.x3 = 0; return true; }
    __device__ __forceinline__ unsigned b_off(int R, int C) const { return (unsigned)(R * 512 + C) * 2u; }
    __device__ __forceinline__ void a_off(const GUnit&, const int (&R)[2], const int (&C)[2], unsigned (&v)[2][2]) const {
#pragma unroll
        for (int h = 0; h < 2; ++h)
#pragma unroll
            for (int i = 0; i < 2; ++i) v[h][i] = (unsigned)((h * 128 + R[i]) * A2LD + C[i]) * 2u; }
};
struct SchedSSM {
    static constexpr bool GATHER = false;
    int G, c; const char* A2; const char* TV;
    __device__ __forceinline__ bool next(int i, GUnit& u) const { const int L = i * G + c; if (L >= 256) return false; const int g = L >> 3, b = (L >> 1) & 3, pn = L & 1;
        u.A = A2 + ((size_t)((g * 4 + b) * NCH + NCTXCH) * A2LD) * 2; u.B = TV + ((size_t)(g * 512 + pn * 256) * A2LD) * 2; u.nt = 12; u.x0 = g; u.x1 = b; u.x2 = pn; u.x3 = 0; return true; }
    __device__ __forceinline__ unsigned b_off(int R, int C) const { return (unsigned)(R * A2LD + C) * 2u; }
    __device__ __forceinline__ void a_off(const GUnit&, const int (&R)[2], const int (&C)[2], unsigned (&v)[2][2]) const {
#pragma unroll
        for (int h = 0; h < 2; ++h)
#pragma unroll
            for (int i = 0; i < 2; ++i) v[h][i] = (unsigned)((h * 128 + R[i]) * A2LD + C[i]) * 2u; }
};
struct SchedF1 {
    static constexpr bool GATHER = false;
    int G, c; const char* FkT; const char* UF;
    __device__ __forceinline__ bool next(int i, GUnit& u) const { const int L = i * G + c; if (L >= 1024) return false; const int pn = L >> 1, pm = L & 1;
        u.A = FkT + (size_t)pm * 256 * 256 * 2; u.B = UF + (size_t)pn * 64 * FW * 2; u.nt = 4; u.x0 = pm; u.x1 = pn; u.x2 = 0; u.x3 = 0; return true; }
    __device__ __forceinline__ unsigned b_off(int R, int C) const { const int g = R >> 6, cc = R & 63; return (unsigned)(cc * FW + g * 256 + C) * 2u; }
    __device__ __forceinline__ void a_off(const GUnit&, const int (&R)[2], const int (&C)[2], unsigned (&v)[2][2]) const {
#pragma unroll
        for (int h = 0; h < 2; ++h)
#pragma unroll
            for (int i = 0; i < 2; ++i) v[h][i] = (unsigned)((h * 128 + R[i]) * 256 + C[i]) * 2u; }
};
struct SchedF2 {
    static constexpr bool GATHER = false;
    int G, c; const char* FcT; const char* Z1T;
    __device__ __forceinline__ bool next(int i, GUnit& u) const { const int L = i * G + c; if (L >= 2048) return false; const int b = L >> 9, g = (L >> 7) & 3, kp = L & 127;
        u.A = FcT; u.B = Z1T + ((size_t)((b * 128) * 4 + g) * 256 + 2 * kp) * 128 * 2; u.nt = 2; u.x0 = b; u.x1 = g; u.x2 = 2 * kp; u.x3 = 0; return true; }
    __device__ __forceinline__ unsigned b_off(int R, int C) const { const int dk = R >> 7, r = R & 127; return (unsigned)(r * (4 * 256 * 128) + dk * 128 + C) * 2u; }
    __device__ __forceinline__ void a_off(const GUnit&, const int (&R)[2], const int (&C)[2], unsigned (&v)[2][2]) const {
#pragma unroll
        for (int h = 0; h < 2; ++h)
#pragma unroll
            for (int i = 0; i < 2; ++i) v[h][i] = (unsigned)((h * 128 + R[i]) * 128 + C[i]) * 2u; }
};
struct SchedF3 {
    static constexpr bool GATHER = false;
    int G, c; const char* FrT; const char* Z2T;
    __device__ __forceinline__ bool next(int i, GUnit& u) const { const int L = i * G + c; if (L >= 1024) return false; const int b = L >> 8, cp = (L >> 2) & 63, g = L & 3;
        u.A = FrT; u.B = Z2T + ((size_t)((b * 4 + g) * 256) * 64 + cp) * 256 * 2; u.nt = 4; u.x0 = b; u.x1 = cp; u.x2 = g; u.x3 = 0; return true; }
    __device__ __forceinline__ unsigned b_off(int R, int C) const { return (unsigned)(R * (64 * 256) + C) * 2u; }
    __device__ __forceinline__ void a_off(const GUnit&, const int (&R)[2], const int (&C)[2], unsigned (&v)[2][2]) const {
#pragma unroll
        for (int h = 0; h < 2; ++h)
#pragma unroll
            for (int i = 0; i < 2; ++i) v[h][i] = (unsigned)((h * 128 + R[i]) * 256 + C[i]) * 2u; }
};
template <int SHIFT, int PA, int PB, int NT> struct SchedMoe {
    static constexpr bool GATHER = true; static constexpr int KSTEP_B = 32768;
    int G, c; const char* Abase; const char* Bbase; const int* rowlist; const LAS int* pre; const LAS int* cnt;
    __device__ __forceinline__ bool next(int i, GUnit& u) const { const int L = i * G + c; const int ti = L >> 3, ct = L & 7; if (ti >= __builtin_amdgcn_readfirstlane(pre[NE])) return false;
        int e = 0;
#pragma unroll 1
        for (int s = 16; s >= 1; s >>= 1) if (pre[e + s] <= ti) e += s;
        e = __builtin_amdgcn_readfirstlane(e);
        u.A = Abase; u.B = Bbase + ((size_t)((e * 8 + ct) * NT) << 15); u.nt = NT; u.x0 = e; u.x1 = ti - __builtin_amdgcn_readfirstlane(pre[e]); u.x2 = ct; u.x3 = __builtin_amdgcn_readfirstlane(cnt[e]); return true; }
    __device__ __forceinline__ unsigned b_off(int R, int C) const { return (unsigned)(R * 128 + C * 2); }
    __device__ __forceinline__ void a_off(const GUnit& u, const int (&R)[2], const int (&C)[2], unsigned (&v)[2][2]) const {
        const int* rl = rowlist + (size_t)u.x0 * ECAP; const int base = u.x1 * 256, cm = u.x3 - 1;
#pragma unroll
        for (int h = 0; h < 2; ++h)
#pragma unroll
            for (int i = 0; i < 2; ++i) { int p = base + h * 128 + R[i]; p = p < cm ? p : cm; const unsigned ent = (unsigned)rl[p]; v[h][i] = (ent >> SHIFT) * (unsigned)PA + (unsigned)C[i] * 2u; } }
};

struct SchedMoeDown {
    static constexpr bool GATHER = false; static constexpr int KSTEP = 32768, NT = DE / 128;
    int G, c; const char* Abase; const char* Bbase; const LAS int* pre; const LAS int* cnt;
    __device__ __forceinline__ bool next(int i, GUnit& u) const { const int L = i * G + c; const int ti = L >> 3, ct = L & 7; if (ti >= __builtin_amdgcn_readfirstlane(pre[NE])) return false;
        int e = 0;
#pragma unroll 1
        for (int s = 16; s >= 1; s >>= 1) if (pre[e + s] <= ti) e += s;
        e = __builtin_amdgcn_readfirstlane(e);
        u.A = Abase + ((size_t)(ti * NT) << 15); u.B = Bbase + ((size_t)((e * 8 + ct) * NT) << 15); u.nt = NT; u.x0 = e; u.x1 = ti - __builtin_amdgcn_readfirstlane(pre[e]); u.x2 = ct; u.x3 = __builtin_amdgcn_readfirstlane(cnt[e]); return true; }
    __device__ __forceinline__ unsigned b_off(int R, int C) const { return (unsigned)(R * 128 + C * 2); }
    __device__ __forceinline__ void a_off(const GUnit&, const int (&R)[2], const int (&C)[2], unsigned (&v)[2][2]) const {
#pragma unroll
        for (int h = 0; h < 2; ++h)
#pragma unroll
            for (int i = 0; i < 2; ++i) v[h][i] = (unsigned)((h * 128 + R[i]) * 128 + C[i] * 2); }
};

template <bool S8> struct EpiInProjT {
    static constexpr bool PERM = true, PERM16 = true;
    bf16* UF; bf16* A2; bf16* GZF; bf16* GZS;
    __device__ __forceinline__ void operator()(AccRef acc, const GUnit& u, int wr, int wc, int fr, int fq) const {
        const int pm = u.x0, pn = u.x1; const int col = pn * 256 + wc * 64 + 16 * fq;
#pragma unroll
        for (int ai = 0; ai < 2; ++ai)
#pragma unroll
            for (int m = 0; m < 4; ++m) { const int row = pm * 256 + ai * 128 + wr * 64 + m * 16 + fr; bf16* dst;
                if (pn < 4) dst = UF + (size_t)row * FW + col;
                else { const int g = (col - FW) >> 4, b = row >> 13, t = row & (SEQ - 1); dst = A2 + ((size_t)((g * 4 + b) * NCH + NCTXCH + (t >> 5)) * A2LD + (t & 31) * 16); }
                constexpr float SC = S8 ? W8_INV : 1.0f; st16_bf16(dst, acc[ai][0][m][0] * SC, acc[ai][0][m][1] * SC, acc[ai][1][m][0] * SC, acc[ai][1][m][1] * SC); }
    }
};
typedef EpiInProjT<false> EpiInProj;
struct EpiGates8 {
    static constexpr bool PERM = true, PERM16 = true;
    unsigned char* GZF; unsigned char* GZS;
    __device__ __forceinline__ void operator()(AccRef acc, const GUnit& u, int wr, int wc, int fr, int fq) const {
        const int pm = u.x0, pn = u.x1; unsigned char* base = (pn < 8 ? GZF : GZS) + (size_t)(pm * 256 + wr * 64 + fr) * D + (pn & 7) * 256 + wc * 64 + 16 * fq;
#pragma unroll
        for (int ai = 0; ai < 2; ++ai)
#pragma unroll
            for (int m = 0; m < 4; ++m) { u32x4 w;
#pragma unroll
                for (int bj = 0; bj < 2; ++bj)
#pragma unroll
                    for (int n = 0; n < 2; ++n) { const f32x4 v = acc[ai][bj][m][n]; w[bj * 2 + n] = pk4_u8(fsigmoid(v[0] * W8_INV), fsigmoid(v[1] * W8_INV), fsigmoid(v[2] * W8_INV), fsigmoid(v[3] * W8_INV)); }
                *(u32x4*)(base + (size_t)(ai * 128 + m * 16) * D) = w; }
    }
};
struct EpiE {
    static constexpr bool PERM = false;
    float* E;
    __device__ __forceinline__ void operator()(AccRef acc, const GUnit& u, int wr, int wc, int fr, int fq) const {
        float* base = E + (size_t)((u.x0 * 4 + u.x1) * NCH + NCTXCH) * 256;
#pragma unroll
        for (int ai = 0; ai < 2; ++ai)
#pragma unroll
            for (int m = 0; m < 4; ++m) { float* rowp = base + (size_t)(ai * 128 + wr * 64 + m * 16 + fr) * 256 + wc * 32 + 4 * fq;
#pragma unroll
                for (int bj = 0; bj < 2; ++bj)
#pragma unroll
                    for (int n = 0; n < 2; ++n) *(f32x4*)(rowp + bj * 128 + n * 16) = acc[ai][bj][m][n]; }
    }
};
struct EpiSSM {
    static constexpr bool PERM = true, PERM16 = true;
    bf16* YS;
    __device__ __forceinline__ void operator()(AccRef acc, const GUnit& u, int wr, int wc, int fr, int fq) const {
        const int g = u.x0, b = u.x1, pn = u.x2; const int tt = (pn * 256 + wc * 64 + 16 * fq) >> 4;
#pragma unroll
        for (int ai = 0; ai < 2; ++ai)
#pragma unroll
            for (int m = 0; m < 4; ++m) { const int ch = ai * 128 + wr * 64 + m * 16 + fr; const size_t tok = (size_t)b * SEQ + ch * LC + tt;
                f32x4 v0 = acc[ai][0][m][0], v1 = acc[ai][0][m][1], v2 = acc[ai][1][m][0], v3 = acc[ai][1][m][1];
#pragma unroll
                for (int j = 0; j < 4; ++j) { v0[j] = gelu_tanh(v0[j]); v1[j] = gelu_tanh(v1[j]); v2[j] = gelu_tanh(v2[j]); v3[j] = gelu_tanh(v3[j]); }
                st16_bf16(YS + tok * SW + g * 16, v0, v1, v2, v3); }
    }
};
constexpr float S8_SCALE = 16.0f, S8_INV = 1.0f / 16.0f;
template <int MODE> struct EpiGate {
    static constexpr bool PERM = true, PERM16 = true; static constexpr float ASC = MODE == 0 ? W8_INV / 255.0f : (MODE == 1 ? W8_INV * S8_INV / 255.0f : 1.0f);
    bf16* O; const void* G0; const float* bias; int ld; unsigned char* O8; int ldo;
    __device__ __forceinline__ void operator()(AccRef acc, const GUnit& u, int wr, int wc, int fr, int fq) const {
        const int pm = u.x0, pn = u.x1;
        const size_t off0 = (size_t)(pm * 256 + wr * 64 + fr) * ld + pn * 256 + wc * 64 + 16 * fq;
        f32x4 bv[2][2];
        if (MODE == 2) {
#pragma unroll
            for (int q = 0; q < 4; ++q) bv[q >> 1][q & 1] = *(const f32x4*)(bias + pn * 256 + wc * 64 + 16 * fq + 4 * q); }
#pragma unroll
        for (int ai = 0; ai < 2; ++ai) {
            u32x4 gq[4], yq[4][2], oq[4][2];
#pragma unroll
            for (int m = 0; m < 4; ++m) { const size_t off = off0 + (size_t)(ai * 128 + m * 16) * ld;
                if (MODE == 2) { yq[m][0] = *(const u32x4*)((const bf16*)G0 + off); yq[m][1] = *(const u32x4*)((const bf16*)G0 + off + 8); }
                else gq[m] = __builtin_nontemporal_load((const u32x4*)((const unsigned char*)G0 + off));
                if (MODE == 1) { oq[m][0] = *(const u32x4*)(O + off); oq[m][1] = *(const u32x4*)(O + off + 8); } }
#pragma unroll
            for (int m = 0; m < 4; ++m) { const size_t off = off0 + (size_t)(ai * 128 + m * 16) * ld;
                f32x4 v[2][2];
#pragma unroll
                for (int bj = 0; bj < 2; ++bj)
#pragma unroll
                    for (int n = 0; n < 2; ++n) { const int q = bj * 2 + n; const f32x4 a = acc[ai][bj][m][n];
                        if (MODE == 2) { const unsigned lo = yq[m][bj][2 * n], hi = yq[m][bj][2 * n + 1]; const f32x4 y = (f32x4){bf_lo(lo), bf_hi(lo), bf_lo(hi), bf_hi(hi)};
#pragma unroll
                            for (int j = 0; j < 4; ++j) v[bj][n][j] = y[j] * fsigmoid(a[j] + bv[bj][n][j]) * S8_SCALE; }
                        else { const f32x4 g = u8x4_f32(gq[m][q]);
                            if (MODE == 0) v[bj][n] = a * g * ASC;
                            else { const unsigned lo = oq[m][bj][2 * n], hi = oq[m][bj][2 * n + 1]; v[bj][n] = (f32x4){bf_lo(lo), bf_hi(lo), bf_lo(hi), bf_hi(hi)} + a * g * ASC; } } }
                if (MODE == 0) {
#pragma unroll
                    for (int bj = 0; bj < 2; ++bj) { u32x4 w; w.x = pk_bf16(v[bj][0][0], v[bj][0][1]); w.y = pk_bf16(v[bj][0][2], v[bj][0][3]); w.z = pk_bf16(v[bj][1][0], v[bj][1][1]); w.w = pk_bf16(v[bj][1][2], v[bj][1][3]); *(u32x4*)(O + off + 8 * bj) = w; } }
                else { u32x4 w;
#pragma unroll
                    for (int q = 0; q < 4; ++q) w[q] = pk4_fp8(v[q >> 1][q & 1][0], v[q >> 1][q & 1][1], v[q >> 1][q & 1][2], v[q >> 1][q & 1][3]);
                    const size_t offo = MODE == 2 ? tiled_off((size_t)(pm * 256 + wr * 64 + fr + ai * 128 + m * 16), pn * 256 + wc * 64 + 16 * fq, ldo) : off;
                    *(u32x4*)(O8 + offo) = w; } }
            asm volatile("" ::: "memory");
        }
    }
};
struct EpiMerge {
    static constexpr bool PERM = true, PERM16 = true, SEG2 = true;
    unsigned char* M8; const unsigned char* GZF; const unsigned char* GZS;
    __device__ __forceinline__ void operator()(f32x4 (&acc)[2][2][4][2], const GUnit& u, int wr, int wc, int fr, int fq) const {
        const size_t off0 = (size_t)(u.x0 * 256 + wr * 64 + fr) * D + u.x1 * 256 + wc * 64 + 16 * fq;
        if (u.x2 == 0) {
#pragma unroll
            for (int ai = 0; ai < 2; ++ai) {
                u32x4 qs[4], qf[4];
#pragma unroll
                for (int m = 0; m < 4; ++m) { const size_t off = off0 + (size_t)(ai * 128 + m * 16) * D; qs[m] = __builtin_nontemporal_load((const u32x4*)(GZS + off)); qf[m] = *(const u32x4*)(GZF + off); }
#pragma unroll
                for (int m = 0; m < 4; ++m)
#pragma unroll
                    for (int q = 0; q < 4; ++q) { const f32x4 s = u8x4_f32(qs[m][q]), f = u8x4_f32(qf[m][q]); f32x4 r;
#pragma unroll
                        for (int j = 0; j < 4; ++j) r[j] = s[j] * S8_INV * __builtin_amdgcn_rcpf(fmaxf(f[j], 0.5f));
                        acc[ai][q >> 1][m][q & 1] *= r; }
                asm volatile("" ::: "memory");
            }
            return;
        }
#pragma unroll
        for (int ai = 0; ai < 2; ++ai) {
            u32x4 qf[4];
#pragma unroll
            for (int m = 0; m < 4; ++m) qf[m] = __builtin_nontemporal_load((const u32x4*)(GZF + off0 + (size_t)(ai * 128 + m * 16) * D));
#pragma unroll
            for (int m = 0; m < 4; ++m) { u32x4 w;
#pragma unroll
                for (int q = 0; q < 4; ++q) { const f32x4 f = u8x4_f32(qf[m][q]); const f32x4 a = acc[ai][q >> 1][m][q & 1]; f32x4 v;
#pragma unroll
                    for (int j = 0; j < 4; ++j) v[j] = a[j] * (fmaxf(f[j], 0.5f) * (W8_INV / 255.0f));
                    w[q] = pk4_fp8(v[0], v[1], v[2], v[3]); }
                *(u32x4*)(M8 + tiled_off((size_t)(u.x0 * 256 + wr * 64 + fr + ai * 128 + m * 16), u.x1 * 256 + wc * 64 + 16 * fq, D / 128)) = w; }
            asm volatile("" ::: "memory");
        }
    }
};
constexpr float MG8_SCALE = 16.0f, MG8_INV = 1.0f / 16.0f;
struct EpiOut {
    static constexpr bool PERM = true, PERM16 = true;
    const float* modv; unsigned char* MG;
    __device__ __forceinline__ void operator()(AccRef acc, const GUnit& u, int wr, int wc, int fr, int fq) const {
        const int pm = u.x0, pn = u.x1; const float* gate = modv + (size_t)(pm >> 5) * 12288 + 2 * D;
        const int col0 = pn * 256 + wc * 64 + 16 * fq;
        f32x4 gv[4];
#pragma unroll
        for (int q = 0; q < 4; ++q) gv[q] = *(const f32x4*)(gate + col0 + 4 * q) * (W8_INV * MG8_SCALE);
#pragma unroll
        for (int ai = 0; ai < 2; ++ai)
#pragma unroll
            for (int m = 0; m < 4; ++m) { u32x4 w;
#pragma unroll
                for (int q = 0; q < 4; ++q) { const f32x4 v = acc[ai][q >> 1][m][q & 1] * gv[q]; w[q] = pk4_fp8(v[0], v[1], v[2], v[3]); }
                *(u32x4*)(MG + (size_t)(pm * 256 + ai * 128 + wr * 64 + m * 16 + fr) * D + col0) = w; }
    }
};
struct EpiF1 {
    static constexpr bool PERM = true, PERM16 = true;
    bf16* Z1T;
    __device__ __forceinline__ void operator()(AccRef acc, const GUnit& u, int wr, int wc, int fr, int fq) const {
        const int reim = u.x0, br = u.x1;
#pragma unroll
        for (int ai = 0; ai < 2; ++ai)
#pragma unroll
            for (int m = 0; m < 4; ++m) { const int kp = ai * 128 + wr * 64 + m * 16 + fr;
                st16_bf16(Z1T + ((((size_t)br * 4 + wc) * 256 + kp) * 2 + reim) * 64 + 16 * fq, acc[ai][0][m][0], acc[ai][0][m][1], acc[ai][1][m][0], acc[ai][1][m][1]); }
    }
};
struct EpiF2 {
    static constexpr bool PERM = true, PERM16 = true;
    bf16* Z2T;
    __device__ __forceinline__ void operator()(AccRef acc, const GUnit& u, int wr, int wc, int fr, int fq) const {
        const int b = u.x0, g = u.x1, k0 = u.x2; const int kp = k0 + (wc >> 1), r0 = (wc & 1) * 64 + 16 * fq;
#pragma unroll
        for (int m = 0; m < 4; ++m) { const int mm = wr * 64 + m * 16 + fr, reim = mm >> 6, cp = mm & 63;
            st16_bf16(Z2T + (((((size_t)b * 4 + g) * 256 + kp) * 64 + cp) * 2 + reim) * 128 + r0, acc[0][0][m][0], acc[0][0][m][1], acc[0][1][m][0], acc[0][1][m][1]); }
    }
};
struct EpiF3 {
    static constexpr bool PERM = true, PERM16 = true;
    unsigned char* FO;
    __device__ __forceinline__ void operator()(AccRef acc, const GUnit& u, int wr, int wc, int fr, int fq) const {
        const int b = u.x0, cp = u.x1, g = u.x2;
#pragma unroll
        for (int m = 0; m < 4; ++m) { const int rr = wr * 64 + m * 16 + fr; const size_t tok = (size_t)b * SEQ + rr * 64 + cp; u32x4 w;
#pragma unroll
            for (int q = 0; q < 4; ++q) { const f32x4 v = acc[0][q >> 1][m][q & 1]; w[q] = pk4_fp8(v[0], v[1], v[2], v[3]); }
            *(u32x4*)(FO + tiled_off(tok, SW + g * 256 + wc * 64 + 16 * fq, (SW + FW) / 128)) = w; }
    }
};
struct EpiMoe1 {
    static constexpr bool PERM = true;
    unsigned char* HID; const LAS int* pre;
    __device__ __forceinline__ void operator()(AccRef acc, const GUnit& u, int wr, int wc, int fr, int fq) const {
        const int e = u.x0, rt = u.x1, ct = u.x2, cnt = u.x3; const int p0 = rt * 256 + wr * 64 + fr;
        const int odd = fq & 1;
        unsigned char* blk = HID + ((size_t)((__builtin_amdgcn_readfirstlane(pre[e]) + rt) * (DE / 128) + ct) << 15) + (wr * 64 + fr) * 128 + wc * 32 + 16 * (fq >> 1);
#pragma unroll
        for (int ai = 0; ai < 2; ++ai)
#pragma unroll
            for (int mp = 0; mp < 4; mp += 2) {
                f32x4 v0, v1, w0, w1;
#pragma unroll
                for (int j = 0; j < 4; ++j) { const float a0 = acc[ai][0][mp][0][j] * W8_INV, a1 = acc[ai][0][mp][1][j] * W8_INV; v0[j] = a0 * fsigmoid(a0) * (acc[ai][1][mp][0][j] * W8_INV); v1[j] = a1 * fsigmoid(a1) * (acc[ai][1][mp][1][j] * W8_INV); }
#pragma unroll
                for (int j = 0; j < 4; ++j) { const float a0 = acc[ai][0][mp + 1][0][j] * W8_INV, a1 = acc[ai][0][mp + 1][1][j] * W8_INV; w0[j] = a0 * fsigmoid(a0) * (acc[ai][1][mp + 1][0][j] * W8_INV); w1[j] = a1 * fsigmoid(a1) * (acc[ai][1][mp + 1][1][j] * W8_INV); }
                const unsigned lo0 = pk4_fp8(v0[0], v0[1], v0[2], v0[3]), hi0 = pk4_fp8(v1[0], v1[1], v1[2], v1[3]), lo1 = pk4_fp8(w0[0], w0[1], w0[2], w0[3]), hi1 = pk4_fp8(w1[0], w1[1], w1[2], w1[3]);
                const auto sl = __builtin_amdgcn_permlane16_swap(lo0, lo1, false, false), sh = __builtin_amdgcn_permlane16_swap(hi0, hi1, false, false);
                const int p = p0 + ai * 128 + (mp + odd) * 16;
                if (p < cnt) *(u32x4*)(blk + (ai * 128 + (mp + odd) * 16) * 128) = (u32x4){sl[0], sh[0], sl[1], sh[1]}; }
    }
};
constexpr float Y8_SCALE = 16.0f, Y8_INV = 1.0f / 16.0f;
struct EpiMoe2 {
    static constexpr bool PERM = true, PERM16 = true;
    unsigned char* Y; const int* rowlist;
    __device__ __forceinline__ void operator()(AccRef acc, const GUnit& u, int wr, int wc, int fr, int fq) const {
        const int e = u.x0, rt = u.x1, ct = u.x2, cnt = u.x3; const int* rl = rowlist + (size_t)e * ECAP; const int p0 = rt * 256 + wr * 64 + fr;
        unsigned ent[2][4];
#pragma unroll
        for (int ai = 0; ai < 2; ++ai)
#pragma unroll
            for (int m = 0; m < 4; ++m) { int p = p0 + ai * 128 + m * 16; p = p < cnt ? p : cnt - 1; ent[ai][m] = (unsigned)rl[p]; }
#pragma unroll
        for (int ai = 0; ai < 2; ++ai)
#pragma unroll
            for (int m = 0; m < 4; ++m) { const int p = p0 + ai * 128 + m * 16;
                if (p < cnt) { u32x4 w;
#pragma unroll
                    for (int q = 0; q < 4; ++q) { const f32x4 v = acc[ai][q >> 1][m][q & 1] * (W8_INV * Y8_SCALE); w[q] = pk4_fp8(v[0], v[1], v[2], v[3]); }
                    *(u32x4*)(Y + (size_t)ent[ai][m] * D + ct * 256 + wc * 64 + 16 * fq) = w; } }
    }
};

enum { IX = 0, IC, ICTX, ICCTX, IWADA, IBADA, IWIN, IWF, ILAMRE, ILAMIM, ILOGDT, IBRE, IBIM, ICRE, ICIM, IDSKIP, IWGLU, IBGLU, IWS, IWOUT, ILN1G, ILN1B, IWGRP, IBGRP, IWEXP, IBEXP, IW1, IW3, IW2, ILN2G, ILN2B, NIN };
struct Args { const float* in[NIN]; float* out; unsigned char* ws; int ph_lo, ph_hi; };
constexpr int ARGS_OFF = MISC_OFF + 1024;
__device__ __forceinline__ unsigned long long ldp(LAS unsigned char* lds, int i) {
    const volatile LAS unsigned* p = (const volatile LAS unsigned*)(lds + ARGS_OFF) + 2 * i;
    const unsigned lo = __builtin_amdgcn_readfirstlane(p[0]), hi = __builtin_amdgcn_readfirstlane(p[1]);
    return ((unsigned long long)hi << 32) | lo;
}
#define AIN(i) ((const float*)ldp(lds, (i)))
#define AOUT ((float*)ldp(lds, NIN))
#define AWS ((unsigned char*)ldp(lds, NIN + 1))

template <int MAP>
__device__ __forceinline__ void transpose_item(const float* W, int K, int N, bf16* WT, LAS float* scr, int item, int lane) {
    const int nblk = N / 64, kb = item / nblk, nb = item % nblk, k0 = 64 * kb, n0 = 64 * nb;
    const int kr = lane >> 4, nc = (lane & 15) * 4;
    const float* src = W + (size_t)(k0 + kr) * N + n0 + nc;
    f32x4 v[16];
#pragma unroll
    for (int i = 0; i < 16; ++i) v[i] = __builtin_nontemporal_load((const f32x4*)(src + (size_t)(4 * i) * N));
#pragma unroll
    for (int i = 0; i < 16; ++i) { LAS float* d = scr + (4 * i + kr) * 65 + nc; d[0] = v[i].x; d[1] = v[i].y; d[2] = v[i].z; d[3] = v[i].w; }
    LDS_WAIT(); asm volatile("" ::: "memory");
    const int c = lane & 7;
#pragma unroll
    for (int j = 0; j < 8; ++j) { const int n = (lane >> 3) + 8 * j; const LAS float* s = scr + (8 * c) * 65 + n;
        u32x4 o; o.x = pk_bf16(s[0 * 65], s[1 * 65]); o.y = pk_bf16(s[2 * 65], s[3 * 65]); o.z = pk_bf16(s[4 * 65], s[5 * 65]); o.w = pk_bf16(s[6 * 65], s[7 * 65]);
        const int nn = n0 + n; const int row = MAP == 0 ? nn : ((nn >> 7) * 256 + (nn & 127) + (MAP == 2 ? 128 : 0));
        __builtin_nontemporal_store(o, (u32x4*)(WT + (size_t)row * K + k0 + 8 * c)); }
    LDS_WAIT(); asm volatile("" ::: "memory");
}
template <int MAP>
__device__ __forceinline__ void transpose_item_f8(const float* W, int K, int N, unsigned char* WT, LAS float* scr, int item, int lane, int pitch = 0) {
    const int nblk = N / 64, kb = item / nblk, nb = item % nblk, k0 = 64 * kb, n0 = 64 * nb;
    const int kr = lane >> 4, nc = (lane & 15) * 4;
    const float* src = W + (size_t)(k0 + kr) * N + n0 + nc;
    f32x4 v[16];
#pragma unroll
    for (int i = 0; i < 16; ++i) v[i] = __builtin_nontemporal_load((const f32x4*)(src + (size_t)(4 * i) * N));
#pragma unroll
    for (int i = 0; i < 16; ++i) { LAS float* d = scr + (4 * i + kr) * 65 + nc; d[0] = v[i].x * W8_SCALE; d[1] = v[i].y * W8_SCALE; d[2] = v[i].z * W8_SCALE; d[3] = v[i].w * W8_SCALE; }
    LDS_WAIT(); asm volatile("" ::: "memory");
    const int c = lane & 3;
#pragma unroll
    for (int j = 0; j < 4; ++j) { const int n = (lane >> 2) + 16 * j; const LAS float* s = scr + (16 * c) * 65 + n;
        u32x4 o; o.x = pk4_fp8(s[0 * 65], s[1 * 65], s[2 * 65], s[3 * 65]); o.y = pk4_fp8(s[4 * 65], s[5 * 65], s[6 * 65], s[7 * 65]);
        o.z = pk4_fp8(s[8 * 65], s[9 * 65], s[10 * 65], s[11 * 65]); o.w = pk4_fp8(s[12 * 65], s[13 * 65], s[14 * 65], s[15 * 65]);
        const int nn = n0 + n; const int row = MAP == 0 ? nn : ((nn >> 7) * 256 + (nn & 127) + (MAP == 2 ? 128 : 0));
        __builtin_nontemporal_store(o, (u32x4*)(WT + (pitch < 0 ? tiled_off((size_t)row, k0 + 16 * c, pitch == -1 ? (K >> 7) : -pitch) : (size_t)row * (pitch ? pitch : K) + k0 + 16 * c))); }
    LDS_WAIT(); asm volatile("" ::: "memory");
}
__device__ __forceinline__ void ph0(LAS unsigned char* lds, int tid, int lane, int wave, int G, int bid) {
    unsigned char* ws = AWS;
    {
        LAS float* sv = (LAS float*)(lds + 81920);
        LAS f32x4* comb = (LAS f32x4*)(lds + 81920 + 4096);
        float* modpart = (float*)(ws + WS_MODPART);
        for (int task = bid; task < 256; task += G) {
            const int cb = task & 15, kr = task >> 4;
            __syncthreads();
            for (int i = tid; i < 5 * 128; i += 512) { const int r = i >> 7, k = kr * 128 + (i & 127); const float v = (r < 4) ? AIN(IC)[r * D + k] : AIN(ICCTX)[k]; sv[i] = v / (1.0f + expf(-v)); }
            __syncthreads();
            f32x4 acc[5];
#pragma unroll
            for (int r = 0; r < 5; ++r) acc[r] = (f32x4){0.f, 0.f, 0.f, 0.f};
            const int c4 = tid % 192, ks = tid / 192;
            if (tid < 384) {
                const float* wp = AIN(IWADA) + (size_t)(kr * 128 + ks * 64) * 12288 + cb * 768 + c4 * 4;
#pragma unroll 8
                for (int k = 0; k < 64; ++k) { const f32x4 w = __builtin_nontemporal_load((const f32x4*)(wp + (size_t)k * 12288));
#pragma unroll
                    for (int r = 0; r < 5; ++r) acc[r] += w * sv[r * 128 + ks * 64 + k]; }
                if (ks == 1) {
#pragma unroll
                    for (int r = 0; r < 5; ++r) comb[r * 192 + c4] = acc[r]; }
            }
            __syncthreads();
            if (tid < 192) {
#pragma unroll
                for (int r = 0; r < 5; ++r) { const f32x4 t = acc[r] + comb[r * 192 + tid]; *(f32x4*)(modpart + (size_t)(kr * 5 + r) * 12288 + cb * 768 + tid * 4) = t; } }
        }
        __syncthreads();
    }
    const int gt = bid * 512 + tid, NGT = G * 512;
    {
        f32x2* PW = (f32x2*)(ws + WS_PW); f32x2* BBAR = (f32x2*)(ws + WS_BBAR); f32x2* LAML = (f32x2*)(ws + WS_LAML); f32x2* LAMSEG = (f32x2*)(ws + WS_LAMSEG);
        const double TWO_PI = 6.283185307179586476925287;
        for (int idx = gt; idx < SG * 2 * SP * 34; idx += NGT) {
            const int i = idx / 34, j = idx - i * 34; const int g = i >> 7, dir = (i >> 6) & 1, p = i & 63; const int si = (dir * SG + g) * SP + p;
            const double lr = (double)AIN(ILAMRE)[si], li = (double)AIN(ILAMIM)[si], dt = exp((double)AIN(ILOGDT)[dir * SG + g]);
            const int jj = (j == 33) ? LC * 33 : j;
            const double mag = exp((double)jj * lr * dt); double ang = (double)jj * li * dt; ang -= TWO_PI * rint(ang / TWO_PI);
            const float fa = (float)ang; const double cr = mag * (double)cosf(fa), ci = mag * (double)sinf(fa);
            const f32x2 o = (f32x2){(float)cr, (float)ci};
            if (j <= 32) PW[(size_t)i * 33 + j] = o;
            if (j == 32) LAML[i] = o;
            if (j == 33) LAMSEG[i] = o;
        }
        for (int idx = gt; idx < SG * 2 * SP * SH; idx += NGT) {
            const int i = idx >> 4, h = idx & 15; const int g = i >> 7, dir = (i >> 6) & 1, p = i & 63; const int si = (dir * SG + g) * SP + p;
            const double lr = (double)AIN(ILAMRE)[si], li = (double)AIN(ILAMIM)[si], dt = exp((double)AIN(ILOGDT)[dir * SG + g]);
            const double mag = exp(lr * dt); double ang = li * dt; ang -= TWO_PI * rint(ang / TWO_PI);
            const float fa = (float)ang; const double l1r = mag * (double)cosf(fa), l1i = mag * (double)sinf(fa);
            const double nr = l1r - 1.0, ni = l1i, den = lr * lr + li * li; const double qr = (nr * lr + ni * li) / den, qi = (ni * lr - nr * li) / den;
            const double br = (double)AIN(IBRE)[(size_t)si * SH + h], bi = (double)AIN(IBIM)[(size_t)si * SH + h];
            BBAR[(size_t)i * SH + h] = (f32x2){(float)(qr * br - qi * bi), (float)(qr * bi + qi * br)};
        }
    }
    {
        bf16* FKT = (bf16*)(ws + WS_FKT); bf16* FCT = (bf16*)(ws + WS_FCT); bf16* FRT = (bf16*)(ws + WS_FRT); bf16* WHI = (bf16*)(ws + WS_WRTHI); bf16* WLO = (bf16*)(ws + WS_WRTLO);
        const float TWO_PI_F = 6.2831853071795864f;
        for (int i = gt; i < 512 * 256; i += NGT) { const int m = i >> 8, k = i & 255, kp = m & 255, reim = m >> 8; const float ang = TWO_PI_F * (float)((k * kp) & 255) * (1.0f / 256.0f);
            FKT[i] = f2bf((reim ? -sinf(ang) : cosf(ang)) * 0.0625f); }
        for (int i = gt; i < 256 * 128; i += NGT) { const int m = i >> 7, kk = i & 127; float v = 0.f;
            if (m < 128) { const int ro = m >> 6, cp = m & 63, ri = kk >> 6, c = kk & 63; const float ang = TWO_PI_F * (float)((c * cp) & 63) * (1.0f / 64.0f); const float co = cosf(ang), sn = sinf(ang);
                v = (ro == 0 ? (ri == 0 ? co : sn) : (ri == 0 ? -sn : co)) * 0.125f; }
            FCT[i] = f2bf(v); }
        for (int i = gt; i < 256 * 256; i += NGT) { const int m = i >> 8, kk = i & 255; float v = 0.f;
            if (m < 128) { const int ri = kk >> 7, r = kk & 127; const float ang = TWO_PI_F * (float)((r * m) & 127) * (1.0f / 128.0f); v = (ri ? sinf(ang) : cosf(ang)) * 0.08838834764831845f; }
            FRT[i] = f2bf(v); }
        for (int i = gt; i < 48 * D; i += NGT) { const int n = i >> 11, k = i & (D - 1); float w = 0.f;
            if (n < 4) w = AIN(IWGRP)[k * 4 + n]; else if (n < 36) w = AIN(IWEXP)[k * 32 + (n - 4)];
            const bf16 h = f2bf(w); WHI[i] = h; WLO[i] = f2bf(w - bf2f(h)); }
    }
    {
        LAS float* scr = (LAS float*)(lds + wave * 16640);
        const int gw = bid * NWAVES + wave, NGW = G * NWAVES;
        constexpr int I_IN = 32 * 88, I_IN2 = 32 * 8, I_F = 16 * 32, I_S = 8 * 32, I_O = 32 * 32, I_G = 8 * 8, I_E = 512;
        constexpr int NITEMS = I_IN + I_IN2 + I_F + I_S + I_O + I_G + 3 * NE * I_E;
        for (int it = gw; it < NITEMS; it += NGW) {
            int r = NITEMS - 1 - it;
            if (r < I_IN) { transpose_item_f8<0>(AIN(IWIN), D, INW, (unsigned char*)(ws + WS_WG8), scr, r, lane, -1); continue; } r -= I_IN;
            if (r < I_IN2) { transpose_item<0>(AIN(IWIN), D, INW, (bf16*)(ws + WS_WINT), scr, (r >> 3) * 88 + 16 + (r & 7), lane); continue; } r -= I_IN2;
            if (r < I_F) { transpose_item_f8<0>(AIN(IWF), FW, D, (unsigned char*)(ws + WS_WFT) + ((size_t)(SW / 128) << 15), scr, r, lane, -(SW + FW) / 128); continue; } r -= I_F;
            if (r < I_S) { transpose_item_f8<0>(AIN(IWS), SW, D, (unsigned char*)(ws + WS_WFT), scr, r, lane, -(SW + FW) / 128); continue; } r -= I_S;
            if (r < I_O) { transpose_item_f8<0>(AIN(IWOUT), D, D, (unsigned char*)(ws + WS_WOT), scr, r, lane, -1); continue; } r -= I_O;
            if (r < I_G) { transpose_item<0>(AIN(IWGLU), SW, SW, (bf16*)(ws + WS_WGLUT), scr, r, lane); continue; } r -= I_G;
            if (r < NE * I_E) { const int e = r >> 9; transpose_item_f8<1>(AIN(IW1) + (size_t)e * D * DE, D, DE, (unsigned char*)(ws + WS_W13T) + (size_t)e * 2048 * D, scr, r & 511, lane, -1); continue; } r -= NE * I_E;
            if (r < NE * I_E) { const int e = r >> 9; transpose_item_f8<2>(AIN(IW3) + (size_t)e * D * DE, D, DE, (unsigned char*)(ws + WS_W13T) + (size_t)e * 2048 * D, scr, r & 511, lane, -1); continue; } r -= NE * I_E;
            { const int e = r >> 9; transpose_item_f8<0>(AIN(IW2) + (size_t)e * DE * D, DE, D, (unsigned char*)(ws + WS_W2T) + (size_t)e * D * DE, scr, r & 511, lane, -1); }
        }
    }
}

__device__ __forceinline__ void ph1(LAS unsigned char* lds, int tid, int G, int bid) {
    unsigned char* ws = AWS; const int gt = bid * 512 + tid, NGT = G * 512;
    const f32x2* PW = (const f32x2*)(ws + WS_PW); const f32x2* BBAR = (const f32x2*)(ws + WS_BBAR);
    { const float* modpart = (const float*)(ws + WS_MODPART); float* modv = (float*)(ws + WS_MODV);
      for (int i = gt; i < 5 * 12288; i += NGT) { float s = AIN(IBADA)[i % 12288];
#pragma unroll
          for (int kr = 0; kr < 16; ++kr) s += modpart[(size_t)kr * 5 * 12288 + i];
          modv[i] = s; } }
    { float* KLAG = (float*)(ws + WS_KLAG);
      for (int i = gt; i < SG * 2 * LC * 64; i += NGT) { const int hq = i & 3, ho = (i >> 2) & 15, k = (i >> 6) & 31, gd = i >> 11, g = gd >> 1, dir = gd & 1;
          const float* cre = AIN(ICRE) + ((size_t)(dir * SG + g) * SH + ho) * SP; const float* cim = AIN(ICIM) + ((size_t)(dir * SG + g) * SH + ho) * SP;
          f32x4 s = (f32x4){0.f, 0.f, 0.f, 0.f};
#pragma unroll 4
          for (int p = 0; p < SP; ++p) { const f32x2 pw = PW[((size_t)gd * SP + p) * 33 + k]; const f32x4* bq = (const f32x4*)(BBAR + ((size_t)gd * SP + p) * SH + 4 * hq); const f32x4 b01 = bq[0], b23 = bq[1]; const float cr = cre[p], ci = cim[p];
              const float tr = cr * pw.x - ci * pw.y, ti = cr * pw.y + ci * pw.x;
              s.x += tr * b01.x - ti * b01.y; s.y += tr * b01.z - ti * b01.w; s.z += tr * b23.x - ti * b23.y; s.w += tr * b23.z - ti * b23.w; }
          *(f32x4*)(KLAG + (((size_t)gd * LC + k) << 8) + ho * 16 + 4 * hq) = s; } }
    { bf16* WET = (bf16*)(ws + WS_WET);
      for (int i = gt; i < SG * 256 * LC; i += NGT) { const int jj = i & 31, n = (i >> 5) & 255, g = i >> 13; const int dir = n >> 7, reim = (n >> 6) & 1, p = n & 63;
          const int gd = g * 2 + dir; const f32x2 pw = PW[((size_t)gd * SP + p) * 33 + (dir == 0 ? (LC - 1 - jj) : jj)]; const f32x4* bb = (const f32x4*)(BBAR + ((size_t)gd * SP + p) * SH);
          unsigned o[8];
#pragma unroll
          for (int q = 0; q < 8; ++q) { const f32x4 b2 = bb[q];
              const float v0 = reim ? (pw.x * b2.y + pw.y * b2.x) : (pw.x * b2.x - pw.y * b2.y), v1 = reim ? (pw.x * b2.w + pw.y * b2.z) : (pw.x * b2.z - pw.y * b2.w); o[q] = pk_bf16(v0, v1); }
          u32x4* dst = (u32x4*)(WET + ((size_t)g * 256 + n) * 512 + jj * 16); dst[0] = (u32x4){o[0], o[1], o[2], o[3]}; dst[1] = (u32x4){o[4], o[5], o[6], o[7]}; } }
    { bf16* TV = (bf16*)(ws + WS_TV);
      for (int i = gt; i < SG * 512 * 32; i += NGT) { const int p8 = i & 7, reim = (i >> 3) & 1, dir = (i >> 4) & 1, n = (i >> 5) & 511, g = i >> 14; const int tt = n >> 4, ho = n & 15;
          const int gd = g * 2 + dir, pj = dir == 0 ? (tt + 1) : (LC - tt); const size_t ci = ((size_t)(dir * SG + g) * SH + ho) * SP + p8 * 8;
          const f32x4 cr0 = *(const f32x4*)(AIN(ICRE) + ci), cr1 = *(const f32x4*)(AIN(ICRE) + ci + 4), ci0 = *(const f32x4*)(AIN(ICIM) + ci), ci1 = *(const f32x4*)(AIN(ICIM) + ci + 4);
          float v[8];
#pragma unroll
          for (int q = 0; q < 8; ++q) { const f32x2 pw = PW[((size_t)gd * SP + p8 * 8 + q) * 33 + pj]; const float cr = q < 4 ? cr0[q & 3] : cr1[q & 3], cim = q < 4 ? ci0[q & 3] : ci1[q & 3];
              v[q] = reim ? -(cr * pw.y + cim * pw.x) : (cr * pw.x - cim * pw.y); }
          *(u32x4*)(TV + ((size_t)g * 512 + n) * A2LD + 512 + dir * 128 + reim * 64 + p8 * 8) = (u32x4){pk_bf16(v[0], v[1]), pk_bf16(v[2], v[3]), pk_bf16(v[4], v[5]), pk_bf16(v[6], v[7])}; } }
}

__device__ __forceinline__ void ph2(LAS unsigned char* lds, int tid, int lane, int wave, int G, int bid) {
    unsigned char* ws = AWS; const float* modv = (const float*)(ws + WS_MODV);
    { const int gt = bid * 512 + tid, NGT = G * 512; bf16* TV = (bf16*)(ws + WS_TV); const float* KLAG = (const float*)(ws + WS_KLAG); const float* dsk = AIN(IDSKIP);
      for (int i = gt; i < SG * 512 * LC; i += NGT) { const int jj = i & 31, n = (i >> 5) & 511, g = i >> 14; const int tt = n >> 4, ho = n & 15;
          const int dir = jj > tt ? 1 : 0, lag = jj > tt ? jj - tt : tt - jj;
          const f32x4* k0 = (const f32x4*)(KLAG + (((size_t)(g * 2 + dir) * LC + lag) << 8) + ho * 16);
          f32x4 a[4];
#pragma unroll
          for (int q = 0; q < 4; ++q) a[q] = k0[q];
          if (jj == tt) { const f32x4* k1 = (const f32x4*)(KLAG + (((size_t)(g * 2 + 1) * LC) << 8) + ho * 16);
#pragma unroll
              for (int q = 0; q < 4; ++q) a[q] += k1[q];
              const float dv = dsk[g * SH + ho];
#pragma unroll
              for (int q = 0; q < 4; ++q) { a[q].x += (ho == 4 * q + 0) ? dv : 0.f; a[q].y += (ho == 4 * q + 1) ? dv : 0.f; a[q].z += (ho == 4 * q + 2) ? dv : 0.f; a[q].w += (ho == 4 * q + 3) ? dv : 0.f; } }
          u32x4* dst = (u32x4*)(TV + ((size_t)g * 512 + n) * A2LD + jj * 16);
          dst[0] = (u32x4){pk_bf16(a[0].x, a[0].y), pk_bf16(a[0].z, a[0].w), pk_bf16(a[1].x, a[1].y), pk_bf16(a[1].z, a[1].w)};
          dst[1] = (u32x4){pk_bf16(a[2].x, a[2].y), pk_bf16(a[2].z, a[2].w), pk_bf16(a[3].x, a[3].y), pk_bf16(a[3].z, a[3].w)}; } }
    LAS f32x4* MV = (LAS f32x4*)lds;
    for (int i = tid; i < 5 * 2 * 512; i += NWAVES * 64) { const int b = i >> 10, which = (i >> 9) & 1, q = i & 511; f32x4 t = *((const f32x4*)(modv + (size_t)b * 12288 + which * D) + q); if (which) t = t + 1.0f; MV[i] = t; }
    __syncthreads();
    const int gw = bid * NWAVES + wave, NGW = G * NWAVES; const float* XP = AIN(IX); const float* CP = AIN(ICTX);
    f32x4 v[8];
    { const int m = T + TC - 1 - gw; const f32x4* xq = (const f32x4*)(m < T ? XP + (size_t)m * D : CP + (size_t)(m - T) * D) + lane;
#pragma unroll
      for (int j = 0; j < 8; ++j) v[j] = __builtin_nontemporal_load(xq + 64 * j); }
    for (int m = T + TC - 1 - gw; m >= 0; m -= NGW) {
        f32x4 vn[8]; const int mn = m - NGW;
        if (mn >= 0) { const f32x4* xq = (const f32x4*)(mn < T ? XP + (size_t)mn * D : CP + (size_t)(mn - T) * D) + lane;
#pragma unroll
            for (int j = 0; j < 8; ++j) vn[j] = __builtin_nontemporal_load(xq + 64 * j); }
        else {
#pragma unroll
            for (int j = 0; j < 8; ++j) vn[j] = (f32x4){0.f, 0.f, 0.f, 0.f}; }
        bf16* orow; int bsel;
        if (m < T) { orow = (bf16*)(ws + WS_R3) + (size_t)m * D; bsel = m >> 13; }
        else { orow = (bf16*)(ws + WS_HC) + (size_t)(m - T) * D; bsel = 4; }
        float s = 0.f;
#pragma unroll
        for (int j = 0; j < 8; ++j) s += (v[j].x + v[j].y) + (v[j].z + v[j].w);
        const float mean = wave_sum(s) * (1.f / D); float s2 = 0.f;
#pragma unroll
        for (int j = 0; j < 8; ++j) { v[j] = v[j] - mean; s2 += (v[j].x * v[j].x + v[j].y * v[j].y) + (v[j].z * v[j].z + v[j].w * v[j].w); }
        const float rstd = 1.f / sqrtf(wave_sum(s2) * (1.f / D) + LN_EPS);
        const LAS f32x4* shq = MV + bsel * 1024 + lane; const LAS f32x4* scq = shq + 512; u32x2* o8 = (u32x2*)orow + lane;
        unsigned char* o4 = ws + WS_RA + ((size_t)((m < T ? m : 0) >> 8) * 16 << 15) + ((size_t)(m & 255) << 7) + ((lane >> 5) << 15) + 4 * (lane & 31);
#pragma unroll
        for (int j = 0; j < 8; ++j) { const f32x4 sh = shq[64 * j], sc = scq[64 * j]; const f32x4 y = v[j] * rstd * sc + sh; if (m < T) *(unsigned*)(o4 + ((size_t)(2 * j) << 15)) = pk4_fp8(y.x, y.y, y.z, y.w); else o8[64 * j] = (u32x2){pk_bf16(y.x, y.y), pk_bf16(y.z, y.w)}; }
#pragma unroll
        for (int j = 0; j < 8; ++j) v[j] = vn[j];
    }
}

__device__ __forceinline__ void ctx_inproj(LAS unsigned char* lds, int lane, int wave, int G, int bid) {
    unsigned char* ws = AWS; const bf16* HC = (const bf16*)(ws + WS_HC); const bf16* WINT = (const bf16*)(ws + WS_WINT); bf16* A2 = (bf16*)(ws + WS_A2);
    const int fr = lane & 15, fq = lane >> 4;
    for (int wt = bid * NWAVES + wave; wt < 2048; wt += G * NWAVES) {
        const int rt = wt >> 5, ct = wt & 31;
        const bf16* ap = HC + (size_t)(16 * rt + fr) * D + 8 * fq; const bf16* bp = WINT + (size_t)(FW + 16 * ct + fr) * D + 8 * fq;
        f32x4 acc = (f32x4){0.f, 0.f, 0.f, 0.f};
#pragma unroll 8
        for (int ks = 0; ks < 64; ++ks) { const bf16x8 av = *(const bf16x8*)(ap + 32 * ks), bv = *(const bf16x8*)(bp + 32 * ks); acc = __builtin_amdgcn_mfma_f32_16x16x32_bf16(av, bv, acc, 0, 0, 0); }
#pragma unroll
        for (int j = 0; j < 4; ++j) { const int row = 16 * rt + 4 * fq + j, b = row >> 8, tp = row & 255;
            A2[((size_t)((ct * 4 + b) * NCH + (tp >> 5))) * A2LD + (tp & 31) * 16 + fr] = f2bf(acc[j]); }
    }
}
__device__ __forceinline__ void ctx_E(LAS unsigned char* lds, int lane, int wave, int G, int bid) {
    unsigned char* ws = AWS; const bf16* A2 = (const bf16*)(ws + WS_A2); const bf16* WET = (const bf16*)(ws + WS_WET); float* E = (float*)(ws + WS_E);
    const int fr = lane & 15, fq = lane >> 4;
    for (int task = (bid + G - (128 % G)) % G; task < 128; task += G) {
        const int g = task >> 2, b = task & 3;
        const bf16* ap = A2 + (size_t)((g * 4 + b) * NCH + fr) * A2LD + 8 * fq;
        const bf16* bp0 = WET + (size_t)(g * 256 + 32 * wave + fr) * 512 + 8 * fq; const bf16* bp1 = bp0 + 16 * 512;
        f32x4 acc0 = (f32x4){0.f, 0.f, 0.f, 0.f}, acc1 = acc0;
#pragma unroll 4
        for (int ks = 0; ks < 16; ++ks) { const bf16x8 av = *(const bf16x8*)(ap + 32 * ks), b0 = *(const bf16x8*)(bp0 + 32 * ks), b1 = *(const bf16x8*)(bp1 + 32 * ks);
            acc0 = __builtin_amdgcn_mfma_f32_16x16x32_bf16(av, b0, acc0, 0, 0, 0); acc1 = __builtin_amdgcn_mfma_f32_16x16x32_bf16(av, b1, acc1, 0, 0, 0); }
        if (fq < 2) {
#pragma unroll
            for (int j = 0; j < 4; ++j) { float* er = E + (size_t)((g * 4 + b) * NCH + 4 * fq + j) * 256 + 32 * wave + fr; er[0] = acc0[j]; er[16] = acc1[j]; } }
    }
}

__device__ __forceinline__ void chunk_scan(LAS unsigned char* lds, int lane, int wave, int G, int bid) {
    unsigned char* ws = AWS; const float* E = (const float*)(ws + WS_E); bf16* A2 = (bf16*)(ws + WS_A2);
    const f32x2* LAML = (const f32x2*)(ws + WS_LAML); const f32x2* LAMSEG = (const f32x2*)(ws + WS_LAMSEG);
    LAS f32x2* segEnd = (LAS f32x2*)lds;
    for (int task = bid; task < 256; task += G) {
        const int g = task >> 3, b = (task >> 1) & 3, dir = task & 1, p = lane;
        const f32x2 lamL = LAML[(g * 2 + dir) * SP + p], lamS = LAMSEG[(g * 2 + dir) * SP + p];
        const float* Eb = E + (size_t)((g * 4 + b) * NCH) * 256 + dir * 128 + p;
        const int v0 = 33 * wave;
        float sr = 0.f, si = 0.f;
#pragma unroll 11
        for (int i = 0; i < 33; ++i) { const int vi = v0 + i; const int cr = dir == 0 ? vi : (vi < NCTXCH ? NCTXCH - 1 - vi : (NCH - 1 + NCTXCH) - vi);
            const float er = Eb[(size_t)cr * 256], ei = Eb[(size_t)cr * 256 + 64];
            const float tr = lamL.x * sr - lamL.y * si + er, ti = lamL.x * si + lamL.y * sr + ei; sr = tr; si = ti; }
        __syncthreads();
        segEnd[wave * 64 + p] = (f32x2){sr, si};
        __syncthreads();
        sr = 0.f; si = 0.f;
        for (int w = 0; w < wave; ++w) { const f32x2 se = segEnd[w * 64 + p]; const float tr = lamS.x * sr - lamS.y * si + se.x, ti = lamS.x * si + lamS.y * sr + se.y; sr = tr; si = ti; }
        bf16* Ab = A2 + (size_t)((g * 4 + b) * NCH) * A2LD + 512 + dir * 128 + p;
#pragma unroll 11
        for (int i = 0; i < 33; ++i) { const int vi = v0 + i; const int cr = dir == 0 ? vi : (vi < NCTXCH ? NCTXCH - 1 - vi : (NCH - 1 + NCTXCH) - vi);
            const float er = Eb[(size_t)cr * 256], ei = Eb[(size_t)cr * 256 + 64];
            if (cr >= NCTXCH) { Ab[(size_t)cr * A2LD] = f2bf(sr); Ab[(size_t)cr * A2LD + 64] = f2bf(si); }
            const float tr = lamL.x * sr - lamL.y * si + er, ti = lamL.x * si + lamL.y * sr + ei; sr = tr; si = ti; }
    }
    __syncthreads();
}

__device__ __forceinline__ void ph10(LAS unsigned char* lds, int tid, int lane, int wave, int G, int bid) {
    unsigned char* ws = AWS; bf16* XM = (bf16*)(ws + WS_XMID); unsigned char* H2 = (unsigned char*)(ws + WS_RB); const float* modv = (const float*)(ws + WS_MODV);
    const bf16* WHI = (const bf16*)(ws + WS_WRTHI); const bf16* WLO = (const bf16*)(ws + WS_WRTLO);
    unsigned* ctl = (unsigned*)(ws + WS_CTL); int* rowlist = (int*)(ws + WS_ROWLIST); float* rw = (float*)(ws + WS_RW);
    constexpr int RS = 4112;
    LAS unsigned char* Hhi = lds; LAS unsigned char* Hlo = lds + 16 * RS;
    LAS float* Pp = (LAS float*)lds;
    LAS float* Lg = (LAS float*)(lds + 2 * 16 * RS);
    LAS int* tokE = (LAS int*)(lds + 2 * 16 * RS + 2304);
    LAS float* tokW = (LAS float*)(lds + 2 * 16 * RS + 3328);
    LAS int* tokLi = (LAS int*)(lds + 2 * 16 * RS + 4352);
    LAS int* lcnt = (LAS int*)(lds + 2 * 16 * RS + 5376);
    LAS int* lbase = (LAS int*)(lds + 2 * 16 * RS + 5504);
    const int fr = lane & 15, fq = lane >> 4;
    const float* XIN = AIN(IX); const bf16* MG = (const bf16*)(ws + WS_R3);
    const float* bgrp = AIN(IBGRP); const float* bexp = AIN(IBEXP); const float* ln1g = AIN(ILN1G); const float* ln1b = AIN(ILN1B);
    bf16x8 wf[8][3];
#pragma unroll
    for (int ks = 0; ks < 8; ++ks)
#pragma unroll
        for (int nt = 0; nt < 3; ++nt) wf[ks][nt] = *(const bf16x8*)(WHI + (size_t)(16 * nt + fr) * D + 256 * wave + 32 * ks + 8 * fq);
    LAS f32x4* VEC = (LAS f32x4*)(lds + 16 * RS);
    const f32x4* XIN4 = (const f32x4*)XIN + lane; const unsigned* MG2 = (const unsigned*)MG + lane;
    auto load_row = [&](size_t gtok, f32x4 (&xv)[8], unsigned (&mv_)[8]) {
        const f32x4* xin = XIN4 + gtok * (D / 4); const unsigned* mgq = MG2 + gtok * (D / 4);
#pragma unroll
        for (int j = 0; j < 8; ++j) { mv_[j] = __builtin_nontemporal_load(mgq + 64 * j); xv[j] = __builtin_nontemporal_load(xin + 64 * j); } };
    auto do_row = [&](f32x4 (&v)[8], const unsigned (&mg)[8], size_t gtok, int row) {
        u32x2* xq = (u32x2*)(XM + gtok * D) + lane; float s = 0.f;
#pragma unroll
        for (int j = 0; j < 8; ++j) { const f32x2 m0 = __builtin_amdgcn_cvt_pk_f32_fp8((int)mg[j], false), m1 = __builtin_amdgcn_cvt_pk_f32_fp8((int)mg[j], true);
            v[j] = v[j] * DN_ALPHA + (f32x4){m0.x, m0.y, m1.x, m1.y} * MG8_INV; s += (v[j].x + v[j].y) + (v[j].z + v[j].w); }
        float mean = wave_sum(s) * (1.f / D), s2 = 0.f;
#pragma unroll
        for (int j = 0; j < 8; ++j) { v[j] = v[j] - mean; s2 += (v[j].x * v[j].x + v[j].y * v[j].y) + (v[j].z * v[j].z + v[j].w * v[j].w); }
        float rstd = 1.f / sqrtf(wave_sum(s2) * (1.f / D) + LN_EPS);
        const LAS f32x4* gq = VEC + lane; const LAS f32x4* bq = VEC + 512 + lane; s = 0.f;
#pragma unroll
        for (int j = 0; j < 8; ++j) { v[j] = v[j] * rstd * gq[64 * j] + bq[64 * j]; xq[64 * j] = (u32x2){pk_bf16(v[j].x, v[j].y), pk_bf16(v[j].z, v[j].w)}; s += (v[j].x + v[j].y) + (v[j].z + v[j].w); }
        mean = wave_sum(s) * (1.f / D); s2 = 0.f;
#pragma unroll
        for (int j = 0; j < 8; ++j) { v[j] = v[j] - mean; s2 += (v[j].x * v[j].x + v[j].y * v[j].y) + (v[j].z * v[j].z + v[j].w * v[j].w); }
        rstd = 1.f / sqrtf(wave_sum(s2) * (1.f / D) + LN_EPS);
        const LAS f32x4* scq = VEC + 1024 + lane; const LAS f32x4* shq = VEC + 1536 + lane; unsigned* o8 = (unsigned*)(H2 + gtok * D) + lane;
#pragma unroll
        for (int j = 0; j < 8; ++j) { const f32x4 y = v[j] * rstd * scq[64 * j] + shq[64 * j];
            const u32x2 hi = (u32x2){pk_bf16(y.x, y.y), pk_bf16(y.z, y.w)};
            o8[64 * j] = pk4_fp8(y.x, y.y, y.z, y.w);
            *(LAS u32x2*)(Hhi + row * RS + (256 * j + 4 * lane) * 2) = hi; } };
    for (int batch = bid; batch < 256; batch += G) {
        if (tid < 32) lcnt[tid] = 0;
        { const float* mv = modv + (size_t)((batch * 128) >> 13) * 12288;
          for (int i = tid; i < 4 * 512; i += NWAVES * 64) { const int r = i >> 9, q = i & 511;
              f32x4 t = *((const f32x4*)(r == 0 ? ln1g : r == 1 ? ln1b : r == 2 ? mv + 4 * D : mv + 3 * D) + q); if (r == 2) t = t + 1.0f; VEC[i] = t; } }
        __syncthreads();
        const size_t tokB = (size_t)batch * 128 + 2 * wave;
        f32x4 xa[8], xb[8]; unsigned ma[8], mb[8];
        load_row(tokB, xa, ma);
        for (int grp = 0; grp < 8; ++grp) {
            const size_t g0 = tokB + grp * 16;
            load_row(g0 + 1, xb, mb);
            do_row(xa, ma, g0, 2 * wave);
            if (grp < 7) load_row(g0 + 16, xa, ma);
            do_row(xb, mb, g0 + 1, 2 * wave + 1);
            __syncthreads();
            f32x4 acc[3];
#pragma unroll
            for (int nt = 0; nt < 3; ++nt) acc[nt] = (f32x4){0.f, 0.f, 0.f, 0.f};
#pragma unroll
            for (int ks = 0; ks < 8; ++ks) { const int k = 256 * wave + 32 * ks + 8 * fq;
                const bf16x8 ahi = *(const LAS bf16x8*)(Hhi + fr * RS + k * 2);
#pragma unroll
                for (int nt = 0; nt < 3; ++nt) acc[nt] = __builtin_amdgcn_mfma_f32_16x16x32_bf16(ahi, wf[ks][nt], acc[nt], 0, 0, 0); }
            __syncthreads();
#pragma unroll
            for (int nt = 0; nt < 3; ++nt)
#pragma unroll
                for (int j = 0; j < 4; ++j) Pp[(wave * 16 + 4 * fq + j) * 48 + 16 * nt + fr] = acc[nt][j];
            __syncthreads();
            for (int i = tid; i < 16 * 36; i += 512) { const int tk = i / 36, n = i % 36; float s = 0.f;
#pragma unroll
                for (int w = 0; w < 8; ++w) s += Pp[(w * 16 + tk) * 48 + n];
                Lg[i] = s; }
            __syncthreads();
            if (tid < 16) {
                const LAS float* L = Lg + tid * 36;
                float lg[4]; int gi = 0; float gm;
#pragma unroll
                for (int i = 0; i < 4; ++i) lg[i] = L[i] + bgrp[i];
                gm = lg[0];
#pragma unroll
                for (int i = 1; i < 4; ++i) if (lg[i] > gm) { gm = lg[i]; gi = i; }
                float gz = 0.f;
#pragma unroll
                for (int i = 0; i < 4; ++i) gz += expf(lg[i] - gm);
                const float gtop = 1.0f / gz;
                float le[8]; int j0 = 0; float m0;
#pragma unroll
                for (int j = 0; j < 8; ++j) le[j] = L[4 + gi * 8 + j] + bexp[gi * 8 + j];
                m0 = le[0];
#pragma unroll
                for (int j = 1; j < 8; ++j) if (le[j] > m0) { m0 = le[j]; j0 = j; }
                int j1 = (j0 == 0) ? 1 : 0; float m1 = -3.0e38f;
#pragma unroll
                for (int j = 0; j < 8; ++j) if (j != j0 && le[j] > m1) { m1 = le[j]; j1 = j; }
                const float e1 = expf(m1 - m0), w0 = gtop / (1.0f + e1), w1 = gtop * e1 / (1.0f + e1);
                const int ex0 = gi * 8 + j0, ex1 = gi * 8 + j1; const int sl = (grp * 16 + tid) * 2;
                tokE[sl] = ex0; tokE[sl + 1] = ex1; tokW[sl] = w0; tokW[sl + 1] = w1;
                tokLi[sl] = __hip_atomic_fetch_add(lcnt + ex0, 1, __ATOMIC_RELAXED, __HIP_MEMORY_SCOPE_WORKGROUP);
                tokLi[sl + 1] = __hip_atomic_fetch_add(lcnt + ex1, 1, __ATOMIC_RELAXED, __HIP_MEMORY_SCOPE_WORKGROUP);
            }
            __syncthreads();
        }
        if (tid < 32) { const int n = lcnt[tid]; lbase[tid] = n ? (int)__hip_atomic_fetch_add(ctl + CW_CNT + 64 * tid, (unsigned)n, RLX_AGENT) : 0; }
        __syncthreads();
        if (tid < 256) { const int e = tokE[tid], pos = lbase[e] + tokLi[tid], ent = (batch * 128 + (tid >> 1)) * 2 + (tid & 1); rowlist[(size_t)e * ECAP + pos] = ent; rw[ent] = tokW[tid]; }
        __syncthreads();
    }
}

__device__ __forceinline__ void ph13(LAS unsigned char* lds, int tid, int lane_, int wave, int G, int bid) {
    const int lane = (int)__builtin_amdgcn_mbcnt_hi(~0u, __builtin_amdgcn_mbcnt_lo(~0u, 0u));
    unsigned char* ws = AWS; float* X = AOUT; const bf16* XM = (const bf16*)(ws + WS_XMID); const unsigned char* Y = (const unsigned char*)(ws + WS_RB); const float* rw = (const float*)(ws + WS_RW); const float* modv = (const float*)(ws + WS_MODV);
    LAS f32x4* VG = (LAS f32x4*)lds;
    { const f32x4* g2 = (const f32x4*)AIN(ILN2G); const f32x4* b2 = (const f32x4*)AIN(ILN2B);
      for (int i = tid; i < 6 * 512; i += NWAVES * 64) { const int r = i >> 9, q = i & 511; VG[i] = r < 4 ? *((const f32x4*)(modv + (size_t)r * 12288 + 5 * D) + q) : (r == 4 ? g2[q] : b2[q]); } }
    __syncthreads();
    const int gw = bid * NWAVES + wave, NGW = G * NWAVES;
    unsigned p0[8], p1[8]; u32x2 xb[8]; float w0, w1;
    { const int m = gw; const u32x2* xm = (const u32x2*)(XM + (size_t)m * D) + lane; const unsigned* y0 = (const unsigned*)(Y + (size_t)(2 * m) * D) + lane; const unsigned* y1 = y0 + D / 4;
#pragma unroll
      for (int j = 0; j < 8; ++j) { p0[j] = __builtin_nontemporal_load(y0 + 64 * j); p1[j] = __builtin_nontemporal_load(y1 + 64 * j); xb[j] = __builtin_nontemporal_load(xm + 64 * j); }
      w0 = rw[2 * m]; w1 = rw[2 * m + 1]; }
    for (int m = gw; m < T; m += NGW) {
        unsigned q0[8], q1[8]; u32x2 xn[8]; float wn0 = 0.f, wn1 = 0.f; const int mn = m + NGW;
        if (mn < T) { const u32x2* xm = (const u32x2*)(XM + (size_t)mn * D) + lane; const unsigned* y0 = (const unsigned*)(Y + (size_t)(2 * mn) * D) + lane; const unsigned* y1 = y0 + D / 4;
#pragma unroll
            for (int j = 0; j < 8; ++j) { q0[j] = __builtin_nontemporal_load(y0 + 64 * j); q1[j] = __builtin_nontemporal_load(y1 + 64 * j); xn[j] = __builtin_nontemporal_load(xm + 64 * j); }
            wn0 = rw[2 * mn]; wn1 = rw[2 * mn + 1]; }
        else {
#pragma unroll
            for (int j = 0; j < 8; ++j) { q0[j] = 0u; q1[j] = 0u; xn[j] = (u32x2){0u, 0u}; } }
        f32x4* xq = (f32x4*)(X + (size_t)m * D) + lane; const LAS f32x4* gq = VG + (m >> 13) * 512 + lane;
        const float c0 = w0 * Y8_INV, c1 = w1 * Y8_INV;
        f32x4 v[8]; float s = 0.f;
#pragma unroll
        for (int j = 0; j < 8; ++j) {
            const f32x2 a0 = __builtin_amdgcn_cvt_pk_f32_fp8((int)p0[j], false), a1 = __builtin_amdgcn_cvt_pk_f32_fp8((int)p0[j], true), b0 = __builtin_amdgcn_cvt_pk_f32_fp8((int)p1[j], false), b1 = __builtin_amdgcn_cvt_pk_f32_fp8((int)p1[j], true);
            const f32x4 yy = (f32x4){a0.x, a0.y, a1.x, a1.y} * c0 + (f32x4){b0.x, b0.y, b1.x, b1.y} * c1;
            v[j] = (f32x4){bf_lo(xb[j].x), bf_hi(xb[j].x), bf_lo(xb[j].y), bf_hi(xb[j].y)} * DN_ALPHA + gq[64 * j] * yy; s += (v[j].x + v[j].y) + (v[j].z + v[j].w); }
        const float mean = wave_sum(s) * (1.f / D); float s2 = 0.f;
#pragma unroll
        for (int j = 0; j < 8; ++j) { v[j] = v[j] - mean; s2 += (v[j].x * v[j].x + v[j].y * v[j].y) + (v[j].z * v[j].z + v[j].w * v[j].w); }
        const float rstd = 1.f / sqrtf(wave_sum(s2) * (1.f / D) + LN_EPS);
        const LAS f32x4* g2 = VG + 4 * 512 + lane; const LAS f32x4* b2 = VG + 5 * 512 + lane;
#pragma unroll
        for (int j = 0; j < 8; ++j) __builtin_nontemporal_store(v[j] * rstd * g2[64 * j] + b2[64 * j], xq + 64 * j);
#pragma unroll
        for (int j = 0; j < 8; ++j) { p0[j] = q0[j]; p1[j] = q1[j]; xb[j] = xn[j]; }
        w0 = wn0; w1 = wn1;
    }
}

__global__ void __launch_bounds__(NWAVES * 64, 2) fwd_kernel(Args a) {
    extern __shared__ __attribute__((aligned(16))) unsigned char lds_raw[];
    LAS unsigned char* lds = (LAS unsigned char*)lds_raw;
    const int tid = threadIdx.x, lane = tid & 63, wave = __builtin_amdgcn_readfirstlane(tid >> 6), G = gridDim.x, bid = blockIdx.x;
    for (int u = tid; u < (LDS_BYTES - MISC_OFF) / 4; u += NWAVES * 64) ((LAS unsigned*)(lds + MISC_OFF))[u] = 0u;
    __syncthreads();
    if (tid < NIN + 2) { const unsigned long long* kp = (const unsigned long long*)&a; const unsigned long long v = kp[tid];
        volatile LAS unsigned* tab = (volatile LAS unsigned*)(lds + ARGS_OFF); tab[2 * tid] = (unsigned)v; tab[2 * tid + 1] = (unsigned)(v >> 32); }
    __syncthreads();
    unsigned char* ws = AWS;
    const int lo = a.ph_lo, hi = a.ph_hi;
    XcdBarrier bar; bar.bar = (unsigned*)(ws + WS_CTL) + CW_BAR; bar.x = 0; bar.st = nullptr;
    if (hi - lo > 1) bar = xcd_barrier_post((unsigned*)(ws + WS_CTL) + CW_BAR, (volatile LAS unsigned*)(lds + MISC_OFF));
#ifndef PHASE_MASK
#define PHASE_MASK 0x3fff
#endif
#define IN(k) (((PHASE_MASK >> (k)) & 1) && lo <= (k) && (k) < hi)
#define SEAM(k) do { if (IN(k) && IN((k) + 1)) xcd_barrier(bar); } while (0)
    LAS int* moe_pre = (LAS int*)(lds + MISC_OFF + 256);
    LAS int* moe_cnt = (LAS int*)(lds + MISC_OFF + 512);

    if (IN(0)) { ph0(lds, tid, lane, wave, G, bid); } SEAM(0);
    if (IN(1)) { ph1(lds, tid, G, bid); } SEAM(1);
    if (IN(2)) { ph2(lds, tid, lane, wave, G, bid); } SEAM(2);
    if (IN(3)) {
        ctx_inproj(lds, lane, wave, G, bid);
        { SchedTiled S; S.o.init(T / 256, 6, G, bid); S.A = (const char*)(ws + WS_RA); S.B = (const char*)(ws + WS_WG8); S.nt = D / 128;
          EpiInProjT<true> E{(bf16*)(ws + WS_UF), (bf16*)(ws + WS_A2), nullptr, nullptr};
          pg8::gemm_phase<EpiInProjT<true>, SchedTiled, true, true>(lds, S, E); }
        { SchedTiled S; S.o.init(T / 256, 16, G, bid); S.A = (const char*)(ws + WS_RA); S.B = (const char*)(ws + WS_WG8) + ((size_t)6 * (D / 128) << 15); S.nt = D / 128;
          EpiGates8 E{(unsigned char*)AOUT, (unsigned char*)AOUT + (size_t)T * D};
          pg8::gemm_phase<EpiGates8, SchedTiled, true, true>(lds, S, E); }
    } SEAM(3);
    if (IN(4)) {
#ifndef NO_P4A
        { SchedE S{G, bid, (const char*)(ws + WS_A2), (const char*)(ws + WS_WET)}; EpiE E{(float*)(ws + WS_E)}; pg8::gemm_phase<EpiE, SchedE>(lds, S, E); }
#endif
#ifndef NO_P4B
        ctx_E(lds, lane, wave, G, bid);
#endif
#ifndef NO_P4C
        { SchedF1 S{G, bid, (const char*)(ws + WS_FKT), (const char*)(ws + WS_UF)}; EpiF1 E{(bf16*)(ws + WS_R3)}; pg8::gemm_phase<EpiF1, SchedF1>(lds, S, E); }
#endif
    } SEAM(4);
    if (IN(5)) {
        chunk_scan(lds, lane, wave, G, bid);
        { SchedF2 S{G, bid, (const char*)(ws + WS_FCT), (const char*)(ws + WS_R3)}; EpiF2 E{(bf16*)(ws + WS_RA)}; pg8::gemm_phase<EpiF2, SchedF2>(lds, S, E); }
    } SEAM(5);
    if (IN(6)) {
#ifndef NO_P6A
        { SchedSSM S{G, bid, (const char*)(ws + WS_A2), (const char*)(ws + WS_TV)}; EpiSSM E{(bf16*)(ws + WS_YS)}; pg8::gemm_phase<EpiSSM, SchedSSM>(lds, S, E); }
#endif
#ifndef NO_P6B
        { SchedF3 S{G, bid, (const char*)(ws + WS_FRT), (const char*)(ws + WS_RA)}; EpiF3 E{(unsigned char*)(ws + WS_R3)}; pg8::gemm_phase<EpiF3, SchedF3>(lds, S, E); }
#endif
    } SEAM(6);
    if (IN(7)) {
        SchedRect S; S.o.init(T / 256, SW / 256, G, bid); S.A = (const char*)(ws + WS_YS); S.B = (const char*)(ws + WS_WGLUT); S.lda = SW; S.ldb = SW; S.nt = SW / 64;
        EpiGate<2> E{nullptr, (const void*)(ws + WS_YS), AIN(IBGLU), SW, (unsigned char*)(ws + WS_R3), (SW + FW) / 128};
        pg8::gemm_phase<EpiGate<2>, SchedRect>(lds, S, E);
    } SEAM(7);
    if (IN(8)) {
        SchedMerge S; S.o.init(T / 256, D / 256, G, bid); S.A = (const char*)(ws + WS_R3); S.B = (const char*)(ws + WS_WFT);
        EpiMerge E{(unsigned char*)(ws + WS_RA), (const unsigned char*)AOUT, (const unsigned char*)AOUT + (size_t)T * D};
        pg8::gemm_phase<EpiMerge, SchedMerge, true, true>(lds, S, E);
    } SEAM(8);
    if (IN(9)) {
        SchedTiled S; S.o.init(T / 256, D / 256, G, bid); S.A = (const char*)(ws + WS_RA); S.B = (const char*)(ws + WS_WOT); S.nt = D / 128;
        EpiOut E{(const float*)(ws + WS_MODV), (unsigned char*)(ws + WS_R3)};
        pg8::gemm_phase<EpiOut, SchedTiled, true, true>(lds, S, E);
    } SEAM(9);
    if (IN(10)) { ph10(lds, tid, lane, wave, G, bid); } SEAM(10);
    if (IN(11) || IN(12)) {
        if (tid < 64) { const int cnt = tid < NE ? (int)__hip_atomic_load((unsigned*)(ws + WS_CTL) + CW_CNT + 64 * tid, RLX_AGENT) : 0; const int tiles = (cnt + 255) >> 8; int incl = tiles;
#pragma unroll
            for (int o = 1; o < 32; o <<= 1) { const int t = __shfl_up(incl, o); if (lane >= o) incl += t; }
            if (tid < NE) { moe_pre[tid] = incl - tiles; moe_cnt[tid] = cnt; } if (tid == NE - 1) moe_pre[NE] = incl; }
        __syncthreads();
    }
    if (IN(11)) {
        SchedMoe<1, D, D, D / 128> S{G, bid, (const char*)(ws + WS_RB), (const char*)(ws + WS_W13T), (const int*)(ws + WS_ROWLIST), moe_pre, moe_cnt};
        EpiMoe1 E{(unsigned char*)(ws + WS_RA), moe_pre};
        pg8::gemm_phase<EpiMoe1, SchedMoe<1, D, D, D / 128>, true, true>(lds, S, E);
    } SEAM(11);
    if (IN(12)) {
        SchedMoeDown S{G, bid, (const char*)(ws + WS_RA), (const char*)(ws + WS_W2T), moe_pre, moe_cnt};
        EpiMoe2 E{(unsigned char*)(ws + WS_RB), (const int*)(ws + WS_ROWLIST)};
        pg8::gemm_phase<EpiMoe2, SchedMoeDown, true, true>(lds, S, E);
    } SEAM(12);
    if (IN(13)) { ph13(lds, tid, lane, wave, G, bid); }
#undef IN
#undef SEAM
}

extern "C" void kernel_launch(void* const* d_in, const int* in_sizes, int n_in, void* d_out, int out_size, void* d_ws, size_t ws_size, hipStream_t stream) {
    static int grid = 0;
    if (grid == 0) {
        if (n_in != NIN || out_size != T * D || ws_size < WS_END) { fprintf(stderr, "kernel_launch: unexpected problem (n_in %d, out %d, ws %zu); nothing launched\n", n_in, out_size, ws_size); grid = -1; return; }
        int dev = 0, cus = 0, per_cu = 0;
        if (hipGetDevice(&dev) != hipSuccess || hipDeviceGetAttribute(&cus, hipDeviceAttributeMultiprocessorCount, dev) != hipSuccess) { grid = -1; return; }
        if (hipFuncSetAttribute((const void*)fwd_kernel, hipFuncAttributeMaxDynamicSharedMemorySize, LDS_BYTES) != hipSuccess) { fprintf(stderr, "kernel_launch: hipFuncSetAttribute failed\n"); grid = -1; return; }
        if (hipOccupancyMaxActiveBlocksPerMultiprocessor(&per_cu, (const void*)fwd_kernel, NWAVES * 64, LDS_BYTES) != hipSuccess || per_cu < 1) { fprintf(stderr, "kernel_launch: occupancy query says %d\n", per_cu); (void)hipGetLastError(); }
        grid = cus > 256 ? 256 : cus;
    }
    if (grid < 0) return;
    (void)hipMemsetAsync((char*)d_ws + WS_CTL, 0, CTL_ZERO_BYTES, stream);
    Args a{};
    for (int i = 0; i < NIN; ++i) a.in[i] = (const float*)d_in[i];
    a.out = (float*)d_out; a.ws = (unsigned char*)d_ws;
#if MK_ONE_LAUNCH
    a.ph_lo = 0; a.ph_hi = NPHASE;
    hipLaunchKernelGGL(fwd_kernel, dim3(grid), dim3(NWAVES * 64), LDS_BYTES, stream, a);
#else
#ifndef RUN_PHASES
#define RUN_PHASES NPHASE
#endif
    for (int p = 0; p < RUN_PHASES; ++p) { a.ph_lo = p; a.ph_hi = p + 1; hipLaunchKernelGGL(fwd_kernel, dim3(grid), dim3(NWAVES * 64), LDS_BYTES, stream, a); }
#endif
}
```
